# Optimizing an MI355X kernel written in HIP

```python
import math
import jax
import jax.numpy as jnp
from jax import lax
import numpy as np

D_MODEL = 1024
BATCH = 8
SEQ = 2048
DEPTH = 4

GRID_W = 64
CTX_LEN = 256
N_MOD = 9
FFN_HIDDEN = 2816
EPS = 1e-6
ROPE_THETA = 10000.0
Q_BLOCK = 128
GROUP_W = D_MODEL // 4
D_MIX = 4 * GROUP_W
HEAD_DIM = 64
ML_HEADS = GROUP_W // HEAD_DIM
ML_HEAD_DIM = HEAD_DIM
ML_CHUNK = 64
ML_CONV = 3
ML_N_GATES = 4 * ML_HEADS
GQA_HEADS = GROUP_W // HEAD_DIM
GQA_KV_HEADS = GQA_HEADS // 2
HY_CH = GROUP_W
HY_ORDER = 2
HY_SHORT = 3
HY_POS_BANDS = 16
HY_POS_DIM = 1 + 2 * HY_POS_BANDS
HY_FILT_HIDDEN = 64
HY_DECAY_TARGET = 1e-2
HY_FAST_DECAY = 0.3
HY_SLOW_DECAY = 1.5
DIFF_HEADS = GROUP_W // HEAD_DIM
DIFF_SUB_DIM = HEAD_DIM // 2
N_IN_ML = 4 * GROUP_W + ML_N_GATES
N_IN_GQA = (GQA_HEADS + 2 * GQA_KV_HEADS) * HEAD_DIM
N_IN_HY = (HY_ORDER + 1) * HY_CH
N_IN_DIFF = 3 * GROUP_W
N_IN = N_IN_ML + N_IN_GQA + N_IN_HY + N_IN_DIFF
IN_SPLITS = [N_IN_ML, N_IN_ML + N_IN_GQA, N_IN_ML + N_IN_GQA + N_IN_HY]

kernel_name = 'hybrid_mlstm_gqa_hyena_diffattn_dit_trunk'


def _rmsnorm(x, g):
    xf = x.astype(jnp.float32)
    y = xf * lax.rsqrt(jnp.mean(xf * xf, axis=-1, keepdims=True) + EPS)
    return (y * g.astype(jnp.float32)).astype(x.dtype)


def _modnorm(x, g, shift, scale):
    return _rmsnorm(x, g) * (1 + scale) + shift


def _swiglu(x, w13, w2):
    a, b = jnp.split(x @ w13, 2, axis=-1)
    return (jax.nn.silu(a) * b) @ w2


def _ffn_half(x, g, shift, scale, gate, w13, w2):
    return x + 0.5 * gate * _swiglu(_modnorm(x, g, shift, scale), w13, w2)


def _split_heads(x, n_heads):
    B, L, _ = x.shape
    return x.reshape(B, L, n_heads, -1).transpose(0, 2, 1, 3)


def _merge_heads(x):
    B, H, L, d = x.shape
    return x.transpose(0, 2, 1, 3).reshape(B, L, H * d)


def _dwconv_centred(x, w, b):
    C, K = x.shape[-1], w.shape[0]
    y = lax.conv_general_dilated(x, w[:, None, :].astype(x.dtype), window_strides=(1,),
                                 padding=[(K // 2, K // 2)],
                                 dimension_numbers=('NWC', 'WIO', 'NWC'), feature_group_count=C)
    return y + b


def _axial_rope_tables(length, dim):
    rows = length // GRID_W
    row = jnp.repeat(jnp.arange(rows), GRID_W).astype(jnp.float32)
    col = jnp.tile(jnp.arange(GRID_W), rows).astype(jnp.float32)
    n_freq = dim // 4
    inv = ROPE_THETA ** (-jnp.arange(n_freq, dtype=jnp.float32) / n_freq)
    ang = jnp.concatenate([row[:, None] * inv, col[:, None] * inv], axis=-1)
    return jnp.cos(ang), jnp.sin(ang)


def _rope(x, rope):
    cos, sin = rope
    x1, x2 = jnp.split(x, 2, axis=-1)
    return jnp.concatenate([x1 * cos - x2 * sin, x1 * sin + x2 * cos], axis=-1).astype(x.dtype)


def _sweep(fn, *qs):
    B, H, L, _ = qs[0].shape
    nb = L // Q_BLOCK
    blocks = tuple(q.reshape(B, H, nb, Q_BLOCK, q.shape[-1]).transpose(2, 0, 1, 3, 4) for q in qs)
    out = lax.map(lambda bq: fn(*bq), blocks)
    return out.transpose(1, 2, 0, 3, 4).reshape(B, H, L, out.shape[-1])


def _mlstm_scan(q, k, v, log_i, log_f, state):
    B, H, L, d = q.shape
    nc = L // ML_CHUNK

    def to_chunks(t):
        return jnp.moveaxis(t.reshape(B, H, nc, ML_CHUNK, *t.shape[3:]), 2, 0)

    tril = jnp.tril(jnp.ones((ML_CHUNK, ML_CHUNK), dtype=bool))

    def step(carry, xs):
        C, n, m = carry
        qc, kc, vc, ic, fc = xs
        b = jnp.cumsum(fc, axis=-1)
        log_w = jnp.where(tril, b[..., :, None] - b[..., None, :] + ic[..., None, :], -jnp.inf)
        log_inter = b + m[..., None]
        m_t = jnp.maximum(log_inter, jnp.max(log_w, axis=-1))
        w_intra = jnp.exp(log_w - m_t[..., None])
        w_inter = jnp.exp(log_inter - m_t)
        s = jnp.einsum('bhtd,bhsd->bhts', qc, kc) * w_intra
        num = (w_inter[..., None] * jnp.einsum('bhde,bhte->bhtd', C, qc)
               + jnp.einsum('bhts,bhsd->bhtd', s, vc))
        den = w_inter * jnp.einsum('bhd,bhtd->bht', n, qc) + jnp.sum(s, axis=-1)
        h = num / jnp.maximum(jnp.abs(den), jnp.exp(-m_t))[..., None]
        b_end = b[..., -1]
        log_g = b_end[..., None] - b + ic
        m_new = jnp.maximum(b_end + m, jnp.max(log_g, axis=-1))
        w_g = jnp.exp(log_g - m_new[..., None])
        w_c = jnp.exp(b_end + m - m_new)
        C = w_c[..., None, None] * C + jnp.einsum('bhs,bhsd,bhse->bhde', w_g, vc, kc)
        n = w_c[..., None] * n + jnp.einsum('bhs,bhsd->bhd', w_g, kc)
        return (C, n, m_new), h

    xs = tuple(to_chunks(t) for t in (q, k, v, log_i, log_f))
    state, hs = lax.scan(step, state, xs)
    return jnp.moveaxis(hs, 0, 2).reshape(B, H, L, d), state


def _mlstm_bidir(q, k, v, g, state_f, state_b):
    h_f, s_f = _mlstm_scan(q, k, v, g[0], jax.nn.log_sigmoid(g[1]), state_f)
    fl = lambda t: jnp.flip(t, axis=2)
    h_b, s_b = _mlstm_scan(fl(q), fl(k), fl(v), fl(g[2]), fl(jax.nn.log_sigmoid(g[3])), state_b)
    return h_f + fl(h_b), s_f, s_b


def _mlstm_mixer(pl, pc, conv_w, conv_b, gate_b, norm_g, need_ctx):
    def prep(p):
        B, L, _ = p.shape
        q, k, v, o, g = jnp.split(p, [GROUP_W, 2 * GROUP_W, 3 * GROUP_W, 4 * GROUP_W], axis=-1)
        qk = jax.nn.silu(_dwconv_centred(jnp.concatenate([q, k], axis=-1), conv_w, conv_b))
        q, k = jnp.split(qk, 2, axis=-1)
        g = (g.astype(jnp.float32) + gate_b).reshape(B, L, 4, ML_HEADS).transpose(2, 0, 3, 1)
        heads = lambda t: _split_heads(t, ML_HEADS).astype(jnp.float32)
        return heads(q) * ML_HEAD_DIM ** -0.5, heads(k), heads(v), o, g

    def out(h, o, dtype):
        hn = _rmsnorm(h, norm_g.reshape(ML_HEADS, 1, ML_HEAD_DIM))
        return (_merge_heads(hn) * jax.nn.sigmoid(o.astype(jnp.float32))).astype(dtype)

    qc, kc, vc, oc, gc = prep(pc)
    ql, kl, vl, ol, gl = prep(pl)
    B = pl.shape[0]
    zero = (jnp.zeros((B, ML_HEADS, ML_HEAD_DIM, ML_HEAD_DIM), jnp.float32),
            jnp.zeros((B, ML_HEADS, ML_HEAD_DIM), jnp.float32),
            jnp.zeros((B, ML_HEADS), jnp.float32))
    hc, s_f, s_b = _mlstm_bidir(qc, kc, vc, gc, zero, zero)
    hl, _, _ = _mlstm_bidir(ql, kl, vl, gl, s_f, s_b)
    yc = out(hc, oc, pc.dtype) if need_ctx else None
    return out(hl, ol, pl.dtype), yc


def _gqa_block(qb, k, v):
    B, Hq, Q, d = qb.shape
    Hkv = k.shape[1]
    qg = qb.reshape(B, Hkv, Hq // Hkv, Q, d)
    s = jnp.einsum('bhgqd,bhkd->bhgqk', qg, k, preferred_element_type=jnp.float32) * d ** -0.5
    p = jax.nn.softmax(s, axis=-1)
    o = jnp.einsum('bhgqk,bhkd->bhgqd', p.astype(v.dtype), v)
    return o.reshape(B, Hq, Q, d)


def _gqa_mixer(pl, pc, qk_g, rope, need_ctx):
    def prep(p):
        q, k, v = jnp.split(p, [GQA_HEADS * HEAD_DIM, (GQA_HEADS + GQA_KV_HEADS) * HEAD_DIM], axis=-1)
        return (_rmsnorm(_split_heads(q, GQA_HEADS), qk_g[0]),
                _rmsnorm(_split_heads(k, GQA_KV_HEADS), qk_g[1]),
                _split_heads(v, GQA_KV_HEADS))

    ql, kl, vl = prep(pl)
    qc, kc, vc = prep(pc)
    ql, kl = _rope(ql, rope), _rope(kl, rope)
    k_all = jnp.concatenate([kc, kl], axis=2)
    v_all = jnp.concatenate([vc, vl], axis=2)
    yl = _merge_heads(_sweep(lambda qb: _gqa_block(qb, k_all, v_all), ql))
    yc = _merge_heads(_sweep(lambda qb: _gqa_block(qb, kc, vc), qc)) if need_ctx else None
    return yl, yc


def _hyena_filters(length, w1, b1, w2, b2, w3, b3):
    t = jnp.arange(length, dtype=jnp.float32)
    tn = t / length
    bands = jnp.arange(1, HY_POS_BANDS + 1, dtype=jnp.float32)
    ang = 2.0 * math.pi * tn[:, None] * bands
    feats = jnp.concatenate([tn[:, None], jnp.cos(ang), jnp.sin(ang)], axis=-1)
    h = jnp.sin(feats @ w1.astype(jnp.float32) + b1.astype(jnp.float32))
    h = jnp.sin(h @ w2.astype(jnp.float32) + b2.astype(jnp.float32))
    h = h @ w3.astype(jnp.float32) + b3.astype(jnp.float32)
    dist = jnp.abs(t - length // 2) / (length / 2)
    deltas = jnp.abs(jnp.linspace(math.log(HY_DECAY_TARGET) / HY_SLOW_DECAY,
                                  math.log(HY_DECAY_TARGET) / HY_FAST_DECAY, HY_CH, dtype=jnp.float32))
    h = h * jnp.exp(-dist[:, None] * jnp.tile(deltas, HY_ORDER))
    return h / jnp.sum(jnp.abs(h), axis=0, keepdims=True)


def _fft_conv_centred(u, h, skip):
    L = u.shape[1]
    n = 2 * L
    y = jnp.fft.irfft(jnp.fft.rfft(u, n=n, axis=1) * jnp.fft.rfft(h, n=n, axis=0)[None], n=n, axis=1)
    return y[:, L // 2: L // 2 + L] + u * skip


def _hyena_seq(p, conv_w, conv_b, filt, skip):
    u = _dwconv_centred(p, conv_w, conv_b).astype(jnp.float32)
    v, x1, x2 = jnp.split(u, 3, axis=-1)
    h = _hyena_filters(p.shape[1], *filt)
    skip = skip.astype(jnp.float32)
    z = x1 * _fft_conv_centred(v, h[:, :HY_CH], skip[0])
    return (x2 * _fft_conv_centred(z, h[:, HY_CH:], skip[1])).astype(p.dtype)


def _diff_block(q1b, q2b, k1, k2, v, lam):
    scale = DIFF_SUB_DIM ** -0.5
    s1 = jnp.einsum('bhqd,bhkd->bhqk', q1b, k1, preferred_element_type=jnp.float32) * scale
    s2 = jnp.einsum('bhqd,bhkd->bhqk', q2b, k2, preferred_element_type=jnp.float32) * scale
    p = jax.nn.softmax(s1, axis=-1) - lam * jax.nn.softmax(s2, axis=-1)
    return jnp.einsum('bhqk,bhkd->bhqd', p.astype(v.dtype), v)


def _diff_mixer(pl, pc, qk_g, lam_p, subln_g, lam_init, rope, need_ctx):
    def prep(p):
        q, k, v = jnp.split(p, 3, axis=-1)
        q1, q2 = jnp.split(_split_heads(q, DIFF_HEADS), 2, axis=-1)
        k1, k2 = jnp.split(_split_heads(k, DIFF_HEADS), 2, axis=-1)
        return (_rmsnorm(q1, qk_g[0]), _rmsnorm(q2, qk_g[0]),
                _rmsnorm(k1, qk_g[1]), _rmsnorm(k2, qk_g[1]), _split_heads(v, DIFF_HEADS))

    lp = lam_p.astype(jnp.float32)
    lam = jnp.exp(jnp.sum(lp[0] * lp[1])) - jnp.exp(jnp.sum(lp[2] * lp[3])) + lam_init
    q1l, q2l, k1l, k2l, vl = prep(pl)
    q1l, q2l, k1l, k2l = (_rope(t, rope) for t in (q1l, q2l, k1l, k2l))
    q1c, q2c, k1c, k2c, vc = prep(pc)

    def out(q1, q2, k1, k2, v):
        y = _sweep(lambda a, b: _diff_block(a, b, k1, k2, v, lam), q1, q2)
        return _merge_heads(_rmsnorm(y, subln_g) * (1.0 - lam_init))

    cat = lambda a, b: jnp.concatenate([a, b], axis=2)
    yl = out(q1l, q2l, cat(k1c, k1l), cat(k2c, k2l), cat(vc, vl))
    yc = out(q1c, q2c, k1c, k2c, vc) if need_ctx else None
    return yl, yc


def setup_inputs(seed: int = 0) -> dict:
    key = jax.random.key(seed)
    it = iter(list(jax.random.split(key, 32)))
    nrm = lambda shape, scale: jax.random.normal(next(it), shape, jnp.float32) * scale
    f_bias = jnp.linspace(3.0, 6.0, ML_HEADS, dtype=jnp.float32)
    z = jnp.zeros((ML_HEADS,), jnp.float32)
    gate_struct = jnp.concatenate([z, f_bias, z, f_bias])
    return {
        'x': nrm((BATCH, SEQ, D_MODEL), 1.0),
        'c': nrm((BATCH, D_MODEL), 1.0),
        'ctx': nrm((BATCH, CTX_LEN, D_MODEL), 1.0),
        'c_ctx': nrm((D_MODEL,), 1.0),
        'ada_w': nrm((DEPTH, D_MODEL, N_MOD * D_MODEL), 0.5 * D_MODEL ** -0.5),
        'ada_b': nrm((DEPTH, N_MOD * D_MODEL), 0.01),
        'norm_g': 1.0 + nrm((DEPTH, 3, D_MODEL), 0.02),
        'ffn_w13': nrm((DEPTH, 2, D_MODEL, 2 * FFN_HIDDEN), D_MODEL ** -0.5),
        'ffn_w2': nrm((DEPTH, 2, FFN_HIDDEN, D_MODEL), FFN_HIDDEN ** -0.5),
        'w_in': nrm((DEPTH, D_MODEL, N_IN), D_MODEL ** -0.5),
        'w_out': nrm((DEPTH, D_MIX, D_MODEL), D_MIX ** -0.5),
        'ml_gate_b': gate_struct[None] + nrm((DEPTH, ML_N_GATES), 0.1),
        'ml_conv_w': nrm((DEPTH, ML_CONV, 2 * GROUP_W), ML_CONV ** -0.5),
        'ml_conv_b': nrm((DEPTH, 2 * GROUP_W), 0.02),
        'ml_norm_g': 1.0 + nrm((DEPTH, GROUP_W), 0.02),
        'gqa_qk_g': 1.0 + nrm((DEPTH, 2, HEAD_DIM), 0.02),
        'hy_conv_w': nrm((DEPTH, HY_SHORT, N_IN_HY), HY_SHORT ** -0.5),
        'hy_conv_b': nrm((DEPTH, N_IN_HY), 0.02),
        'hy_filt_w1': nrm((DEPTH, HY_POS_DIM, HY_FILT_HIDDEN), 1.0),
        'hy_filt_b1': nrm((DEPTH, HY_FILT_HIDDEN), 0.1),
        'hy_filt_w2': nrm((DEPTH, HY_FILT_HIDDEN, HY_FILT_HIDDEN), HY_FILT_HIDDEN ** -0.5),
        'hy_filt_b2': nrm((DEPTH, HY_FILT_HIDDEN), 0.1),
        'hy_filt_w3': nrm((DEPTH, HY_FILT_HIDDEN, HY_ORDER * HY_CH), HY_FILT_HIDDEN ** -0.5),
        'hy_filt_b3': nrm((DEPTH, HY_ORDER * HY_CH), 0.1),
        'hy_skip': nrm((DEPTH, HY_ORDER, HY_CH), 0.1),
        'diff_qk_g': 1.0 + nrm((DEPTH, 2, DIFF_SUB_DIM), 0.02),
        'diff_lambda': nrm((DEPTH, 4, DIFF_SUB_DIM), 0.1),
        'diff_subln_g': 1.0 + nrm((DEPTH, 2 * DIFF_SUB_DIM), 0.02),
    }


def reference(x, c, ctx, c_ctx, ada_w, ada_b, norm_g, ffn_w13, ffn_w2, w_in, w_out,
              ml_gate_b, ml_conv_w, ml_conv_b, ml_norm_g, gqa_qk_g,
              hy_conv_w, hy_conv_b, hy_filt_w1, hy_filt_b1, hy_filt_w2, hy_filt_b2, hy_filt_w3, hy_filt_b3,
              hy_skip, diff_qk_g, diff_lambda, diff_subln_g):
    B, L, D = x.shape
    rope_gqa = _axial_rope_tables(L, HEAD_DIM)
    rope_diff = _axial_rope_tables(L, DIFF_SUB_DIM)
    sc, scc = jax.nn.silu(c), jax.nn.silu(c_ctx)
    h, hc = x, ctx
    for l in range(DEPTH):
        need_ctx = l < DEPTH - 1
        mod_l = (sc @ ada_w[l] + ada_b[l]).reshape(B, 1, N_MOD, D)
        mod_c = (scc @ ada_w[l] + ada_b[l]).reshape(N_MOD, D)
        lam_init = 0.8 - 0.6 * math.exp(-0.3 * l)
        filt = (hy_filt_w1[l], hy_filt_b1[l], hy_filt_w2[l], hy_filt_b2[l], hy_filt_w3[l], hy_filt_b3[l])

        h = _ffn_half(h, norm_g[l, 0], mod_l[:, :, 0], mod_l[:, :, 1], mod_l[:, :, 2], ffn_w13[l, 0], ffn_w2[l, 0])
        hc = _ffn_half(hc, norm_g[l, 0], mod_c[0], mod_c[1], mod_c[2], ffn_w13[l, 0], ffn_w2[l, 0])

        pl = _modnorm(h, norm_g[l, 1], mod_l[:, :, 3], mod_l[:, :, 4]) @ w_in[l]
        pc = _modnorm(hc, norm_g[l, 1], mod_c[3], mod_c[4]) @ w_in[l]
        pl_ml, pl_gqa, pl_hy, pl_diff = jnp.split(pl, IN_SPLITS, axis=-1)
        pc_ml, pc_gqa, pc_hy, pc_diff = jnp.split(pc, IN_SPLITS, axis=-1)

        ym_l, ym_c = _mlstm_mixer(pl_ml, pc_ml, ml_conv_w[l], ml_conv_b[l], ml_gate_b[l], ml_norm_g[l], need_ctx)
        yg_l, yg_c = _gqa_mixer(pl_gqa, pc_gqa, gqa_qk_g[l], rope_gqa, need_ctx)
        yh_l = _hyena_seq(pl_hy, hy_conv_w[l], hy_conv_b[l], filt, hy_skip[l])
        yd_l, yd_c = _diff_mixer(pl_diff, pc_diff, diff_qk_g[l], diff_lambda[l], diff_subln_g[l],
                                 lam_init, rope_diff, need_ctx)

        h = h + mod_l[:, :, 5] * (jnp.concatenate([ym_l, yg_l, yh_l, yd_l], axis=-1) @ w_out[l])
        h = _ffn_half(h, norm_g[l, 2], mod_l[:, :, 6], mod_l[:, :, 7], mod_l[:, :, 8], ffn_w13[l, 1], ffn_w2[l, 1])

        if need_ctx:
            yh_c = _hyena_seq(pc_hy, hy_conv_w[l], hy_conv_b[l], filt, hy_skip[l])
            hc = hc + mod_c[5] * (jnp.concatenate([ym_c, yg_c, yh_c, yd_c], axis=-1) @ w_out[l])
            hc = _ffn_half(hc, norm_g[l, 2], mod_c[6], mod_c[7], mod_c[8], ffn_w13[l, 1], ffn_w2[l, 1])
    return h
```

```cpp
#include <hip/hip_runtime.h>
#include <hip/hip_cooperative_groups.h>
#include <cstdio>
namespace cg = cooperative_groups;
__device__ __forceinline__ int opaque_tid() { int t = threadIdx.x; asm volatile("" : "+v"(t)); return t; }
__device__ __forceinline__ int opaque_bid() { int b = blockIdx.x; asm volatile("" : "+s"(b)); return b; }
namespace pg8 {
#define PG8_LAS __attribute__((address_space(3)))
typedef unsigned short bf16_t;
typedef short bf16x8 __attribute__((ext_vector_type(8)));
typedef float f32x4 __attribute__((ext_vector_type(4)));
typedef unsigned u32x4 __attribute__((ext_vector_type(4)));
constexpr int BM = 256, BK = 64, HALF = 128, HTB = HALF * BK * 2  , STAGE_BYTES = 8 * HTB, NXCD = 8, WGM = 8;

__host__ __device__ __forceinline__ int lds_byte(int r, int c) { const int st = (r >> 4) * 2 + (c >> 5), rr = r & 15, cc = c & 31, ob = rr * 64 + cc * 2; return st * 1024 + (ob ^ (((ob >> 9) & 1) << 5)); }
__host__ __device__ __forceinline__ void stage_rc(int b, int& R, int& C) { const int st = b / 1024, sb = b % 1024, swz = sb ^ (((sb >> 9) & 1) << 5); R = (st >> 1) * 16 + swz / 64; C = (st & 1) * 32 + (swz % 64) / 2; }
__host__ __device__ __forceinline__ int perm32(int rho) { const int n = rho >> 4, i = rho & 15; return 8 * (i >> 2) + 4 * n + (i & 3); }

struct Unit { int pm, pn; };
struct Gemm { const bf16_t* A; const bf16_t* Bt; int M, N, K; };

struct StaticOrder {
    int nM, nN, nwg, G, c;
    __host__ __device__ void init(int M, int N, int G_, int c_) { nM = M / BM; nN = N / BM; nwg = nM * nN; G = G_; c = c_; }
    __host__ __device__ bool next(int i, Unit& u) const {
        const long L = (long)i * G + c; if (L >= nwg) return false;
        int wgid = (int)L; { const int q = nwg / NXCD, r = nwg % NXCD, xcd = wgid % NXCD, off = wgid / NXCD; wgid = (xcd < r ? xcd * (q + 1) : r * (q + 1) + (xcd - r) * q) + off; }
        const int nig = WGM * nN, gid = wgid / nig, fm = gid * WGM, gsz = (nM - fm) < WGM ? (nM - fm) : WGM;
        u.pm = fm + ((wgid % nig) % gsz); u.pn = (wgid % nig) / gsz; return true;
    }
    __device__ __forceinline__ void a_ready(const Unit&) const {}
    __device__ __forceinline__ void done(const Unit&) const {}
};
__device__ __forceinline__ unsigned cvt_pk_bf16(float lo, float hi) { unsigned r; asm volatile("v_cvt_pk_bf16_f32 %0, %1, %2" : "=v"(r) : "v"(lo), "v"(hi)); return r; }
template <class Epi, class Sched, bool STAMP = false>
__device__ __forceinline__ void gemm_phase(PG8_LAS unsigned char* lds, const Gemm g, const Sched& S, const Epi& E, unsigned long long* stamps) {
    const int tid = opaque_tid(), wid = __builtin_amdgcn_readfirstlane(tid >> 6), lane = tid & 63, wr = wid >> 2, wc = wid & 3, fr = lane & 15, fq = lane >> 4;
    const int K = g.K, nt = K / BK;
    int ts_lo = 0, ts_hi = 0, nts = 0; const unsigned long long rt_entry = STAMP ? (unsigned long long)wall_clock64() : 0ull;
#define PG8_STAMP() do { if (STAMP && wid == 0 && nts < 64) { const unsigned long long _c = (unsigned long long)clock64(); \
        ts_lo = (lane == nts) ? (int)(unsigned)_c : ts_lo; ts_hi = (lane == nts) ? (int)(unsigned)(_c >> 32) : ts_hi; ++nts; } } while (0)
    PG8_STAMP();
    unsigned voffA[2], voffB[2];
#pragma unroll
    for (int i = 0; i < 2; ++i) { int R, C; stage_rc(tid * 16 + i * 8192, R, C); const int Rb = Epi::PERM ? ((R & ~31) + perm32(R & 31)) : R;
        voffA[i] = (unsigned)(R * K + C) * 2u; voffB[i] = (unsigned)(Rb * K + C) * 2u; }
    const size_t kstep = (size_t)(BK * 2);
    const size_t hstep = (size_t)HALF * K * 2;
    const size_t tstep = 2 * hstep;
    const unsigned ldsw = (unsigned)wid * 1024u;
    const int aoff = lds_byte(wr * 64 + fr, fq * 8), boff = lds_byte(wc * 32 + fr, fq * 8);
#define PG8_SA(b, h) (((b) * 2 + (h)) * HTB)
#define PG8_SB(b, h) ((4 + (b) * 2 + (h)) * HTB)
#define PG8_STAGE(bufoff, gbase, voff) do { _Pragma("unroll") for (int _i = 0; _i < 2; ++_i) \
        __builtin_amdgcn_global_load_lds((const unsigned*)((const char*)(gbase) + (voff)[_i]), (PG8_LAS unsigned*)(lds + (bufoff) + ldsw + _i * 8192), 16, 0, 0); } while (0)
#define PG8_LDA(dst, b, h) do { _Pragma("unroll") for (int m = 0; m < 4; ++m) _Pragma("unroll") for (int k = 0; k < 2; ++k) dst[m][k] = *(const PG8_LAS bf16x8*)(lds + PG8_SA(b, h) + aoff + m * 2048 + k * 1024); } while (0)
#define PG8_LDB(dst, b, h) do { _Pragma("unroll") for (int n = 0; n < 2; ++n) _Pragma("unroll") for (int k = 0; k < 2; ++k) dst[n][k] = *(const PG8_LAS bf16x8*)(lds + PG8_SB(b, h) + boff + n * 2048 + k * 1024); } while (0)
#define PG8_MMA(ai, bj, At, Bt) do { __builtin_amdgcn_s_setprio(1); _Pragma("unroll") for (int m = 0; m < 4; ++m) _Pragma("unroll") for (int n = 0; n < 2; ++n) _Pragma("unroll") for (int k = 0; k < 2; ++k) \
        acc[ai][bj][m][n] = __builtin_amdgcn_mfma_f32_16x16x32_bf16(Bt[n][k], At[m][k], acc[ai][bj][m][n], 0, 0, 0); __builtin_amdgcn_s_setprio(0); } while (0)
#define PG8_WAIT_V(n) asm volatile("s_waitcnt vmcnt(" #n ")" ::: "memory")
#define PG8_WAIT_L(n) asm volatile("s_waitcnt lgkmcnt(" #n ")" ::: "memory")
#define PG8_BAR __builtin_amdgcn_s_barrier()
#define PG8_SCHED __builtin_amdgcn_sched_barrier(0)
    Unit cur, nxt; int ui = 0;
    if (!S.next(0, cur)) return;
    f32x4 acc[2][2][4][2];
#pragma unroll
    for (int a = 0; a < 2; ++a)
#pragma unroll
        for (int b = 0; b < 2; ++b)
#pragma unroll
            for (int m = 0; m < 4; ++m)
#pragma unroll
                for (int n = 0; n < 2; ++n) acc[a][b][m][n] = (f32x4){0.f, 0.f, 0.f, 0.f};
    bf16x8 At[4][2], B0[2][2], B1[2][2];
    const char* cA = (const char*)g.A + (size_t)cur.pm * tstep; const char* cB = (const char*)g.Bt + (size_t)cur.pn * tstep;
    S.a_ready(cur);
    PG8_STAGE(PG8_SB(0, 0), cB, voffB); PG8_STAGE(PG8_SA(0, 0), cA, voffA); PG8_STAGE(PG8_SB(0, 1), cB + hstep, voffB); PG8_STAGE(PG8_SA(0, 1), cA + hstep, voffA);
    if (wr == 1) PG8_BAR;
    PG8_WAIT_V(4); PG8_BAR;
    PG8_STAGE(PG8_SB(1, 0), cB + kstep, voffB); PG8_STAGE(PG8_SA(1, 0), cA + kstep, voffA); PG8_STAGE(PG8_SB(1, 1), cB + hstep + kstep, voffB);
    PG8_WAIT_V(6); PG8_BAR;
    PG8_STAMP();
    for (;;) {
        const bool has_next = S.next(ui + 1, nxt);
        const char* nA = has_next ? (const char*)g.A + (size_t)nxt.pm * tstep : cA; const char* nB = has_next ? (const char*)g.Bt + (size_t)nxt.pn * tstep : cB;
        for (int t = 0; t < nt; t += 2) {
            const bool last = (t == nt - 2);
            const char* a1 = cA + (size_t)(t + 1) * kstep;
            const char* a2 = last ? nA : cA + (size_t)(t + 2) * kstep; const char* b2 = last ? nB : cB + (size_t)(t + 2) * kstep;
            const char* a3 = a2 + kstep; const char* b3 = b2 + kstep;
            if (last && has_next) S.a_ready(nxt);
            PG8_LDB(B0, 0, 0); PG8_SCHED; PG8_LDA(At, 0, 0); PG8_STAGE(PG8_SA(1, 1), a1 + hstep, voffA);
            PG8_WAIT_L(8); PG8_BAR; PG8_WAIT_L(0); PG8_MMA(0, 0, At, B0); PG8_BAR; PG8_SCHED;
            PG8_LDB(B1, 0, 1); PG8_STAGE(PG8_SB(0, 0), b2, voffB);
            PG8_BAR; PG8_WAIT_L(0); PG8_MMA(0, 1, At, B1); PG8_BAR;
            PG8_LDA(At, 0, 1); PG8_STAGE(PG8_SA(0, 0), a2, voffA);
            PG8_BAR; PG8_WAIT_L(0); PG8_MMA(1, 0, At, B0); PG8_BAR; PG8_SCHED;
            PG8_STAGE(PG8_SB(0, 1), b2 + hstep, voffB);
            PG8_WAIT_V(6); PG8_BAR; PG8_MMA(1, 1, At, B1); PG8_BAR;
            PG8_LDB(B0, 1, 0); PG8_SCHED; PG8_LDA(At, 1, 0); PG8_STAGE(PG8_SA(0, 1), a2 + hstep, voffA);
            PG8_WAIT_L(8); PG8_BAR; PG8_WAIT_L(0); PG8_MMA(0, 0, At, B0); PG8_BAR; PG8_SCHED;
            PG8_LDB(B1, 1, 1); PG8_STAGE(PG8_SB(1, 0), b3, voffB);
            PG8_BAR; PG8_WAIT_L(0); PG8_MMA(0, 1, At, B1); PG8_BAR;
            PG8_LDA(At, 1, 1); PG8_STAGE(PG8_SA(1, 0), a3, voffA);
            PG8_BAR; PG8_WAIT_L(0); PG8_MMA(1, 0, At, B0); PG8_BAR; PG8_SCHED;
            PG8_STAGE(PG8_SB(1, 1), b3 + hstep, voffB);
            PG8_WAIT_V(6); PG8_BAR; PG8_MMA(1, 1, At, B1); PG8_BAR;
        }
        PG8_STAMP();
        if constexpr (!Epi::AFTER_DRAIN) { E(acc, cur, wr, wc, fr, fq); S.done(cur); }
        PG8_STAMP();
        if (!has_next) break;
#pragma unroll
        for (int a = 0; a < 2; ++a)
#pragma unroll
            for (int b = 0; b < 2; ++b)
#pragma unroll
                for (int m = 0; m < 4; ++m)
#pragma unroll
                    for (int n = 0; n < 2; ++n) acc[a][b][m][n] = (f32x4){0.f, 0.f, 0.f, 0.f};
        cur = nxt; cA = nA; cB = nB; ++ui;
    }
    PG8_WAIT_V(0);
    if (wr == 0) PG8_BAR;
    PG8_BAR;
    if constexpr (Epi::AFTER_DRAIN) { E.fused(acc, cur, wr, wc, fr, fq, lds, wid, lane); S.done(cur); }
    PG8_STAMP();
    if (STAMP && wid == 0) { stamps[lane] = lane < nts ? (((unsigned long long)(unsigned)ts_hi << 32) | (unsigned)ts_lo) : 0ull;
        if (lane == 62) stamps[62] = rt_entry; if (lane == 63) stamps[63] = (unsigned long long)wall_clock64(); }
#undef PG8_STAMP
#undef PG8_SA
#undef PG8_SB
#undef PG8_STAGE
#undef PG8_LDA
#undef PG8_LDB
#undef PG8_MMA
#undef PG8_WAIT_V
#undef PG8_WAIT_L
#undef PG8_BAR
#undef PG8_SCHED
}
}

using pg8::bf16_t; using pg8::bf16x8; using pg8::f32x4;
#define DEVI __device__ __forceinline__
#define LAS3 __attribute__((address_space(3)))

constexpr int D = 1024, NB = 8, SEQ = 2048, CTX = 256, DEPTH = 4, FF = 2816, NIN = 3088, NP = 3072;
constexpr int MLAT = NB * SEQ, MCTX = NB * CTX, MT = MLAT + MCTX, KEYS = CTX + SEQ;
constexpr float LOG2E = 1.4426950408889634f;
constexpr int LDS_BYTES = 160 * 1024;
#ifndef SKIPMASK
#define SKIPMASK 0
#endif
#ifndef GM
#define GM 0
#endif
#ifndef P0M
#define P0M 0
#endif

constexpr size_t al256(size_t x) { return (x + 255) & ~(size_t)255; }
constexpr size_t WS_CTL = 0;
constexpr size_t WS_MOD = 4096;
constexpr size_t WS_W13 = WS_MOD + al256((size_t)DEPTH * 9 * 9216 * 4);
constexpr size_t WS_W2 = WS_W13 + al256((size_t)DEPTH * 2 * 5632 * 1024 * 2);
constexpr size_t WS_WIN = WS_W2 + al256((size_t)DEPTH * 2 * 1024 * 2816 * 2);
constexpr size_t WS_WOUT = WS_WIN + al256((size_t)DEPTH * 3072 * 1024 * 2);
constexpr size_t WS_HF = WS_WOUT + al256((size_t)DEPTH * 1024 * 1024 * 2);
constexpr size_t HF_LAYER = (size_t)512 * (SEQ + CTX);
constexpr size_t WS_HFS = WS_HF + al256((size_t)DEPTH * HF_LAYER * 4);
constexpr size_t WS_ROPEG = WS_HFS + al256((size_t)DEPTH * 36 * 512 * 4);
constexpr size_t WS_ROPED = WS_ROPEG + al256((size_t)SEQ * 64 * 4);
constexpr size_t WS_HCTX = WS_ROPED + al256((size_t)SEQ * 32 * 4);
constexpr size_t WS_A = WS_HCTX + al256((size_t)MCTX * D * 4);
constexpr size_t WS_P = WS_A + al256((size_t)MT * D * 2);
constexpr size_t WS_HID = WS_P;
constexpr size_t WS_GATES = WS_P + al256((size_t)MT * NP * 2);
constexpr size_t WS_CAT = WS_GATES + al256((size_t)MT * 16 * 4);
constexpr size_t WS_Q = WS_CAT + al256((size_t)MT * D * 2);
constexpr size_t WS_K = WS_Q + al256((size_t)NB * 8 * KEYS * 64 * 2);
constexpr size_t WS_VT = WS_K + al256((size_t)NB * 6 * KEYS * 64 * 2);
constexpr size_t WS_MLQK = WS_VT + al256((size_t)NB * 6 * KEYS * 64 * 2);
constexpr size_t WS_HYU = WS_MLQK + al256((size_t)MT * 512 * 4);
constexpr size_t WS_HYO = WS_HYU + al256((size_t)768 * MT * 2);
constexpr size_t WS_MLH = WS_HYO + al256((size_t)256 * MT * 2);
constexpr size_t WS_END = WS_MLH + al256((size_t)2 * MT * 256 * 4);
static_assert((size_t)MT * FF * 2 <= (size_t)MT * NP * 2, "HID must fit in P region");

struct Params { const float* in[28]; float* out; unsigned char* ws; };
__device__ __forceinline__ unsigned char* opaque_ws(const Params& P) { unsigned char* w = P.ws; asm volatile("" : "+s"(w)); return w; }

DEVI bf16_t f2bf(float f) { unsigned u = __float_as_uint(f); u += 0x7FFFu + ((u >> 16) & 1u); return (bf16_t)(u >> 16); }
DEVI unsigned pack2(float lo, float hi) { return (unsigned)f2bf(lo) | ((unsigned)f2bf(hi) << 16); }
DEVI float bflo(unsigned u) { return __uint_as_float(u << 16); }
DEVI float bfhi(unsigned u) { return __uint_as_float(u & 0xffff0000u); }
DEVI float bf2f(bf16_t b) { return __uint_as_float(((unsigned)b) << 16); }
DEVI float wave_sum(float v) { for (int o = 32; o; o >>= 1) v += __shfl_xor(v, o); return v; }
DEVI float wave_max(float v) { for (int o = 32; o; o >>= 1) v = fmaxf(v, __shfl_xor(v, o)); return v; }
DEVI float silu_fast(float a) { return a / (1.f + __expf(-a)); }
DEVI float silu_prec(float a) { return a / (1.f + expf(-a)); }
DEVI float sigmoid_fast(float a) { return 1.f / (1.f + __expf(-a)); }
DEVI float logsigmoid(float x) { return x >= 0.f ? -log1pf(expf(-x)) : x - log1pf(expf(x)); }
DEVI uint2 pack4(f32x4 v) { uint2 r; r.x = pack2(v[0], v[1]); r.y = pack2(v[2], v[3]); return r; }
DEVI f32x4 mfma16(bf16x8 a, bf16x8 b, f32x4 c) { return __builtin_amdgcn_mfma_f32_16x16x32_bf16(a, b, c, 0, 0, 0); }

struct EpiSwiglu {
    static constexpr bool PERM = false, AFTER_DRAIN = false;
    bf16_t* H;
    DEVI void operator()(const f32x4 (&acc)[2][2][4][2], const pg8::Unit& u, int wr, int wc, int fr, int fq) const {
        const int row0 = u.pm * 256 + wr * 64 + fr, col0 = u.pn * 128 + wc * 32 + 4 * fq;
#pragma unroll
        for (int ai = 0; ai < 2; ++ai)
#pragma unroll
            for (int m = 0; m < 4; ++m) { bf16_t* rowp = H + (size_t)(row0 + ai * 128 + m * 16) * FF + col0;
#pragma unroll
                for (int n = 0; n < 2; ++n) { const f32x4 a = acc[ai][0][m][n], b = acc[ai][1][m][n]; f32x4 v;
#pragma unroll
                    for (int i = 0; i < 4; ++i) v[i] = silu_fast(a[i]) * b[i];
                    *(uint2*)(rowp + n * 16) = pack4(v); } }
    }
};
struct EpiResid {
    static constexpr bool PERM = false, AFTER_DRAIN = false;
    float* hl; float* hc; const float* gate; float fac;
    DEVI void operator()(const f32x4 (&acc)[2][2][4][2], const pg8::Unit& u, int wr, int wc, int fr, int fq) const {
        const int row0 = u.pm * 256 + wr * 64 + fr, col0 = u.pn * 256 + wc * 32 + 4 * fq;
        const int r9 = u.pm < 64 ? (u.pm >> 3) : 8;
        const float* gp = gate + (size_t)r9 * 9216 + col0;
        f32x4 gv[2][2];
#pragma unroll
        for (int bj = 0; bj < 2; ++bj)
#pragma unroll
            for (int n = 0; n < 2; ++n) gv[bj][n] = *(const f32x4*)(gp + bj * 128 + n * 16) * fac;
#pragma unroll
        for (int ai = 0; ai < 2; ++ai)
#pragma unroll
            for (int m = 0; m < 4; ++m) { const int row = row0 + ai * 128 + m * 16;
                float* rowp = (row < MLAT ? hl + (size_t)row * D : hc + (size_t)(row - MLAT) * D) + col0;
#pragma unroll
                for (int bj = 0; bj < 2; ++bj)
#pragma unroll
                    for (int n = 0; n < 2; ++n) { f32x4* p = (f32x4*)(rowp + bj * 128 + n * 16); *p = *p + gv[bj][n] * acc[ai][bj][m][n]; } }
    }
};
struct EpiP {
    static constexpr bool PERM = false, AFTER_DRAIN = false;
    bf16_t* Pp;
    DEVI void operator()(const f32x4 (&acc)[2][2][4][2], const pg8::Unit& u, int wr, int wc, int fr, int fq) const {
        const int row0 = u.pm * 256 + wr * 64 + fr, col0 = u.pn * 256 + wc * 32 + 4 * fq;
#pragma unroll
        for (int ai = 0; ai < 2; ++ai)
#pragma unroll
            for (int m = 0; m < 4; ++m) { bf16_t* rowp = Pp + (size_t)(row0 + ai * 128 + m * 16) * NP + col0;
#pragma unroll
                for (int bj = 0; bj < 2; ++bj)
#pragma unroll
                    for (int n = 0; n < 2; ++n) *(uint2*)(rowp + bj * 128 + n * 16) = pack4(acc[ai][bj][m][n]); }
    }
};
template <class Epi> DEVI void run_gemm(unsigned char* smem, const bf16_t* A, const bf16_t* Bt, int N, int K, const Epi& E) {
    pg8::StaticOrder S; S.init(MT, N, (int)gridDim.x, opaque_bid());
    pg8::Gemm g; g.A = A; g.Bt = Bt; g.M = MT; g.N = N; g.K = K;
    pg8::gemm_phase<Epi, pg8::StaticOrder, false>((LAS3 unsigned char*)(smem + 1024), g, S, E, nullptr);
}

DEVI int colmap(int type, int n) {
    if (type == 0) { const int pn = n >> 8, bj = (n >> 7) & 1, jj = n & 127; return bj * FF + pn * 128 + jj; }
    if (type == 2) return n < 1024 ? n : n + 16;
    return n;
}
DEVI void convert_tile(const float* __restrict__ src, int Nsrc, int K, int type, bf16_t* __restrict__ dst, int kt, int nt, float* lt) {
    const int tid = opaque_tid(), k0 = kt * 64, n0 = nt * 256;
    { const int nn = tid & 255, kk0 = tid >> 8; const int col = colmap(type, n0 + nn);
      const float* s = src + (size_t)k0 * Nsrc + col;
#pragma unroll 8
      for (int i = 0; i < 32; ++i) { const int kk = kk0 + 2 * i; lt[nn * 65 + kk] = s[(size_t)kk * Nsrc]; } }
    __syncthreads();
    { const int kp = (tid & 31) * 2, nn0 = tid >> 5;
#pragma unroll 4
      for (int i = 0; i < 16; ++i) { const int nn = nn0 + 16 * i;
          *(unsigned*)(dst + (size_t)(n0 + nn) * K + k0 + kp) = pack2(lt[nn * 65 + kp], lt[nn * 65 + kp + 1]); } }
    __syncthreads();
}

DEVI void filt_item(const Params& P, int l, int tile, float* lds) {
    const int tid = opaque_tid();
    const int Lsel = tile >= 32; const int L = Lsel ? CTX : SEQ; const int t0 = (Lsel ? tile - 32 : tile) * 64;
    float* feats = lds; float* h1 = lds + 64 * 33; float* h2 = h1 + 64 * 65;
#pragma unroll 1
    for (int idx = tid; idx < 64 * 33; idx += 512) { const int r = idx / 33, f = idx - r * 33; const int t = t0 + r; float v;
        if (f == 0) v = (float)t / (float)L;
        else { const int band = f <= 16 ? f : f - 16; const int x = (t * band) & (L - 1); const float ang = 6.283185307179586f * ((float)x / (float)L); v = f <= 16 ? cosf(ang) : sinf(ang); }
        feats[idx] = v; }
    __syncthreads();
    const float* w1 = P.in[18] + (size_t)l * 33 * 64; const float* b1 = P.in[19] + l * 64;
    const float* w2 = P.in[20] + (size_t)l * 64 * 64; const float* b2 = P.in[21] + l * 64;
    const float* w3 = P.in[22] + (size_t)l * 64 * 512; const float* b3 = P.in[23] + l * 512;
    { const int j = tid & 63, r0 = tid >> 6; float acc[8];
#pragma unroll
      for (int i = 0; i < 8; ++i) acc[i] = b1[j];
      for (int f = 0; f < 33; ++f) { const float w = w1[f * 64 + j];
#pragma unroll
          for (int i = 0; i < 8; ++i) acc[i] += feats[(r0 + 8 * i) * 33 + f] * w; }
#pragma unroll
      for (int i = 0; i < 8; ++i) h1[(r0 + 8 * i) * 65 + j] = acc[i]; }
    __syncthreads();
#pragma unroll 1
    for (int idx = tid; idx < 64 * 64; idx += 512) { const int a = (idx >> 6) * 65 + (idx & 63); h1[a] = sinf(h1[a]); }
    __syncthreads();
    { const int j = tid & 63, r0 = tid >> 6; float acc[8];
#pragma unroll
      for (int i = 0; i < 8; ++i) acc[i] = b2[j];
      for (int f = 0; f < 64; ++f) { const float w = w2[f * 64 + j];
#pragma unroll
          for (int i = 0; i < 8; ++i) acc[i] += h1[(r0 + 8 * i) * 65 + f] * w; }
#pragma unroll
      for (int i = 0; i < 8; ++i) h2[(r0 + 8 * i) * 65 + j] = acc[i]; }
    __syncthreads();
#pragma unroll 1
    for (int idx = tid; idx < 64 * 64; idx += 512) { const int a = (idx >> 6) * 65 + (idx & 63); h2[a] = sinf(h2[a]); }
    __syncthreads();
    { const int c = tid; const float bb = b3[c]; const int cc = c & 255;
      const float da = -3.0701134573253946f, db = -15.350567286626973f;
      const float delta = fabsf(da + (db - da) * ((float)cc / 255.f));
      float cs = 0.f;
      float* hf = (float*)(opaque_ws(P) + WS_HF) + (size_t)l * HF_LAYER + (Lsel ? (size_t)512 * SEQ : 0) + (size_t)c * L + t0;
#pragma unroll 1
      for (int rh = 0; rh < 4; ++rh) { float acc[16];
#pragma unroll
          for (int r = 0; r < 16; ++r) acc[r] = 0.f;
#pragma unroll 1
          for (int k = 0; k < 64; ++k) { const float w = w3[k * 512 + c];
#pragma unroll
              for (int r = 0; r < 16; ++r) acc[r] += h2[(rh * 16 + r) * 65 + k] * w; }
#pragma unroll
          for (int r = 0; r < 16; ++r) { const int t = t0 + rh * 16 + r; const float dist = fabsf((float)(t - L / 2)) / (float)(L / 2);
              const float v = (acc[r] + bb) * expf(-dist * delta); cs += fabsf(v); hf[rh * 16 + r] = v; } }
      ((float*)(opaque_ws(P) + WS_HFS))[((size_t)l * 36 + tile) * 512 + c] = cs; }
    __syncthreads();
}

DEVI void mod_item(const Params& P, int l, int chunk, float* lds) {
    const int tid = opaque_tid();
    float* sc = lds; float* red = lds + 9 * 1024;
    for (int idx = tid; idx < 9 * 1024; idx += 512) { const int r = idx >> 10, k = idx & 1023; const float v = r < 8 ? P.in[1][r * 1024 + k] : P.in[3][k]; sc[idx] = silu_prec(v); }
    __syncthreads();
    const int col = tid & 127, ks = tid >> 7; const int n = chunk * 128 + col;
    const float* w = P.in[4] + (size_t)l * 1024 * 9216 + (size_t)(ks * 256) * 9216 + n;
    float acc[9];
#pragma unroll
    for (int r = 0; r < 9; ++r) acc[r] = 0.f;
#pragma unroll 8
    for (int k = 0; k < 256; ++k) { const float wv = w[(size_t)k * 9216];
#pragma unroll
        for (int r = 0; r < 9; ++r) acc[r] += sc[r * 1024 + ks * 256 + k] * wv; }
#pragma unroll
    for (int r = 0; r < 9; ++r) red[(ks * 9 + r) * 128 + col] = acc[r];
    __syncthreads();
    float* modout = (float*)(opaque_ws(P) + WS_MOD);
    for (int idx = tid; idx < 9 * 128; idx += 512) { const int r = idx >> 7, c = idx & 127;
        const float s = red[(0 * 9 + r) * 128 + c] + red[(1 * 9 + r) * 128 + c] + red[(2 * 9 + r) * 128 + c] + red[(3 * 9 + r) * 128 + c];
        modout[((size_t)l * 9 + r) * 9216 + chunk * 128 + c] = s + P.in[5][(size_t)l * 9216 + chunk * 128 + c]; }
    __syncthreads();
}

constexpr int N_FILT = DEPTH * 36, N_MODI = DEPTH * 72;
constexpr int CV_W13 = 16 * 22, CV_W2 = 44 * 4, CV_WIN = 16 * 12, CV_WOUT = 16 * 4;
constexpr int N_CV13 = DEPTH * 2 * CV_W13, N_CV2 = DEPTH * 2 * CV_W2, N_CVIN = DEPTH * CV_WIN, N_CVOUT = DEPTH * CV_WOUT;
constexpr int N_COPY = MT / 64, N_ROPE = 4;
constexpr int N_P0 = N_FILT + N_MODI + N_CV13 + N_CV2 + N_CVIN + N_CVOUT + N_COPY + N_ROPE;

DEVI void phase0(const Params& P, unsigned char* smem) {
    const int tid = opaque_tid();
    float* lds = (float*)(smem + 1024);
    if (opaque_bid() == 0 && tid < 64) ((unsigned*)(opaque_ws(P) + WS_CTL))[tid] = 0u;
    for (int it0 = opaque_bid(); it0 < N_P0; it0 += gridDim.x) {
        int it = it0;
        if (it < N_FILT) {
#if !(P0M & 1)
            filt_item(P, it / 36, it % 36, lds);
#endif
            continue; } it -= N_FILT;
        if (it < N_MODI) {
#if !(P0M & 2)
            mod_item(P, it / 72, it % 72, lds);
#endif
            continue; } it -= N_MODI;
        if (it < N_CV13) { const int lf = it / CV_W13, r = it % CV_W13; convert_tile(P.in[7] + (size_t)lf * 1024 * 5632, 5632, 1024, 0, (bf16_t*)(opaque_ws(P) + WS_W13) + (size_t)lf * 5632 * 1024, r / 22, r % 22, lds); continue; } it -= N_CV13;
        if (it < N_CV2) { const int lf = it / CV_W2, r = it % CV_W2; convert_tile(P.in[8] + (size_t)lf * 2816 * 1024, 1024, 2816, 1, (bf16_t*)(opaque_ws(P) + WS_W2) + (size_t)lf * 1024 * 2816, r / 4, r % 4, lds); continue; } it -= N_CV2;
        if (it < N_CVIN) { const int l = it / CV_WIN, r = it % CV_WIN; convert_tile(P.in[9] + (size_t)l * 1024 * NIN, NIN, 1024, 2, (bf16_t*)(opaque_ws(P) + WS_WIN) + (size_t)l * NP * 1024, r / 12, r % 12, lds); continue; } it -= N_CVIN;
        if (it < N_CVOUT) { const int l = it / CV_WOUT, r = it % CV_WOUT; convert_tile(P.in[10] + (size_t)l * 1024 * 1024, 1024, 1024, 1, (bf16_t*)(opaque_ws(P) + WS_WOUT) + (size_t)l * 1024 * 1024, r / 4, r % 4, lds); continue; } it -= N_CVOUT;
        if (it < N_COPY) {
            float* hctx = (float*)(opaque_ws(P) + WS_HCTX);
#pragma unroll 4
            for (int i = 0; i < 32; ++i) { const int idx4 = tid + 512 * i; const int row = it * 64 + (idx4 >> 8), c4 = (idx4 & 255) * 4;
                const float* s = row < MLAT ? P.in[0] + (size_t)row * D : P.in[2] + (size_t)(row - MLAT) * D;
                float* d = row < MLAT ? P.out + (size_t)row * D : hctx + (size_t)(row - MLAT) * D;
                *(float4*)(d + c4) = *(const float4*)(s + c4); }
            continue; } it -= N_COPY;
        { const int t = it * 512 + tid; const int row = t >> 6, col = t & 63;
          float* rg = (float*)(opaque_ws(P) + WS_ROPEG) + (size_t)t * 64; float* rd = (float*)(opaque_ws(P) + WS_ROPED) + (size_t)t * 32;
#if !(P0M & 16)
          for (int j = 0; j < 16; ++j) { const float inv = expf(-(float)j / 16.f * 9.210340371976184f); const float ar = (float)row * inv, ac = (float)col * inv;
              rg[j] = cosf(ar); rg[16 + j] = cosf(ac); rg[32 + j] = sinf(ar); rg[48 + j] = sinf(ac); }
          for (int j = 0; j < 8; ++j) { const float inv = expf(-(float)j / 8.f * 9.210340371976184f); const float ar = (float)row * inv, ac = (float)col * inv;
              rd[j] = cosf(ar); rd[8 + j] = cosf(ac); rd[16 + j] = sinf(ar); rd[24 + j] = sinf(ac); }
#endif
          (void)rg; (void)rd; (void)row; (void)col; }
    }
}

template <bool GATES> DEVI void norm_phase(const Params& P, int l, int which, unsigned char* smem) {
    const int tid = opaque_tid(), lane = tid & 63, wid = tid >> 6;
    const float* g = P.in[6] + (size_t)(l * 3 + which) * 1024;
    const float* modl = (const float*)(opaque_ws(P) + WS_MOD) + (size_t)l * 9 * 9216;
    const float* hctx = (const float*)(opaque_ws(P) + WS_HCTX);
    bf16_t* A = (bf16_t*)(opaque_ws(P) + WS_A);
    float* WgT = (float*)(smem + 1024);
    if (GATES) { const float* win = P.in[9] + (size_t)l * 1024 * NIN;
        for (int idx = tid; idx < 16384; idx += 512) { const int k = idx >> 4, jj = idx & 15; WgT[jj * 1024 + k] = win[(size_t)k * NIN + 1024 + jj]; }
        __syncthreads(); }
    float4 gv[4];
#pragma unroll
    for (int j = 0; j < 4; ++j) gv[j] = *(const float4*)(g + 4 * lane + 256 * j);
    for (int row = opaque_bid() * 8 + wid; row < MT; row += gridDim.x * 8) {
        const float* hp = row < MLAT ? P.out + (size_t)row * D : hctx + (size_t)(row - MLAT) * D;
        const int r9 = row < MLAT ? (row >> 11) : 8;
        const float* sh = modl + (size_t)r9 * 9216 + (3 * which) * 1024; const float* scl = sh + 1024;
        float4 x[4]; float ss = 0.f;
#pragma unroll
        for (int j = 0; j < 4; ++j) { x[j] = *(const float4*)(hp + 4 * lane + 256 * j); ss += x[j].x * x[j].x + x[j].y * x[j].y + x[j].z * x[j].z + x[j].w * x[j].w; }
        ss = wave_sum(ss);
        const float rstd = rsqrtf(ss * (1.f / 1024.f) + 1e-6f);
        float ga[16];
        if (GATES) {
#pragma unroll
            for (int jj = 0; jj < 16; ++jj) ga[jj] = 0.f; }
#pragma unroll
        for (int j = 0; j < 4; ++j) { const int col = 4 * lane + 256 * j;
            const float4 s4 = *(const float4*)(scl + col), h4 = *(const float4*)(sh + col);
            float4 y;
            y.x = x[j].x * rstd * gv[j].x * (1.f + s4.x) + h4.x; y.y = x[j].y * rstd * gv[j].y * (1.f + s4.y) + h4.y;
            y.z = x[j].z * rstd * gv[j].z * (1.f + s4.z) + h4.z; y.w = x[j].w * rstd * gv[j].w * (1.f + s4.w) + h4.w;
            uint2 o; o.x = pack2(y.x, y.y); o.y = pack2(y.z, y.w);
            *(uint2*)(A + (size_t)row * D + col) = o;
            if (GATES) {
#pragma unroll
                for (int jj = 0; jj < 16; ++jj) { const float4 w = *(const float4*)(WgT + jj * 1024 + col); ga[jj] += y.x * w.x + y.y * w.y + y.z * w.z + y.w * w.w; } } }
        if (GATES) { float outv = 0.f;
#pragma unroll
            for (int jj = 0; jj < 16; ++jj) { const float t = wave_sum(ga[jj]); if (lane == jj) outv = t; }
            if (lane < 16) ((float*)(opaque_ws(P) + WS_GATES))[(size_t)row * 16 + lane] = outv + P.in[11][l * 16 + lane]; }
    }
}

template <int LEN> DEVI void prep_seg(const bf16_t* __restrict__ src, const float* __restrict__ g, const float* __restrict__ rope, float scale, bf16_t* __restrict__ dst) {
    float x[LEN];
#pragma unroll
    for (int i = 0; i < LEN / 8; ++i) { const uint4 v = *(const uint4*)(src + 8 * i);
        x[8 * i + 0] = bflo(v.x); x[8 * i + 1] = bfhi(v.x); x[8 * i + 2] = bflo(v.y); x[8 * i + 3] = bfhi(v.y);
        x[8 * i + 4] = bflo(v.z); x[8 * i + 5] = bfhi(v.z); x[8 * i + 6] = bflo(v.w); x[8 * i + 7] = bfhi(v.w); }
    float ss = 0.f;
#pragma unroll
    for (int i = 0; i < LEN; ++i) ss += x[i] * x[i];
    const float rstd = rsqrtf(ss * (1.f / LEN) + 1e-6f);
#pragma unroll
    for (int i = 0; i < LEN; ++i) x[i] = x[i] * rstd * g[i];
    if (rope) {
#pragma unroll
        for (int j = 0; j < LEN / 2; ++j) { const float c = rope[j], s = rope[LEN / 2 + j]; const float a = x[j], b = x[j + LEN / 2]; x[j] = a * c - b * s; x[j + LEN / 2] = a * s + b * c; } }
#pragma unroll
    for (int i = 0; i < LEN / 8; ++i) { uint4 o;
        o.x = pack2(x[8 * i + 0] * scale, x[8 * i + 1] * scale); o.y = pack2(x[8 * i + 2] * scale, x[8 * i + 3] * scale);
        o.z = pack2(x[8 * i + 4] * scale, x[8 * i + 5] * scale); o.w = pack2(x[8 * i + 6] * scale, x[8 * i + 7] * scale);
        *(uint4*)(dst + 8 * i) = o; }
}
DEVI void unpack8(const uint4 v, float (&x)[8]) { x[0] = bflo(v.x); x[1] = bfhi(v.x); x[2] = bflo(v.y); x[3] = bfhi(v.y); x[4] = bflo(v.z); x[5] = bfhi(v.z); x[6] = bflo(v.w); x[7] = bfhi(v.w); }

DEVI void prep_phase(const Params& P, int l, unsigned char* smem) {
    const int tid = opaque_tid();
    const bf16_t* p = (const bf16_t*)(opaque_ws(P) + WS_P);
    bf16_t* Qb = (bf16_t*)(opaque_ws(P) + WS_Q); bf16_t* Kb = (bf16_t*)(opaque_ws(P) + WS_K); bf16_t* VT = (bf16_t*)(opaque_ws(P) + WS_VT);
    float* mlqk = (float*)(opaque_ws(P) + WS_MLQK); bf16_t* hyu = (bf16_t*)(opaque_ws(P) + WS_HYU);
    const float* ropeG = (const float*)(opaque_ws(P) + WS_ROPEG); const float* ropeD = (const float*)(opaque_ws(P) + WS_ROPED);
    const float* gqa_g = P.in[15] + l * 128; const float* diff_g = P.in[25] + l * 64;
    bf16_t* lt = (bf16_t*)(smem + 1024);
    for (int rt = opaque_bid(); rt < MT / 64; rt += gridDim.x) {
        const int row0 = rt * 64; const bool isctx = row0 >= MLAT;
        int b, t0, Ls;
        if (!isctx) { b = row0 >> 11; t0 = row0 & 2047; Ls = SEQ; } else { const int rc = row0 - MLAT; b = rc >> 8; t0 = rc & 255; Ls = CTX; }
        const int pp0 = isctx ? t0 : CTX + t0;
        for (int task = tid; task < 64 * 22; task += 512) {
            if (task < 384) { const int seg = task % 6, r = task / 6;
                const int srccol = seg < 4 ? 1024 + 64 * seg : 1280 + 64 * (seg - 4);
                const float* g = gqa_g + (seg < 4 ? 0 : 64); const float scale = seg < 4 ? 0.125f * LOG2E : 1.f;
                bf16_t* dst = seg < 4 ? Qb + (((size_t)b * 8 + seg) * KEYS + pp0 + r) * 64 : Kb + (((size_t)b * 6 + (seg - 4)) * KEYS + pp0 + r) * 64;
                const float* rope = isctx ? nullptr : ropeG + (size_t)(t0 + r) * 64;
                prep_seg<64>(p + (size_t)(row0 + r) * NP + srccol, g, rope, scale, dst);
            } else { const int tt = task - 384; const int seg = tt & 15, r = tt >> 4; const int isk = seg >> 3, hh = (seg >> 1) & 3, s = seg & 1;
                const int srccol = (isk ? 2560 : 2304) + 64 * hh + 32 * s;
                const float* g = diff_g + isk * 32; const float scale = isk ? 1.f : 0.17677669529663687f * LOG2E;
                bf16_t* dst = isk ? Kb + (((size_t)b * 6 + 2 + hh) * KEYS + pp0 + r) * 64 + 32 * s : Qb + (((size_t)b * 8 + 4 + hh) * KEYS + pp0 + r) * 64 + 32 * s;
                const float* rope = isctx ? nullptr : ropeD + (size_t)(t0 + r) * 32;
                prep_seg<32>(p + (size_t)(row0 + r) * NP + srccol, g, rope, scale, dst);
            }
        }
        { const float* cw = P.in[12] + (size_t)l * 3 * 512; const float* cb = P.in[13] + (size_t)l * 512;
          for (int task = tid; task < 64 * 64; task += 512) { const int cg8 = task & 63, r = task >> 6; const int c0 = cg8 * 8; const int t = t0 + r;
              const bf16_t* pr = p + (size_t)(row0 + r) * NP + c0;
              float xm[8], x0[8], xp[8];
              unpack8(*(const uint4*)pr, x0);
              if (t > 0) unpack8(*(const uint4*)(pr - NP), xm); else {
#pragma unroll
                  for (int i = 0; i < 8; ++i) xm[i] = 0.f; }
              if (t < Ls - 1) unpack8(*(const uint4*)(pr + NP), xp); else {
#pragma unroll
                  for (int i = 0; i < 8; ++i) xp[i] = 0.f; }
              const float sc = c0 < 256 ? 0.125f : 1.f;
              float y[8];
#pragma unroll
              for (int i = 0; i < 8; ++i) { const float v = cw[c0 + i] * xm[i] + cw[512 + c0 + i] * x0[i] + cw[1024 + c0 + i] * xp[i] + cb[c0 + i]; y[i] = silu_fast(v) * sc; }
              float* o = mlqk + (size_t)(row0 + r) * 512 + c0;
              *(float4*)o = make_float4(y[0], y[1], y[2], y[3]); *(float4*)(o + 4) = make_float4(y[4], y[5], y[6], y[7]); } }
        for (int task = tid; task < 64 * 48; task += 512) { const int r = task & 63, ch = task >> 6;
            const int srccol = ch < 16 ? 1408 + ch * 8 : 2816 + (ch - 16) * 8;
            const uint4 v = *(const uint4*)(p + (size_t)(row0 + r) * NP + srccol);
            bf16_t* d = lt + (size_t)(ch * 8) * 72 + r;
            d[0] = (bf16_t)(v.x & 0xffff); d[72] = (bf16_t)(v.x >> 16); d[144] = (bf16_t)(v.y & 0xffff); d[216] = (bf16_t)(v.y >> 16);
            d[288] = (bf16_t)(v.z & 0xffff); d[360] = (bf16_t)(v.z >> 16); d[432] = (bf16_t)(v.w & 0xffff); d[504] = (bf16_t)(v.w >> 16); }
        __syncthreads();
        for (int task = tid; task < 384 * 8; task += 512) { const int dd = task >> 3, ch = task & 7; const int slot = dd >> 6, d = dd & 63;
            *(uint4*)(VT + (((size_t)b * 6 + slot) * 64 + d) * KEYS + pp0 + ch * 8) = *(const uint4*)(lt + (size_t)dd * 72 + ch * 8); }
        __syncthreads();
        { const float* cw = P.in[16] + (size_t)l * 3 * 768; const float* cb = P.in[17] + (size_t)l * 768;
          for (int task = tid; task < 64 * 96; task += 512) { const int r = task & 63, ch = task >> 6; const int c0 = ch * 8; const int t = t0 + r;
              const bf16_t* pr = p + (size_t)(row0 + r) * NP + 1536 + c0;
              float xm[8], x0[8], xp[8];
              unpack8(*(const uint4*)pr, x0);
              if (t > 0) unpack8(*(const uint4*)(pr - NP), xm); else {
#pragma unroll
                  for (int i = 0; i < 8; ++i) xm[i] = 0.f; }
              if (t < Ls - 1) unpack8(*(const uint4*)(pr + NP), xp); else {
#pragma unroll
                  for (int i = 0; i < 8; ++i) xp[i] = 0.f; }
              bf16_t* d = lt + (size_t)c0 * 72 + r;
#pragma unroll
              for (int i = 0; i < 8; ++i) { const float v = cw[c0 + i] * xm[i] + cw[768 + c0 + i] * x0[i] + cw[1536 + c0 + i] * xp[i] + cb[c0 + i]; d[i * 72] = f2bf(v); } } }
        __syncthreads();
        for (int task = tid; task < 768 * 8; task += 512) { const int cc = task >> 3, ch = task & 7;
            *(uint4*)(hyu + (size_t)cc * MT + row0 + ch * 8) = *(const uint4*)(lt + (size_t)cc * 72 + ch * 8); }
        __syncthreads();
    }
}

template <bool DIFF> DEVI void attn_item(const Params& P, int l, int b, int hsel, int qb, bool isctx, unsigned char* smem) {
    const int tid = opaque_tid(), lane = tid & 63, wid = tid >> 6, fr = lane & 15, quad = lane >> 4;
    bf16_t* Ks = (bf16_t*)(smem + 1024); bf16_t* Vs = Ks + 64 * 72;
    const int nkt = (isctx ? CTX : KEYS) / 64;
    const int pq0 = (isctx ? 0 : CTX) + qb * 128 + wid * 16;
    const int slotk = DIFF ? 2 + hsel : hsel;
    const bf16_t* Kg = (const bf16_t*)(opaque_ws(P) + WS_K) + ((size_t)b * 6 + slotk) * KEYS * 64;
    const bf16_t* Vg = (const bf16_t*)(opaque_ws(P) + WS_VT) + ((size_t)b * 6 + slotk) * 64 * KEYS;
    const bf16_t* Qg = (const bf16_t*)(opaque_ws(P) + WS_Q);
    bf16x8 q[2][2];
#pragma unroll
    for (int s = 0; s < 2; ++s) { const int slotq = DIFF ? 4 + hsel : 2 * hsel + s;
        const bf16_t* qp = Qg + (((size_t)b * 8 + slotq) * KEYS + pq0 + fr) * 64 + quad * 8;
        q[s][0] = *(const bf16x8*)qp; q[s][1] = *(const bf16x8*)(qp + 32); }
    float M2;
    { const float* g = DIFF ? P.in[25] + l * 64 : P.in[15] + l * 128; const int n = DIFF ? 32 : 64;
      float a = lane < n ? fabsf(g[lane]) : 0.f, bb = lane < n ? fabsf(g[n + lane]) : 0.f; a = wave_max(a); bb = wave_max(bb);
      M2 = sqrtf((float)n) * a * bb * LOG2E; }
    f32x4 O[2][4];
#pragma unroll
    for (int s = 0; s < 2; ++s)
#pragma unroll
        for (int d = 0; d < 4; ++d) O[s][d] = (f32x4){0.f, 0.f, 0.f, 0.f};
    float lsum[2] = {0.f, 0.f};
    const int lrow = tid >> 3, lch = (tid & 7) * 8;
    uint4 kreg = *(const uint4*)(Kg + (size_t)lrow * 64 + lch);
    uint4 vreg = *(const uint4*)(Vg + (size_t)lrow * KEYS + lch);
    for (int kt = 0; kt < nkt; ++kt) {
        __syncthreads();
        *(uint4*)(Ks + lrow * 72 + lch) = kreg; *(uint4*)(Vs + lrow * 72 + lch) = vreg;
        __syncthreads();
        if (kt + 1 < nkt) { kreg = *(const uint4*)(Kg + (size_t)((kt + 1) * 64 + lrow) * 64 + lch); vreg = *(const uint4*)(Vg + (size_t)lrow * KEYS + (kt + 1) * 64 + lch); }
        f32x4 S[2][4];
        const f32x4 zero = (f32x4){0.f, 0.f, 0.f, 0.f};
#pragma unroll
        for (int ks = 0; ks < 4; ++ks) { const bf16_t* kp = Ks + (ks * 16 + fr) * 72 + quad * 8;
            const bf16x8 k0 = *(const bf16x8*)kp, k1 = *(const bf16x8*)(kp + 32);
            if (!DIFF) { S[0][ks] = mfma16(k0, q[0][0], zero); S[0][ks] = mfma16(k1, q[0][1], S[0][ks]); S[1][ks] = mfma16(k0, q[1][0], zero); S[1][ks] = mfma16(k1, q[1][1], S[1][ks]); }
            else { S[0][ks] = mfma16(k0, q[0][0], zero); S[1][ks] = mfma16(k1, q[0][1], zero); } }
        bf16x8 pb[2][2];
#pragma unroll
        for (int s = 0; s < 2; ++s)
#pragma unroll
            for (int kk = 0; kk < 2; ++kk) { float pv[8];
#pragma unroll
                for (int i = 0; i < 4; ++i) { pv[i] = __builtin_amdgcn_exp2f(S[s][2 * kk][i] - M2); pv[4 + i] = __builtin_amdgcn_exp2f(S[s][2 * kk + 1][i] - M2); }
#pragma unroll
                for (int i = 0; i < 8; ++i) lsum[s] += pv[i];
                union { uint4 u; bf16x8 v; } cv; cv.u.x = pack2(pv[0], pv[1]); cv.u.y = pack2(pv[2], pv[3]); cv.u.z = pack2(pv[4], pv[5]); cv.u.w = pack2(pv[6], pv[7]);
                pb[s][kk] = cv.v; }
#pragma unroll
        for (int ds = 0; ds < 4; ++ds)
#pragma unroll
            for (int kk = 0; kk < 2; ++kk) { const bf16_t* vp = Vs + (ds * 16 + fr) * 72 + kk * 32 + quad * 4;
                const uint2 lo = *(const uint2*)vp, hi = *(const uint2*)(vp + 16);
                union { uint4 u; bf16x8 v; } cv; cv.u.x = lo.x; cv.u.y = lo.y; cv.u.z = hi.x; cv.u.w = hi.y;
                O[0][ds] = mfma16(cv.v, pb[0][kk], O[0][ds]); O[1][ds] = mfma16(cv.v, pb[1][kk], O[1][ds]); }
    }
#pragma unroll
    for (int s = 0; s < 2; ++s) { lsum[s] += __shfl_xor(lsum[s], 16); lsum[s] += __shfl_xor(lsum[s], 32); }
    const int pp = pq0 + fr;
    const size_t row = pp < CTX ? (size_t)MLAT + b * CTX + pp : (size_t)b * SEQ + (pp - CTX);
    bf16_t* cat = (bf16_t*)(opaque_ws(P) + WS_CAT);
    if (!DIFF) {
#pragma unroll
        for (int s = 0; s < 2; ++s) { const float inv = 1.f / lsum[s]; bf16_t* op = cat + row * D + 256 + (2 * hsel + s) * 64 + quad * 4;
#pragma unroll
            for (int ds = 0; ds < 4; ++ds) *(uint2*)(op + ds * 16) = pack4(O[s][ds] * inv); }
    } else {
        const float* lp = P.in[26] + l * 128;
        float a = lane < 32 ? lp[lane] * lp[32 + lane] : 0.f, c = lane < 32 ? lp[64 + lane] * lp[96 + lane] : 0.f; a = wave_sum(a); c = wave_sum(c);
        const float lam_init = 0.8f - 0.6f * expf(-0.3f * (float)l);
        const float lam = expf(a) - expf(c) + lam_init;
        const float i0 = 1.f / lsum[0], i1 = lam / lsum[1];
        f32x4 o[4]; float ss = 0.f;
#pragma unroll
        for (int ds = 0; ds < 4; ++ds) { o[ds] = O[0][ds] * i0 - O[1][ds] * i1; ss += o[ds][0] * o[ds][0] + o[ds][1] * o[ds][1] + o[ds][2] * o[ds][2] + o[ds][3] * o[ds][3]; }
        ss += __shfl_xor(ss, 16); ss += __shfl_xor(ss, 32);
        const float fac = rsqrtf(ss * (1.f / 64.f) + 1e-6f) * (1.f - lam_init);
        const float* sg = P.in[27] + l * 64;
        bf16_t* op = cat + row * D + 768 + hsel * 64 + quad * 4;
#pragma unroll
        for (int ds = 0; ds < 4; ++ds) { const f32x4 gg = *(const f32x4*)(sg + ds * 16 + quad * 4); *(uint2*)(op + ds * 16) = pack4(o[ds] * gg * fac); }
    }
}

DEVI void hy_build_E(const float* __restrict__ hsrc, float norm, int L, bf16_t* E, int NG) {
    const int lo = L / 2, hi = 3 * L / 2 - 1;
    for (int idx = threadIdx.x; idx < 8 * NG; idx += 512) { const int r = idx / NG, m = idx - r * NG; const int i0 = 8 * m + r;
        float v[8];
#pragma unroll
        for (int e = 0; e < 8; ++e) { const int i = i0 + e; v[e] = (i >= lo && i <= hi) ? hsrc[hi - i] * norm : 0.f; }
        uint4 o; o.x = pack2(v[0], v[1]); o.y = pack2(v[2], v[3]); o.z = pack2(v[4], v[5]); o.w = pack2(v[6], v[7]);
        *(uint4*)(E + ((size_t)r * NG + m) * 8) = o; }
}
DEVI f32x4 hy_conv(const bf16_t* E, int NG, const bf16_t* Us, int ustride, int L, int mt, int fr, int quad) {
    const int t0 = mt * 16;
    int jlo = t0 - L / 2 + 1; jlo = jlo < 0 ? 0 : (jlo & ~31);
    int jhi = (t0 + 16 + L / 2 + 31) & ~31; jhi = jhi > L ? L : jhi;
    const bf16_t* Er = E + (size_t)(7 - (fr & 7)) * NG * 8;
    const bf16_t* ub = Us + (fr & 7) * ustride + quad * 8;
    const int ob = quad * 8 - t0 - fr + L - 1;
    f32x4 acc = (f32x4){0.f, 0.f, 0.f, 0.f};
    for (int jb = jlo; jb < jhi; jb += 32) { const int m = (jb + ob) >> 3;
        const bf16x8 a = *(const bf16x8*)(Er + (size_t)m * 8); const bf16x8 bv = *(const bf16x8*)(ub + jb);
        acc = mfma16(a, bv, acc); }
    return acc;
}
DEVI void hy_item(const Params& P, int l, int c, int Lsel, unsigned char* smem) {
    const int tid = opaque_tid(), lane = tid & 63, wid = tid >> 6, fr = lane & 15, quad = lane >> 4;
    const int L = Lsel ? CTX : SEQ; const int NG = L / 4 + 2; const int ustride = L + 8;
    bf16_t* E = (bf16_t*)(smem + 1024); bf16_t* Us = E + (size_t)8 * NG * 8; bf16_t* Zs = Us + 8 * ustride;
    const float* hfs = (const float*)(opaque_ws(P) + WS_HFS) + (size_t)l * 36 * 512;
    float s0 = 0.f, s1 = 0.f;
    { const int tlo = Lsel ? 32 : 0, thi = Lsel ? 36 : 32; for (int t = tlo; t < thi; ++t) { s0 += hfs[t * 512 + c]; s1 += hfs[t * 512 + 256 + c]; } }
    const float* hf = (const float*)(opaque_ws(P) + WS_HF) + (size_t)l * HF_LAYER + (Lsel ? (size_t)512 * SEQ : 0);
    const bf16_t* hyu = (const bf16_t*)(opaque_ws(P) + WS_HYU); bf16_t* hyo = (bf16_t*)(opaque_ws(P) + WS_HYO);
    hy_build_E(hf + (size_t)c * L, 1.f / s0, L, E, NG);
    { const int nch = L / 8; for (int idx = tid; idx < 8 * nch; idx += 512) { const int bb = idx / nch, ch = idx - bb * nch;
          const size_t base = Lsel ? (size_t)MLAT + bb * CTX : (size_t)bb * SEQ;
          *(uint4*)(Us + bb * ustride + ch * 8) = *(const uint4*)(hyu + (size_t)c * MT + base + ch * 8); } }
    __syncthreads();
    const float sk0 = P.in[24][(size_t)l * 512 + c], sk1 = P.in[24][(size_t)l * 512 + 256 + c];
    const size_t baseb = Lsel ? (size_t)MLAT + (fr & 7) * CTX : (size_t)(fr & 7) * SEQ;
    for (int mt = wid; mt < L / 16; mt += 8) { const f32x4 acc = hy_conv(E, NG, Us, ustride, L, mt, fr, quad);
        if (fr < 8) { const int t = mt * 16 + quad * 4;
            const uint2 v4 = *(const uint2*)(Us + fr * ustride + t); const uint2 x4 = *(const uint2*)(hyu + (size_t)(256 + c) * MT + baseb + t);
            f32x4 z; z[0] = bflo(x4.x) * (acc[0] + sk0 * bflo(v4.x)); z[1] = bfhi(x4.x) * (acc[1] + sk0 * bfhi(v4.x));
            z[2] = bflo(x4.y) * (acc[2] + sk0 * bflo(v4.y)); z[3] = bfhi(x4.y) * (acc[3] + sk0 * bfhi(v4.y));
            *(uint2*)(Zs + fr * ustride + t) = pack4(z); } }
    __syncthreads();
    hy_build_E(hf + (size_t)(256 + c) * L, 1.f / s1, L, E, NG);
    __syncthreads();
    for (int mt = wid; mt < L / 16; mt += 8) { const f32x4 acc = hy_conv(E, NG, Zs, ustride, L, mt, fr, quad);
        if (fr < 8) { const int t = mt * 16 + quad * 4;
            const uint2 v4 = *(const uint2*)(Zs + fr * ustride + t); const uint2 x4 = *(const uint2*)(hyu + (size_t)(512 + c) * MT + baseb + t);
            f32x4 z; z[0] = bflo(x4.x) * (acc[0] + sk1 * bflo(v4.x)); z[1] = bfhi(x4.x) * (acc[1] + sk1 * bfhi(v4.x));
            z[2] = bflo(x4.y) * (acc[2] + sk1 * bflo(v4.y)); z[3] = bfhi(x4.y) * (acc[3] + sk1 * bfhi(v4.y));
            *(uint2*)(hyo + (size_t)c * MT + baseb + t) = pack4(z); } }
}

DEVI void ml_item(const Params& P, int l, int b, int hh, int dir, unsigned char* smem) {
    const int tid = opaque_tid(), lane = tid & 63; const int ty = tid >> 4, tx = tid & 15;
    float* qs = (float*)(smem + 1024); float* ks = qs + 64 * 65; float* vs = ks + 64 * 65; float* Cs = vs + 64 * 65; float* Ss = Cs + 64 * 65;
    float* ns = Ss + 64 * 65; float* bcum = ns + 64; float* aval = bcum + 64; float* mrow = aval + 64; float* winter = mrow + 64; float* wg = winter + 64;
    float* rowsum = wg + 64; float* nq = rowsum + 64; float* sc = nq + 64;
    const float* mlqk = (const float*)(opaque_ws(P) + WS_MLQK); const bf16_t* p = (const bf16_t*)(opaque_ws(P) + WS_P); const float* gates = (const float*)(opaque_ws(P) + WS_GATES);
    float* mlh = (float*)(opaque_ws(P) + WS_MLH) + (size_t)dir * MT * 256;
    float C[2][4];
#pragma unroll
    for (int i = 0; i < 2; ++i)
#pragma unroll
        for (int j = 0; j < 4; ++j) C[i][j] = 0.f;
    if (tid < 64) ns[tid] = 0.f;
    if (tid == 0) sc[0] = 0.f;
    __syncthreads();
#pragma unroll 1
    for (int seq = 0; seq < 2; ++seq) { const int Ls = seq ? SEQ : CTX; const size_t rowbase = seq ? (size_t)b * SEQ : (size_t)MLAT + b * CTX; const int nch = Ls / 64;
#pragma unroll 1
        for (int kk = 0; kk < nch; ++kk) {
            for (int idx = tid; idx < 64 * 16; idx += 512) { const int r = idx >> 4, c4 = (idx & 15) * 4; const int pos = dir ? Ls - 1 - (kk * 64 + r) : kk * 64 + r; const size_t row = rowbase + pos;
                const float4 qv = *(const float4*)(mlqk + row * 512 + hh * 64 + c4), kv = *(const float4*)(mlqk + row * 512 + 256 + hh * 64 + c4);
                const uint2 vv = *(const uint2*)(p + row * NP + 512 + hh * 64 + c4);
                float* qd = qs + r * 65 + c4; qd[0] = qv.x; qd[1] = qv.y; qd[2] = qv.z; qd[3] = qv.w;
                float* kd = ks + r * 65 + c4; kd[0] = kv.x; kd[1] = kv.y; kd[2] = kv.z; kd[3] = kv.w;
                float* vd = vs + r * 65 + c4; vd[0] = bflo(vv.x); vd[1] = bfhi(vv.x); vd[2] = bflo(vv.y); vd[3] = bfhi(vv.y); }
            if (tid < 64) { const int r = tid; const int pos = dir ? Ls - 1 - (kk * 64 + r) : kk * 64 + r; const size_t row = rowbase + pos;
                const float* gp = gates + row * 16 + dir * 8 + hh; const float gi = gp[0], gf = gp[4];
                float bsum = logsigmoid(gf);
#pragma unroll
                for (int o = 1; o < 64; o <<= 1) { const float t = __shfl_up(bsum, o); if (lane >= o) bsum += t; }
                const float a = gi - bsum; float pm = a;
#pragma unroll
                for (int o = 1; o < 64; o <<= 1) { const float t = __shfl_up(pm, o); if (lane >= o) pm = fmaxf(pm, t); }
                const float m = sc[0]; const float mt = bsum + fmaxf(m, pm);
                bcum[r] = bsum; aval[r] = a; mrow[r] = mt; winter[r] = expf(bsum + m - mt);
                const float bend = __shfl(bsum, 63), pmend = __shfl(pm, 63); const float mnew = bend + fmaxf(m, pmend);
                wg[r] = expf(bend + a - mnew);
                if (r == 0) { sc[1] = expf(bend + m - mnew); sc[2] = mnew; } }
#pragma unroll
            for (int i = 0; i < 2; ++i)
#pragma unroll
                for (int j = 0; j < 4; ++j) Cs[(2 * ty + i) * 65 + 4 * tx + j] = C[i][j];
            __syncthreads();
            { float acc[2][4];
#pragma unroll
              for (int i = 0; i < 2; ++i)
#pragma unroll
                  for (int j = 0; j < 4; ++j) acc[i][j] = 0.f;
#pragma unroll 4
              for (int e = 0; e < 64; ++e) { const float q0 = qs[(2 * ty) * 65 + e], q1 = qs[(2 * ty + 1) * 65 + e];
#pragma unroll
                  for (int j = 0; j < 4; ++j) { const float kx = ks[(4 * tx + j) * 65 + e]; acc[0][j] += q0 * kx; acc[1][j] += q1 * kx; } }
              float rs[2] = {0.f, 0.f};
#pragma unroll
              for (int i = 0; i < 2; ++i) { const int t = 2 * ty + i; const float bt = bcum[t] - mrow[t];
#pragma unroll
                  for (int j = 0; j < 4; ++j) { const int s = 4 * tx + j; const float v = s <= t ? acc[i][j] * expf(bt + aval[s]) : 0.f; Ss[t * 65 + s] = v; rs[i] += v; } }
#pragma unroll
              for (int i = 0; i < 2; ++i) { float v = rs[i]; v += __shfl_xor(v, 1); v += __shfl_xor(v, 2); v += __shfl_xor(v, 4); v += __shfl_xor(v, 8); if (tx == 0) rowsum[2 * ty + i] = v; } }
            if (tid < 64) { float s = 0.f;
#pragma unroll 8
                for (int e = 0; e < 64; ++e) s += ns[e] * qs[tid * 65 + e];
                nq[tid] = s; }
            __syncthreads();
            { float acc[2][4], acc2[2][4];
#pragma unroll
              for (int i = 0; i < 2; ++i)
#pragma unroll
                  for (int j = 0; j < 4; ++j) { acc[i][j] = 0.f; acc2[i][j] = 0.f; }
#pragma unroll 4
              for (int e = 0; e < 64; ++e) { const float q0 = qs[(2 * ty) * 65 + e], q1 = qs[(2 * ty + 1) * 65 + e];
#pragma unroll
                  for (int j = 0; j < 4; ++j) { const float cx = Cs[(4 * tx + j) * 65 + e]; acc[0][j] += q0 * cx; acc[1][j] += q1 * cx; } }
#pragma unroll 4
              for (int s = 0; s < 64; ++s) { const float s0 = Ss[(2 * ty) * 65 + s], s1 = Ss[(2 * ty + 1) * 65 + s];
#pragma unroll
                  for (int j = 0; j < 4; ++j) { const float vx = vs[s * 65 + 4 * tx + j]; acc2[0][j] += s0 * vx; acc2[1][j] += s1 * vx; } }
#pragma unroll
              for (int i = 0; i < 2; ++i) { const int t = 2 * ty + i; const float wi = winter[t]; const float den = wi * nq[t] + rowsum[t];
                  const float inv = 1.f / fmaxf(fabsf(den), expf(-mrow[t]));
                  const int pos = dir ? Ls - 1 - (kk * 64 + t) : kk * 64 + t; const size_t row = rowbase + pos;
                  float4 o; o.x = (wi * acc[i][0] + acc2[i][0]) * inv; o.y = (wi * acc[i][1] + acc2[i][1]) * inv; o.z = (wi * acc[i][2] + acc2[i][2]) * inv; o.w = (wi * acc[i][3] + acc2[i][3]) * inv;
                  *(float4*)(mlh + row * 256 + hh * 64 + 4 * tx) = o; } }
            { const float wc = sc[1]; float acc[2][4];
#pragma unroll
              for (int i = 0; i < 2; ++i)
#pragma unroll
                  for (int j = 0; j < 4; ++j) acc[i][j] = 0.f;
#pragma unroll 4
              for (int s = 0; s < 64; ++s) { const float w = wg[s]; const float v0 = vs[s * 65 + 2 * ty] * w, v1 = vs[s * 65 + 2 * ty + 1] * w;
#pragma unroll
                  for (int j = 0; j < 4; ++j) { const float kx = ks[s * 65 + 4 * tx + j]; acc[0][j] += v0 * kx; acc[1][j] += v1 * kx; } }
#pragma unroll
              for (int i = 0; i < 2; ++i)
#pragma unroll
                  for (int j = 0; j < 4; ++j) C[i][j] = wc * C[i][j] + acc[i][j]; }
            __syncthreads();
            if (tid < 64) { float s = 0.f;
#pragma unroll 8
                for (int s2 = 0; s2 < 64; ++s2) s += wg[s2] * ks[s2 * 65 + tid];
                ns[tid] = sc[1] * ns[tid] + s; }
            __syncthreads();
            if (tid == 0) sc[0] = sc[2];
            __syncthreads();
        } }
}

constexpr int MX_ML = 64, MX_HYL = 256, MX_GQAL = 256, MX_DIFL = 512, MX_GQAC = 32, MX_DIFC = 64, MX_HYC = 256;
constexpr int MX_TOTAL = MX_ML + MX_HYL + MX_GQAL + MX_DIFL + MX_GQAC + MX_DIFC + MX_HYC;

DEVI void mixer_phase(const Params& P, int l, unsigned char* smem) {
    unsigned* ctr = (unsigned*)(opaque_ws(P) + WS_CTL) + l;
    int* s_item = (int*)smem;
    for (;;) {
        __syncthreads();
        if (threadIdx.x == 0) *s_item = (int)atomicAdd(ctr, 1u);
        __syncthreads();
        int it = *s_item;
        if (it >= MX_TOTAL) break;
        if (it < MX_ML) { ml_item(P, l, it >> 3, (it >> 1) & 3, it & 1, smem); continue; } it -= MX_ML;
        if (it < MX_HYL) { hy_item(P, l, it, 0, smem); continue; } it -= MX_HYL;
        if (it < MX_GQAL) { attn_item<false>(P, l, it >> 5, (it >> 4) & 1, it & 15, false, smem); continue; } it -= MX_GQAL;
        if (it < MX_DIFL) { attn_item<true>(P, l, it >> 6, (it >> 4) & 3, it & 15, false, smem); continue; } it -= MX_DIFL;
        if (it < MX_GQAC) { attn_item<false>(P, l, it >> 2, (it >> 1) & 1, it & 1, true, smem); continue; } it -= MX_GQAC;
        if (it < MX_DIFC) { attn_item<true>(P, l, it >> 3, (it >> 1) & 3, it & 1, true, smem); continue; } it -= MX_DIFC;
        hy_item(P, l, it, 1, smem);
    }
}

DEVI void final_phase(const Params& P, int l, unsigned char* smem) {
    const int tid = opaque_tid();
    const float* mlh0 = (const float*)(opaque_ws(P) + WS_MLH); const float* mlh1 = mlh0 + (size_t)MT * 256;
    const bf16_t* p = (const bf16_t*)(opaque_ws(P) + WS_P); const bf16_t* hyo = (const bf16_t*)(opaque_ws(P) + WS_HYO);
    bf16_t* cat = (bf16_t*)(opaque_ws(P) + WS_CAT);
    const float* ng = P.in[14] + (size_t)l * 256;
    bf16_t* lt = (bf16_t*)(smem + 1024);
    for (int rt = opaque_bid(); rt < MT / 64; rt += gridDim.x) { const int row0 = rt * 64;
        for (int task = tid; task < 64 * 64; task += 512) { const int r = task >> 6, c4 = (task & 63) * 4; const size_t row = row0 + r;
            const float4 a = *(const float4*)(mlh0 + row * 256 + c4), bq = *(const float4*)(mlh1 + row * 256 + c4);
            float4 h; h.x = a.x + bq.x; h.y = a.y + bq.y; h.z = a.z + bq.z; h.w = a.w + bq.w;
            float ss = h.x * h.x + h.y * h.y + h.z * h.z + h.w * h.w;
            ss += __shfl_xor(ss, 1); ss += __shfl_xor(ss, 2); ss += __shfl_xor(ss, 4); ss += __shfl_xor(ss, 8);
            const float rstd = rsqrtf(ss * (1.f / 64.f) + 1e-6f);
            const float4 g4 = *(const float4*)(ng + c4);
            const uint2 ov = *(const uint2*)(p + row * NP + 768 + c4);
            f32x4 y; y[0] = h.x * rstd * g4.x * sigmoid_fast(bflo(ov.x)); y[1] = h.y * rstd * g4.y * sigmoid_fast(bfhi(ov.x));
            y[2] = h.z * rstd * g4.z * sigmoid_fast(bflo(ov.y)); y[3] = h.w * rstd * g4.w * sigmoid_fast(bfhi(ov.y));
            *(uint2*)(cat + row * D + c4) = pack4(y); }
        for (int task = tid; task < 256 * 8; task += 512) { const int c = task >> 3, ch = task & 7;
            const uint4 v = *(const uint4*)(hyo + (size_t)c * MT + row0 + ch * 8);
            bf16_t* d = lt + (size_t)(ch * 8) * 264 + c;
            d[0] = (bf16_t)(v.x & 0xffff); d[264] = (bf16_t)(v.x >> 16); d[528] = (bf16_t)(v.y & 0xffff); d[792] = (bf16_t)(v.y >> 16);
            d[1056] = (bf16_t)(v.z & 0xffff); d[1320] = (bf16_t)(v.z >> 16); d[1584] = (bf16_t)(v.w & 0xffff); d[1848] = (bf16_t)(v.w >> 16); }
        __syncthreads();
        for (int task = tid; task < 64 * 32; task += 512) { const int r = task >> 5, c8 = (task & 31) * 8;
            *(uint4*)(cat + (size_t)(row0 + r) * D + 512 + c8) = *(const uint4*)(lt + (size_t)r * 264 + c8); }
        __syncthreads();
    }
}

__global__ void __launch_bounds__(512) mega_fwd(Params P) {
    extern __shared__ __attribute__((aligned(16))) unsigned char smem[];
    cg::grid_group grid = cg::this_grid();
#if !(SKIPMASK & 1)
    phase0(P, smem);
#endif
    grid.sync();
    bf16_t* A = (bf16_t*)(opaque_ws(P) + WS_A); bf16_t* HID = (bf16_t*)(opaque_ws(P) + WS_HID); bf16_t* Pp = (bf16_t*)(opaque_ws(P) + WS_P); bf16_t* CAT = (bf16_t*)(opaque_ws(P) + WS_CAT);
    float* hctx = (float*)(opaque_ws(P) + WS_HCTX);
#pragma unroll 1
    for (int l = 0; l < DEPTH; ++l) {
        const float* modl = (const float*)(opaque_ws(P) + WS_MOD) + (size_t)l * 9 * 9216;
#pragma unroll 1
        for (int f = 0; f < 2; ++f) {
            if (f == 1) {
#if !(SKIPMASK & 2)
                norm_phase<true>(P, l, 1, smem);
#endif
                grid.sync();
#if !(GM & 1)
                { EpiP E; E.Pp = Pp; run_gemm(smem, A, (const bf16_t*)(opaque_ws(P) + WS_WIN) + (size_t)l * NP * 1024, NP, 1024, E); }
#endif
                grid.sync();
#if !(SKIPMASK & 4)
                prep_phase(P, l, smem);
#endif
                grid.sync();
#if !(SKIPMASK & 8)
                mixer_phase(P, l, smem);
#endif
                grid.sync();
#if !(SKIPMASK & 16)
                final_phase(P, l, smem);
#endif
                grid.sync();
#if !(GM & 2)
                { EpiResid E; E.hl = P.out; E.hc = hctx; E.gate = modl + 5 * 1024; E.fac = 1.f; run_gemm(smem, CAT, (const bf16_t*)(opaque_ws(P) + WS_WOUT) + (size_t)l * 1024 * 1024, 1024, 1024, E); }
#endif
                grid.sync();
            }
#if !(SKIPMASK & 32)
            norm_phase<false>(P, l, f == 0 ? 0 : 2, smem);
#endif
            grid.sync();
#if !(GM & 4)
            { EpiSwiglu E; E.H = HID; run_gemm(smem, A, (const bf16_t*)(opaque_ws(P) + WS_W13) + (size_t)(l * 2 + f) * 5632 * 1024, 5632, 1024, E); }
#endif
            grid.sync();
#if !(GM & 8)
            { EpiResid E; E.hl = P.out; E.hc = hctx; E.gate = modl + (f == 0 ? 2 : 8) * 1024; E.fac = 0.5f; run_gemm(smem, HID, (const bf16_t*)(opaque_ws(P) + WS_W2) + (size_t)(l * 2 + f) * 1024 * 2816, 1024, 2816, E); }
#endif
            grid.sync();
        }
    }
}

extern "C" void kernel_launch(void* const* d_in, const int* in_sizes, int n_in, void* d_out, int out_size, void* d_ws, size_t ws_size, hipStream_t stream) {
    static int grid_blocks = 0;
    if (grid_blocks == 0) {
        if (n_in != 28 || ws_size < WS_END) { fprintf(stderr, "kernel_launch: unexpected n_in %d or ws_size %zu (need %zu)\n", n_in, ws_size, (size_t)WS_END); grid_blocks = -1; return; }
        int dev = 0, cus = 0, per_cu = 0;
        hipGetDevice(&dev);
        hipDeviceGetAttribute(&cus, hipDeviceAttributeMultiprocessorCount, dev);
        if (hipFuncSetAttribute((const void*)mega_fwd, hipFuncAttributeMaxDynamicSharedMemorySize, LDS_BYTES) != hipSuccess) { fprintf(stderr, "kernel_launch: hipFuncSetAttribute failed\n"); }
        if (hipOccupancyMaxActiveBlocksPerMultiprocessor(&per_cu, (const void*)mega_fwd, 512, LDS_BYTES) != hipSuccess || per_cu < 1) { fprintf(stderr, "kernel_launch: occupancy query gave %d\n", per_cu); per_cu = 1; }
        (void)hipGetLastError();
        grid_blocks = cus * per_cu;
    }
    if (grid_blocks < 0) return;
    Params p{};
    for (int i = 0; i < 28; ++i) p.in[i] = (const float*)d_in[i];
    p.out = (float*)d_out; p.ws = (unsigned char*)d_ws;
    void* args[] = {&p};
    hipError_t e = hipLaunchCooperativeKernel((const void*)mega_fwd, dim3(grid_blocks), dim3(512), args, LDS_BYTES, stream);
    if (e != hipSuccess) fprintf(stderr, "cooperative launch failed: %s (grid %d)\n", hipGetErrorString(e), grid_blocks);
}
```

```cpp
#define REPSTEP -1
#include <hip/hip_runtime.h>
#include <hip/hip_cooperative_groups.h>
#include <cstdio>
namespace cg = cooperative_groups;
__device__ __forceinline__ int opaque_tid() { int t = threadIdx.x; asm volatile("" : "+v"(t)); return t; }
__device__ __forceinline__ int opaque_bid() { int b = blockIdx.x; asm volatile("" : "+s"(b)); return b; }
namespace pg8 {
#define PG8_LAS __attribute__((address_space(3)))
typedef unsigned short bf16_t;
typedef short bf16x8 __attribute__((ext_vector_type(8)));
typedef float f32x4 __attribute__((ext_vector_type(4)));
typedef unsigned u32x4 __attribute__((ext_vector_type(4)));
constexpr int BM = 256, BK = 64, HALF = 128, HTB = HALF * BK * 2  , STAGE_BYTES = 8 * HTB, NXCD = 8, WGM = 8;

__host__ __device__ __forceinline__ int lds_byte(int r, int c) { const int st = (r >> 4) * 2 + (c >> 5), rr = r & 15, cc = c & 31, ob = rr * 64 + cc * 2; return st * 1024 + (ob ^ (((ob >> 9) & 1) << 5)); }
__host__ __device__ __forceinline__ void stage_rc(int b, int& R, int& C) { const int st = b / 1024, sb = b % 1024, swz = sb ^ (((sb >> 9) & 1) << 5); R = (st >> 1) * 16 + swz / 64; C = (st & 1) * 32 + (swz % 64) / 2; }
__host__ __device__ __forceinline__ int perm32(int rho) { const int n = rho >> 4, i = rho & 15; return 8 * (i >> 2) + 4 * n + (i & 3); }

struct Unit { int pm, pn, kp; };
struct Gemm { const bf16_t* A; const bf16_t* Bt; int M, N, K, ld; };

struct StaticOrder {
    int nM, nN, nwg, G, c;
    __host__ __device__ void init(int M, int N, int G_, int c_) { nM = M / BM; nN = N / BM; nwg = nM * nN; G = G_; c = c_; }
    __host__ __device__ bool next(int i, Unit& u) const { return at((long)i * G + c, u); }
    __host__ __device__ bool at(const long L, Unit& u) const {
        if (L >= nwg) return false;
        int wgid = (int)L; { const int q = nwg / NXCD, r = nwg % NXCD, xcd = wgid % NXCD, off = wgid / NXCD; wgid = (xcd < r ? xcd * (q + 1) : r * (q + 1) + (xcd - r) * q) + off; }
        const int nig = WGM * nN, gid = wgid / nig, fm = gid * WGM, gsz = (nM - fm) < WGM ? (nM - fm) : WGM;
        u.pm = fm + ((wgid % nig) % gsz); u.pn = (wgid % nig) / gsz; u.kp = 0; return true;
    }
    __device__ __forceinline__ void a_ready(const Unit&) const {}
    __device__ __forceinline__ void done(const Unit&) const {}
};
struct SplitOrder {
    int nN, nK, total, G, c;
    __host__ __device__ void init(int nM_, int nN_, int nK_, int G_, int c_) { nN = nN_; nK = nK_; total = nM_ * nN_ * nK_; G = G_; c = c_; }
    __host__ __device__ bool next(int i, Unit& u) const { const int L = i * G + c; if (L >= total) return false; u.kp = L % nK; const int r = L / nK; u.pn = r % nN; u.pm = r / nN; return true; }
    __device__ __forceinline__ void a_ready(const Unit&) const {}
    __device__ __forceinline__ void done(const Unit&) const {}
};
__device__ __forceinline__ unsigned cvt_pk_bf16(float lo, float hi) { unsigned r; asm volatile("v_cvt_pk_bf16_f32 %0, %1, %2" : "=v"(r) : "v"(lo), "v"(hi)); return r; }
template <class Epi, class Sched, bool STAMP = false>
__device__ __forceinline__ void gemm_phase(PG8_LAS unsigned char* lds, const Gemm g, const Sched& S, const Epi& E, unsigned long long* stamps) {
    const int tid = opaque_tid(), wid = __builtin_amdgcn_readfirstlane(tid >> 6), lane = tid & 63, wr = wid >> 2, wc = wid & 3, fr = lane & 15, fq = lane >> 4;
    const int K = g.K, LD = g.ld, nt = K / BK;
    int ts_lo = 0, ts_hi = 0, nts = 0; const unsigned long long rt_entry = STAMP ? (unsigned long long)wall_clock64() : 0ull;
#define PG8_STAMP() do { if (STAMP && wid == 0 && nts < 64) { const unsigned long long _c = (unsigned long long)clock64(); \
        ts_lo = (lane == nts) ? (int)(unsigned)_c : ts_lo; ts_hi = (lane == nts) ? (int)(unsigned)(_c >> 32) : ts_hi; ++nts; } } while (0)
    PG8_STAMP();
    unsigned voffA[2], voffB[2];
#pragma unroll
    for (int i = 0; i < 2; ++i) { int R, C; stage_rc(tid * 16 + i * 8192, R, C); const int Rb = Epi::PERM ? ((R & ~31) + perm32(R & 31)) : R;
        voffA[i] = (unsigned)(R * LD + C) * 2u; voffB[i] = (unsigned)(Rb * LD + C) * 2u; }
    const size_t kstep = (size_t)(BK * 2);
    const size_t hstep = (size_t)HALF * LD * 2; const size_t kpstep = (size_t)K * 2;
    const size_t tstep = 2 * hstep;
    const unsigned ldsw = (unsigned)wid * 1024u;
    const int aoff = lds_byte(wr * 64 + fr, fq * 8), boff = lds_byte(wc * 32 + fr, fq * 8);
#define PG8_SA(b, h) (((b) * 2 + (h)) * HTB)
#define PG8_SB(b, h) ((4 + (b) * 2 + (h)) * HTB)
#define PG8_STAGE(bufoff, gbase, voff) do { _Pragma("unroll") for (int _i = 0; _i < 2; ++_i) \
        __builtin_amdgcn_global_load_lds((const unsigned*)((const char*)(gbase) + (voff)[_i]), (PG8_LAS unsigned*)(lds + (bufoff) + ldsw + _i * 8192), 16, 0, 0); } while (0)
#define PG8_LDA(dst, b, h) do { _Pragma("unroll") for (int m = 0; m < 4; ++m) _Pragma("unroll") for (int k = 0; k < 2; ++k) dst[m][k] = *(const PG8_LAS bf16x8*)(lds + PG8_SA(b, h) + aoff + m * 2048 + k * 1024); } while (0)
#define PG8_LDB(dst, b, h) do { _Pragma("unroll") for (int n = 0; n < 2; ++n) _Pragma("unroll") for (int k = 0; k < 2; ++k) dst[n][k] = *(const PG8_LAS bf16x8*)(lds + PG8_SB(b, h) + boff + n * 2048 + k * 1024); } while (0)
#define PG8_MMA(ai, bj, At, Bt) do { __builtin_amdgcn_s_setprio(1); _Pragma("unroll") for (int m = 0; m < 4; ++m) _Pragma("unroll") for (int n = 0; n < 2; ++n) _Pragma("unroll") for (int k = 0; k < 2; ++k) \
        acc[ai][bj][m][n] = __builtin_amdgcn_mfma_f32_16x16x32_bf16(Bt[n][k], At[m][k], acc[ai][bj][m][n], 0, 0, 0); __builtin_amdgcn_s_setprio(0); } while (0)
#define PG8_WAIT_V(n) asm volatile("s_waitcnt vmcnt(" #n ")" ::: "memory")
#define PG8_WAIT_L(n) asm volatile("s_waitcnt lgkmcnt(" #n ")" ::: "memory")
#define PG8_BAR __builtin_amdgcn_s_barrier()
#define PG8_SCHED __builtin_amdgcn_sched_barrier(0)
    Unit cur, nxt; int ui = 0;
    if (!S.next(0, cur)) return;
    f32x4 acc[2][2][4][2];
#pragma unroll
    for (int a = 0; a < 2; ++a)
#pragma unroll
        for (int b = 0; b < 2; ++b)
#pragma unroll
            for (int m = 0; m < 4; ++m)
#pragma unroll
                for (int n = 0; n < 2; ++n) acc[a][b][m][n] = (f32x4){0.f, 0.f, 0.f, 0.f};
    bf16x8 At[4][2], B0[2][2], B1[2][2];
    const char* cA = (const char*)g.A + (size_t)cur.pm * tstep + (size_t)cur.kp * kpstep; const char* cB = (const char*)g.Bt + (size_t)cur.pn * tstep + (size_t)cur.kp * kpstep;
    S.a_ready(cur);
    PG8_STAGE(PG8_SB(0, 0), cB, voffB); PG8_STAGE(PG8_SA(0, 0), cA, voffA); PG8_STAGE(PG8_SB(0, 1), cB + hstep, voffB); PG8_STAGE(PG8_SA(0, 1), cA + hstep, voffA);
    if (wr == 1) PG8_BAR;
    PG8_WAIT_V(4); PG8_BAR;
    PG8_STAGE(PG8_SB(1, 0), cB + kstep, voffB); PG8_STAGE(PG8_SA(1, 0), cA + kstep, voffA); PG8_STAGE(PG8_SB(1, 1), cB + hstep + kstep, voffB);
    PG8_WAIT_V(6); PG8_BAR;
    PG8_STAMP();
    for (;;) {
        const bool has_next = S.next(ui + 1, nxt);
        const char* nA = has_next ? (const char*)g.A + (size_t)nxt.pm * tstep + (size_t)nxt.kp * kpstep : cA; const char* nB = has_next ? (const char*)g.Bt + (size_t)nxt.pn * tstep + (size_t)nxt.kp * kpstep : cB;
        for (int t = 0; t < nt; t += 2) {
            const bool last = (t == nt - 2);
            const char* a1 = cA + (size_t)(t + 1) * kstep;
            const char* a2 = last ? nA : cA + (size_t)(t + 2) * kstep; const char* b2 = last ? nB : cB + (size_t)(t + 2) * kstep;
            const char* a3 = a2 + kstep; const char* b3 = b2 + kstep;
            if (last && has_next) S.a_ready(nxt);
            PG8_LDB(B0, 0, 0); PG8_SCHED; PG8_LDA(At, 0, 0); PG8_STAGE(PG8_SA(1, 1), a1 + hstep, voffA);
            PG8_WAIT_L(8); PG8_BAR; PG8_WAIT_L(0); PG8_MMA(0, 0, At, B0); PG8_BAR; PG8_SCHED;
            PG8_LDB(B1, 0, 1); PG8_STAGE(PG8_SB(0, 0), b2, voffB);
            PG8_BAR; PG8_WAIT_L(0); PG8_MMA(0, 1, At, B1); PG8_BAR;
            PG8_LDA(At, 0, 1); PG8_STAGE(PG8_SA(0, 0), a2, voffA);
            PG8_BAR; PG8_WAIT_L(0); PG8_MMA(1, 0, At, B0); PG8_BAR; PG8_SCHED;
            PG8_STAGE(PG8_SB(0, 1), b2 + hstep, voffB);
            PG8_WAIT_V(6); PG8_BAR; PG8_MMA(1, 1, At, B1); PG8_BAR;
            PG8_LDB(B0, 1, 0); PG8_SCHED; PG8_LDA(At, 1, 0); PG8_STAGE(PG8_SA(0, 1), a2 + hstep, voffA);
            PG8_WAIT_L(8); PG8_BAR; PG8_WAIT_L(0); PG8_MMA(0, 0, At, B0); PG8_BAR; PG8_SCHED;
            PG8_LDB(B1, 1, 1); PG8_STAGE(PG8_SB(1, 0), b3, voffB);
            PG8_BAR; PG8_WAIT_L(0); PG8_MMA(0, 1, At, B1); PG8_BAR;
            PG8_LDA(At, 1, 1); PG8_STAGE(PG8_SA(1, 0), a3, voffA);
            PG8_BAR; PG8_WAIT_L(0); PG8_MMA(1, 0, At, B0); PG8_BAR; PG8_SCHED;
            PG8_STAGE(PG8_SB(1, 1), b3 + hstep, voffB);
            PG8_WAIT_V(6); PG8_BAR; PG8_MMA(1, 1, At, B1); PG8_BAR;
        }
        PG8_STAMP();
#ifdef PROBE_EPI
        const unsigned long long pe0 = __builtin_amdgcn_s_memrealtime();
#endif
        if constexpr (!Epi::AFTER_DRAIN) { E(acc, cur, nxt, has_next, wr, wc, fr, fq); S.done(cur); }
#ifdef PROBE_EPI
        asm volatile("s_waitcnt vmcnt(0)" ::: "memory");
        if (tid == 0) { *(volatile PG8_LAS unsigned*)(lds - 1024 + 32) += (unsigned)(__builtin_amdgcn_s_memrealtime() - pe0); }
#endif
        PG8_STAMP();
        if (!has_next) break;
#pragma unroll
        for (int a = 0; a < 2; ++a)
#pragma unroll
            for (int b = 0; b < 2; ++b)
#pragma unroll
                for (int m = 0; m < 4; ++m)
#pragma unroll
                    for (int n = 0; n < 2; ++n) acc[a][b][m][n] = (f32x4){0.f, 0.f, 0.f, 0.f};
        cur = nxt; cA = nA; cB = nB; ++ui;
    }
    PG8_WAIT_V(0);
    if (wr == 0) PG8_BAR;
    PG8_BAR;
    if constexpr (Epi::AFTER_DRAIN) { E.fused(acc, cur, wr, wc, fr, fq, lds, wid, lane); S.done(cur); }
    PG8_STAMP();
    if (STAMP && wid == 0) { stamps[lane] = lane < nts ? (((unsigned long long)(unsigned)ts_hi << 32) | (unsigned)ts_lo) : 0ull;
        if (lane == 62) stamps[62] = rt_entry; if (lane == 63) stamps[63] = (unsigned long long)wall_clock64(); }
#undef PG8_STAMP
#undef PG8_SA
#undef PG8_SB
#undef PG8_STAGE
#undef PG8_LDA
#undef PG8_LDB
#undef PG8_MMA
#undef PG8_WAIT_V
#undef PG8_WAIT_L
#undef PG8_BAR
#undef PG8_SCHED
}
}

using pg8::bf16_t; using pg8::bf16x8; using pg8::f32x4;
#define DEVI __device__ __forceinline__
#define LAS3 __attribute__((address_space(3)))
#define G1 __attribute__((address_space(1)))

constexpr int D = 1024, NB = 8, SEQ = 2048, CTX = 256, DEPTH = 4, FF = 2816, NIN = 3088, NP = 3072, NPG = 3328;
constexpr int MLAT = NB * SEQ, MCTX = NB * CTX, MT = MLAT + MCTX, KEYS = CTX + SEQ;
constexpr float LOG2E = 1.4426950408889634f;
constexpr int LDS_BYTES = 160 * 1024;
#ifndef SKIPMASK
#define SKIPMASK 0
#endif
#ifndef GM
#define GM 0
#endif
#ifndef P0M
#define P0M 0
#endif

constexpr size_t al256(size_t x) { return (x + 255) & ~(size_t)255; }
constexpr size_t WS_CTL = 0;
constexpr size_t WS_BAR = 4096;
constexpr size_t WS_MOD = 4096 + 16384;
constexpr size_t WS_W13 = WS_MOD + al256((size_t)DEPTH * 9 * 9216 * 4);
constexpr size_t WS_W2 = WS_W13 + al256((size_t)DEPTH * 2 * 5632 * 1024 * 2);
constexpr size_t WS_WIN = WS_W2 + al256((size_t)DEPTH * 2 * 1024 * 2816 * 2);
constexpr size_t WS_WOUT = WS_WIN + al256((size_t)DEPTH * NPG * 1024 * 2);
constexpr size_t WS_HF = WS_WOUT + al256((size_t)DEPTH * 1024 * 1024 * 2);
constexpr size_t HF_LAYER = (size_t)512 * (SEQ + CTX);
constexpr size_t WS_HFS = WS_HF + al256((size_t)DEPTH * HF_LAYER * 4);
constexpr size_t WS_ROPEG = WS_HFS + al256((size_t)DEPTH * 36 * 512 * 4);
constexpr size_t WS_ROPED = WS_ROPEG + al256((size_t)SEQ * 64 * 4);
constexpr size_t WS_HCTX = WS_ROPED + al256((size_t)SEQ * 32 * 4);
constexpr size_t WS_A = WS_HCTX + al256((size_t)MCTX * D * 4);
constexpr size_t WS_P = WS_A + al256((size_t)MT * D * 2);
constexpr size_t WS_HID = WS_P + al256((size_t)MT * NP * 2);
constexpr size_t WS_GATES = WS_HID + al256((size_t)MT * FF * 2);
constexpr size_t WS_CAT = WS_GATES + al256((size_t)MT * 16 * 4);
constexpr size_t WS_Q = WS_CAT + al256((size_t)MT * D * 2);
constexpr size_t WS_K = WS_Q + al256((size_t)NB * 8 * KEYS * 64 * 2);
constexpr size_t WS_VT = WS_K + al256((size_t)NB * 6 * KEYS * 64 * 2);
constexpr size_t WS_MLQK = WS_VT + al256((size_t)NB * 6 * KEYS * 64 * 2);
constexpr size_t WS_HYU = WS_MLQK + al256((size_t)MT * 512 * 4);
constexpr size_t WS_HYO = WS_HYU + al256((size_t)768 * MT * 2);
constexpr size_t WS_MLH = WS_HYO + al256((size_t)256 * MT * 2);
constexpr size_t WS_SB = WS_MLH + al256((size_t)2 * MT * 256 * 4);
constexpr size_t WS_SBIN = WS_SB + al256((size_t)DEPTH * 2 * 9 * 5632 * 4);
constexpr size_t WS_SSQ = WS_SBIN + al256((size_t)DEPTH * 9 * NPG * 4);
constexpr size_t WS_END = WS_SSQ + al256((size_t)DEPTH * 3 * MT * 4);
static_assert((size_t)MT * FF * 2 <= (size_t)MT * NP * 2, "HID must fit in P region");

struct Params { const float* in[28]; float* out; unsigned char* ws; };
__device__ __forceinline__ unsigned char* opaque_ws(const Params& P) { unsigned char* w = P.ws; asm volatile("" : "+s"(w)); return w; }

DEVI bf16_t f2bf(float f) { unsigned u = __float_as_uint(f); u += 0x7FFFu + ((u >> 16) & 1u); return (bf16_t)(u >> 16); }
typedef __bf16 bf16x2_t __attribute__((ext_vector_type(2)));
DEVI unsigned pack2(float lo, float hi) { bf16x2_t v; v[0] = (__bf16)lo; v[1] = (__bf16)hi; return __builtin_bit_cast(unsigned, v); }
DEVI float bflo(unsigned u) { return __uint_as_float(u << 16); }
DEVI float bfhi(unsigned u) { return __uint_as_float(u & 0xffff0000u); }
DEVI float bf2f(bf16_t b) { return __uint_as_float(((unsigned)b) << 16); }
DEVI float wave_sum(float v) { for (int o = 32; o; o >>= 1) v += __shfl_xor(v, o); return v; }
DEVI float wave_max(float v) { for (int o = 32; o; o >>= 1) v = fmaxf(v, __shfl_xor(v, o)); return v; }
DEVI float silu_fast(float a) { return a * __builtin_amdgcn_rcpf(1.f + __builtin_amdgcn_exp2f(a * -1.4426950408889634f)); }
DEVI float silu_prec(float a) { return a / (1.f + expf(-a)); }
DEVI float sigmoid_fast(float a) { return __builtin_amdgcn_rcpf(1.f + __builtin_amdgcn_exp2f(a * -1.4426950408889634f)); }
DEVI float logsigmoid(float x) { return x >= 0.f ? -log1pf(expf(-x)) : x - log1pf(expf(x)); }
DEVI uint2 pack4(f32x4 v) { uint2 r; r.x = pack2(v[0], v[1]); r.y = pack2(v[2], v[3]); return r; }
typedef unsigned u32x2 __attribute__((ext_vector_type(2)));
DEVI u32x2 pack4v(f32x4 v) { u32x2 r; r[0] = pack2(v[0], v[1]); r[1] = pack2(v[2], v[3]); return r; }
DEVI f32x4 mfma16(bf16x8 a, bf16x8 b, f32x4 c) { return __builtin_amdgcn_mfma_f32_16x16x32_bf16(a, b, c, 0, 0, 0); }


#define XB_TMO      128
#define XB_XCNT(j)  (256  + 64 * (j))
#define XB_XSUB(j)  (1280 + 64 * (j))
#define XB_XGEN(j)  (2304 + 64 * (j))
#define XB_TOP      3328
#define XB_TOPGEN   3392
#define XCD_BAR_WORDS 3456
#define XB_SPIN_CAP (1u << 20)
DEVI unsigned xb_ld(unsigned* p)              { return __hip_atomic_load(p, __ATOMIC_RELAXED, __HIP_MEMORY_SCOPE_AGENT); }
DEVI unsigned xb_add(unsigned* p, unsigned v) { return __hip_atomic_fetch_add(p, v, __ATOMIC_RELAXED, __HIP_MEMORY_SCOPE_AGENT); }
DEVI unsigned xb_xcc_id() { return (unsigned)__builtin_amdgcn_s_getreg((3 << 11) | 20) & 0xFu; }
#define XB_SPIN(cond, bar) do { unsigned _sp = 0; while (cond) { __builtin_amdgcn_s_sleep(1); \
    if ((++_sp & 255u) == 0u) { if (xb_ld(&(bar)[XB_TMO])) break; if (_sp > XB_SPIN_CAP) { atomicAdd(&(bar)[XB_TMO], 1u); break; } } } } while (0)
struct XcdBarrier { unsigned* bar; unsigned x; volatile LAS3 unsigned* st; };
DEVI XcdBarrier xcd_barrier_post(unsigned* bar, volatile LAS3 unsigned* st) {
    XcdBarrier b; b.bar = bar; b.x = xb_xcc_id(); b.st = st;
    if (threadIdx.x == 0) (void)xb_add(&bar[XB_XCNT(b.x)], 1u);
    return b;
}
DEVI void xcd_barrier_complete(unsigned* bar, unsigned x, unsigned& nloc, unsigned& nx) {
    const unsigned G = gridDim.x * gridDim.y * gridDim.z;
    unsigned sum, cnt, mine, sp = 0u;
    for (;;) {
        sum = 0u; cnt = 0u; mine = 0u;
#pragma unroll
        for (unsigned j = 0; j < 16; ++j) { const unsigned c = xb_ld(&bar[XB_XCNT(j)]); sum += c; cnt += (c > 0u) ? 1u : 0u; mine = (j == x) ? c : mine; }
        if (sum == G) break;
        __builtin_amdgcn_s_sleep(1);
        if ((++sp & 255u) == 0u) { if (xb_ld(&bar[XB_TMO])) break; if (sp > XB_SPIN_CAP) { atomicAdd(&bar[XB_TMO], 1u); break; } }
    }
    nloc = mine > 0u ? mine : 1u; nx = cnt > 0u ? cnt : 1u;
}
#ifndef USE_XCD
#define USE_XCD 1
#endif
DEVI void xcd_barrier(const XcdBarrier& b) {
#if !USE_XCD
    cg::this_grid().sync(); return;
#endif
    asm volatile("s_waitcnt vmcnt(0)" ::: "memory");
    __syncthreads();
    if (threadIdx.x == 0) {
        unsigned* bar = b.bar;
        __builtin_amdgcn_s_waitcnt(0);
        unsigned nloc = b.st[0], nx = b.st[1];
        if (nloc == 0u) { xcd_barrier_complete(bar, b.x, nloc, nx); b.st[0] = nloc; b.st[1] = nx; }
        const unsigned old = xb_add(&bar[XB_XSUB(b.x)], 1u);
        const unsigned gen = old / nloc;
        if (old + 1u == (gen + 1u) * nloc) {
            __builtin_amdgcn_fence(__ATOMIC_RELEASE, "agent");
            asm volatile("s_waitcnt vmcnt(0)" ::: "memory");
            const unsigned og = xb_add(&bar[XB_TOP], 1u);
            const unsigned tg = og / nx;
            if (og + 1u == (tg + 1u) * nx) xb_add(&bar[XB_TOPGEN], 1u);
            else XB_SPIN(xb_ld(&bar[XB_TOPGEN]) == tg, bar);
            __builtin_amdgcn_fence(__ATOMIC_ACQUIRE, "agent");
            xb_add(&bar[XB_XGEN(b.x)], 1u);
            asm volatile("s_waitcnt vmcnt(0)" ::: "memory");
        } else {
            XB_SPIN(xb_ld(&bar[XB_XGEN(b.x)]) == gen, bar);
            __builtin_amdgcn_fence(__ATOMIC_ACQUIRE, "agent");
            asm volatile("s_waitcnt vmcnt(0)" ::: "memory");
        }
    }
    __syncthreads();
}

constexpr int EPW_OFF = 1024 + 131072, EPW_STRIDE = 192 * 4;
DEVI void epw_fill(unsigned char* smem, int mode, const pg8::Unit& u, int wid, int lane, const float* ssq_, const float* Sb_, int sbstride, float (&v)[3]) {
    const G1 float* ssq = (const G1 float*)ssq_; const G1 float* Sb = (const G1 float*)Sb_;
    const int wr = wid >> 2, wc = wid & 3; const int r9 = u.pm < 64 ? (u.pm >> 3) : 8;
#pragma unroll
    for (int k = 0; k < 2; ++k) { const int idx = lane + 64 * k; const int ai = idx >> 6, m = (idx >> 4) & 3, f = idx & 15; v[k] = ssq[u.pm * 256 + ai * 128 + wr * 64 + m * 16 + f]; }
    { const int bj = lane >> 5, c = lane & 31; v[2] = Sb[(size_t)r9 * sbstride + u.pn * 256 + bj * 128 + wc * 32 + c]; }
    (void)mode; (void)smem;
}
DEVI void epw_store(unsigned char* smem, int wid, int lane, const float (&v)[3]) {
    float* w = (float*)(smem + EPW_OFF + wid * EPW_STRIDE);
    w[lane] = rsqrtf(v[0] * (1.f / 1024.f) + 1e-6f); w[64 + lane] = rsqrtf(v[1] * (1.f / 1024.f) + 1e-6f); w[128 + lane] = v[2];
}
struct EpiSwiglu {
    static constexpr bool PERM = false, AFTER_DRAIN = false;
    static DEVI void apply(const f32x4 (&acc)[2][2][4][2], const pg8::Unit& u, int wr, int wc, int fr, int fq, bf16_t* H_, const float* epw) {
        G1 bf16_t* H = (G1 bf16_t*)H_;
        const int row0 = u.pm * 256 + wr * 64 + fr, col0 = u.pn * 128 + wc * 32 + 4 * fq;
        f32x4 sa[2], sb[2];
#pragma unroll
        for (int n = 0; n < 2; ++n) { sa[n] = *(const f32x4*)(epw + 128 + n * 16 + 4 * fq); sb[n] = *(const f32x4*)(epw + 160 + n * 16 + 4 * fq); }
#pragma unroll
        for (int ai = 0; ai < 2; ++ai)
#pragma unroll
            for (int m = 0; m < 4; ++m) { const int row = row0 + ai * 128 + m * 16; G1 bf16_t* rowp = H + (size_t)row * FF + col0;
                const float rstd = epw[(ai * 4 + m) * 16 + fr];
#pragma unroll
                for (int n = 0; n < 2; ++n) { const f32x4 a = acc[ai][0][m][n] * rstd + sa[n], b = acc[ai][1][m][n] * rstd + sb[n]; f32x4 v;
#pragma unroll
                    for (int i = 0; i < 4; ++i) v[i] = silu_fast(a[i]) * b[i];
                    *(G1 u32x2*)(rowp + n * 16) = pack4v(v); } }
    }
};
struct EpiResid {
    static constexpr bool PERM = false, AFTER_DRAIN = false;
    static DEVI void apply(const f32x4 (&acc)[2][2][4][2], const pg8::Unit& u, int wr, int wc, int fr, int fq, float* hl_, float* hc_, const float* gate_, float fac, bf16_t* aout_, const float* ng_, const float* nscale_, float* ssq_) {
        G1 float* hl = (G1 float*)hl_; G1 float* hc = (G1 float*)hc_; const G1 float* gate = (const G1 float*)gate_; G1 bf16_t* aout = (G1 bf16_t*)aout_; const G1 float* ng = (const G1 float*)ng_; const G1 float* nscale = (const G1 float*)nscale_;
        const int row0 = u.pm * 256 + wr * 64 + fr, col0 = u.pn * 256 + wc * 32 + 4 * fq;
        const int r9 = u.pm < 64 ? (u.pm >> 3) : 8;
        const G1 float* gp = gate + (size_t)r9 * 9216 + col0;
        f32x4 gv[2][2];
#pragma unroll
        for (int bj = 0; bj < 2; ++bj)
#pragma unroll
            for (int n = 0; n < 2; ++n) gv[bj][n] = *(const G1 f32x4*)(gp + bj * 128 + n * 16) * fac;
        if (aout_ == nullptr) {
#pragma unroll
            for (int ai = 0; ai < 2; ++ai)
#pragma unroll
                for (int m = 0; m < 4; ++m) { const int row = row0 + ai * 128 + m * 16;
                    G1 float* rowp = (row < MLAT ? hl + (size_t)row * D : hc + (size_t)(row - MLAT) * D) + col0;
#pragma unroll
                    for (int bj = 0; bj < 2; ++bj)
#pragma unroll
                        for (int n = 0; n < 2; ++n) { G1 f32x4* p = (G1 f32x4*)(rowp + bj * 128 + n * 16); *p = *p + gv[bj][n] * acc[ai][bj][m][n]; } }
        } else {
            f32x4 gs[2][2];
#pragma unroll
            for (int bj = 0; bj < 2; ++bj)
#pragma unroll
                for (int n = 0; n < 2; ++n) { const int c = col0 + bj * 128 + n * 16; gs[bj][n] = *(const G1 f32x4*)(ng + c) * (*(const G1 f32x4*)(nscale + (size_t)r9 * 9216 + c) + 1.f); }
#pragma unroll
            for (int ai = 0; ai < 2; ++ai)
#pragma unroll
                for (int m = 0; m < 4; ++m) { const int row = row0 + ai * 128 + m * 16;
                    G1 float* rowp = (row < MLAT ? hl + (size_t)row * D : hc + (size_t)(row - MLAT) * D) + col0;
                    G1 bf16_t* ap = aout + (size_t)row * D + col0;
                    float ss = 0.f;
#pragma unroll
                    for (int bj = 0; bj < 2; ++bj)
#pragma unroll
                        for (int n = 0; n < 2; ++n) { G1 f32x4* p = (G1 f32x4*)(rowp + bj * 128 + n * 16); const f32x4 hn = *p + gv[bj][n] * acc[ai][bj][m][n]; *p = hn;
                            ss += hn[0] * hn[0] + hn[1] * hn[1] + hn[2] * hn[2] + hn[3] * hn[3];
                            *(G1 u32x2*)(ap + bj * 128 + n * 16) = pack4v(hn * gs[bj][n]); }
                    ss += __shfl_xor(ss, 16); ss += __shfl_xor(ss, 32);
                    if (fq == 0) atomicAdd((float*)((G1 float*)ssq_ + row), ss); }
        }
    }
};
struct EpiP {
    static constexpr bool PERM = false, AFTER_DRAIN = false;
    static DEVI void apply(const f32x4 (&acc)[2][2][4][2], const pg8::Unit& u, int wr, int wc, int fr, int fq, bf16_t* Pp_, const float* epw, float* gates_, const float* gb_) {
        G1 bf16_t* Pp = (G1 bf16_t*)Pp_; G1 float* gates = (G1 float*)gates_; const G1 float* gb = (const G1 float*)gb_;
        const int row0 = u.pm * 256 + wr * 64 + fr, col0 = u.pn * 256 + wc * 32 + 4 * fq;
        if (u.pn < 12) {
            f32x4 sv[2][2];
#pragma unroll
            for (int bj = 0; bj < 2; ++bj)
#pragma unroll
                for (int n = 0; n < 2; ++n) sv[bj][n] = *(const f32x4*)(epw + 128 + bj * 32 + n * 16 + 4 * fq);
#pragma unroll
            for (int ai = 0; ai < 2; ++ai)
#pragma unroll
                for (int m = 0; m < 4; ++m) { const int row = row0 + ai * 128 + m * 16; G1 bf16_t* rowp = Pp + (size_t)row * NP + col0;
                    const float rstd = epw[(ai * 4 + m) * 16 + fr];
#pragma unroll
                    for (int bj = 0; bj < 2; ++bj)
#pragma unroll
                        for (int n = 0; n < 2; ++n) *(G1 u32x2*)(rowp + bj * 128 + n * 16) = pack4v(acc[ai][bj][m][n] * rstd + sv[bj][n]); }
        } else if (wc == 0) {
            const f32x4 sv = *(const f32x4*)(epw + 128 + 4 * fq) + *(const G1 f32x4*)(gb + 4 * fq);
#pragma unroll
            for (int ai = 0; ai < 2; ++ai)
#pragma unroll
                for (int m = 0; m < 4; ++m) { const int row = row0 + ai * 128 + m * 16;
                    const float rstd = epw[(ai * 4 + m) * 16 + fr];
                    *(G1 f32x4*)(gates + (size_t)row * 16 + 4 * fq) = acc[ai][0][m][0] * rstd + sv; }
        }
    }
};
template <class Epi> DEVI void run_gemm(unsigned char* smem, const bf16_t* A, const bf16_t* Bt, int Mrows, int N, int K, const Epi& E) {
    pg8::StaticOrder S; S.init(Mrows, N, (int)gridDim.x, opaque_bid());
    pg8::Gemm g; g.A = A; g.Bt = Bt; g.M = Mrows; g.N = N; g.K = K; g.ld = K;
    pg8::gemm_phase<Epi, pg8::StaticOrder, false>((LAS3 unsigned char*)(smem + 1024), g, S, E, nullptr);
}
template <class Epi> DEVI void run_gemm_split(unsigned char* smem, const bf16_t* A, const bf16_t* Bt, int nM, int nN, int K, int KP, const Epi& E) {
    pg8::SplitOrder S; S.init(nM, nN, K / KP, (int)gridDim.x, opaque_bid());
    pg8::Gemm g; g.A = A; g.Bt = Bt; g.M = nM * 256; g.N = nN * 256; g.K = KP; g.ld = K;
    pg8::gemm_phase<Epi, pg8::SplitOrder, false>((LAS3 unsigned char*)(smem + 1024), g, S, E, nullptr);
}
struct EpiResidCtxAtomic {
    static constexpr bool PERM = false, AFTER_DRAIN = false;
    static DEVI void apply(const f32x4 (&acc)[2][2][4][2], const pg8::Unit& u, int wr, int wc, int fr, int fq, float* hc, const float* gate, float fac) {
        const int row0 = u.pm * 256 + wr * 64 + fr, col0 = u.pn * 256 + wc * 32 + 4 * fq;
        const float* gp = gate + (size_t)8 * 9216 + col0;
#pragma unroll
        for (int bj = 0; bj < 2; ++bj)
#pragma unroll
            for (int n = 0; n < 2; ++n) { const f32x4 gv = *(const f32x4*)(gp + bj * 128 + n * 16) * fac;
                float* cp = hc + (size_t)row0 * D + col0 + bj * 128 + n * 16;
#pragma unroll
                for (int ai = 0; ai < 2; ++ai)
#pragma unroll
                    for (int m = 0; m < 4; ++m) { const f32x4 v = gv * acc[ai][bj][m][n]; float* q = cp + (size_t)(ai * 128 + m * 16) * D;
#pragma unroll
                        for (int i = 0; i < 4; ++i) unsafeAtomicAdd(q + i, v[i]); } }
    }
};


struct UniOrder {
    int mode; pg8::StaticOrder so; pg8::SplitOrder sp; int pm0, B0, R;
    DEVI bool next(int i, pg8::Unit& u) const {
        if (mode) return sp.next(i, u);
        const int G = so.G, c = so.c; long L;
        if (c < B0) L = (long)R * (G - B0) + (long)i * G + c;
        else L = i < R ? (long)i * (G - B0) + (c - B0) : (long)R * (G - B0) + (long)(i - R) * G + c;
        if (!so.at(L, u)) return false;
        u.pm += pm0; return true; }
    DEVI void a_ready(const pg8::Unit&) const {}
    DEVI void done(const pg8::Unit&) const {}
};
struct GemmJob { const bf16_t* A; const bf16_t* Bt; int nM, nN, nK, K, ld, order, epi, pm0, B0, R; bf16_t* obf; float* hl; float* hc; const float* gate; float fac; bf16_t* aout; const float* ng; const float* nscale; float* ssq; const float* Sb; float* gates; const float* gb; };
struct EpiParams { int mode; float fac; bf16_t* obf; float* hl; float* hc; const float* gate; bf16_t* aout; const float* ng; const float* nscale; float* ssq; const float* Sb; float* gates; const float* gb; };
struct UniEpi {
    static constexpr bool PERM = false, AFTER_DRAIN = false;
    const EpiParams* ep; unsigned char* smem;
    DEVI void operator()(const f32x4 (&acc)[2][2][4][2], const pg8::Unit& u, const pg8::Unit& nx, bool has_next, int wr, int wc, int fr, int fq) const {
        const int mode = __builtin_amdgcn_readfirstlane(ep->mode);
        if (mode == 1) { EpiResid::apply(acc, u, wr, wc, fr, fq, ep->hl, ep->hc, ep->gate, ep->fac, ep->aout, ep->ng, ep->nscale, ep->ssq); return; }
        const int wid = wr * 4 + wc, lane = fq * 16 + fr;
        const float* epw = (const float*)(smem + EPW_OFF + wid * EPW_STRIDE);
        float pf[3] = {1.f, 1.f, 0.f};
        if (has_next) epw_fill(smem, mode, nx, wid, lane, ep->ssq, ep->Sb, mode == 0 ? 5632 : NPG, pf);
        if (mode == 0) EpiSwiglu::apply(acc, u, wr, wc, fr, fq, ep->obf, epw);
        else EpiP::apply(acc, u, wr, wc, fr, fq, ep->obf, epw, ep->gates, ep->gb);
        if (has_next) epw_store(smem, wid, lane, pf);
    }
};
DEVI void run_job(unsigned char* smem, const GemmJob& J) {
    UniOrder S; S.mode = J.order; S.so.init(J.nM * 256, J.nN * 256, (int)gridDim.x, opaque_bid()); S.sp.init(J.nM, J.nN, J.nK, (int)gridDim.x, opaque_bid()); S.pm0 = J.pm0; S.B0 = J.B0; S.R = J.R;
    pg8::Gemm g; g.A = J.A; g.Bt = J.Bt; g.M = J.nM * 256; g.N = J.nN * 256; g.K = J.K; g.ld = J.ld;
    EpiParams* ep = (EpiParams*)(smem + 64);
    __syncthreads();
    if (threadIdx.x == 0) { ep->mode = J.epi; ep->fac = J.fac; ep->obf = J.obf; ep->hl = J.hl; ep->hc = J.hc; ep->gate = J.gate; ep->aout = J.aout; ep->ng = J.ng; ep->nscale = J.nscale; ep->ssq = J.ssq; ep->Sb = J.Sb; ep->gates = J.gates; ep->gb = J.gb; }
    __syncthreads();
    UniEpi E; E.ep = ep; E.smem = smem;
    if (J.epi != 1) { pg8::Unit u0; if (S.next(0, u0)) { const int tid_ = opaque_tid(); float pf[3]; epw_fill(smem, J.epi, u0, tid_ >> 6, tid_ & 63, J.ssq, J.Sb, J.epi == 0 ? 5632 : NPG, pf); epw_store(smem, tid_ >> 6, tid_ & 63, pf); } }
    pg8::gemm_phase<UniEpi, UniOrder, false>((LAS3 unsigned char*)(smem + 1024), g, S, E, nullptr);
}

DEVI int colmap(int type, int n) {
    if (type == 0) { const int pn = n >> 8, bj = (n >> 7) & 1, jj = n & 127; return bj * FF + pn * 128 + jj; }
    if (type == 2) return n < 1024 ? n : (n < 3072 ? n + 16 : (n < 3088 ? n - 3072 + 1024 : -1));
    return n;
}
DEVI void convert_tile(const float* __restrict__ src, int Nsrc, int K, int type, bf16_t* __restrict__ dst, int kt, int nt, float* lt) {
    const int tid = opaque_tid(), k0 = kt * 64, n0 = nt * 256;
    { const int nn = tid & 255, kk0 = tid >> 8; const int col = colmap(type, n0 + nn);
      const float* s = src + (size_t)k0 * Nsrc + (col < 0 ? 0 : col);
#pragma unroll 8
      for (int i = 0; i < 32; ++i) { const int kk = kk0 + 2 * i; const float v = s[(size_t)kk * Nsrc]; lt[nn * 65 + kk] = col < 0 ? 0.f : v; } }
    __syncthreads();
    { const int kp = (tid & 31) * 2, nn0 = tid >> 5;
#pragma unroll 4
      for (int i = 0; i < 16; ++i) { const int nn = nn0 + 16 * i;
          *(unsigned*)(dst + (size_t)(n0 + nn) * K + k0 + kp) = pack2(lt[nn * 65 + kp], lt[nn * 65 + kp + 1]); } }
    __syncthreads();
}

DEVI void filt_item(const Params& P, int l, int tile, float* lds) {
    const int tid = opaque_tid();
    const int Lsel = tile >= 32; const int L = Lsel ? CTX : SEQ; const int t0 = (Lsel ? tile - 32 : tile) * 64;
    float* feats = lds; float* h1 = lds + 64 * 33; float* h2 = h1 + 64 * 65;
#pragma unroll 1
    for (int idx = tid; idx < 64 * 33; idx += 512) { const int r = idx / 33, f = idx - r * 33; const int t = t0 + r; float v;
        if (f == 0) v = (float)t / (float)L;
        else { const int band = f <= 16 ? f : f - 16; const int x = (t * band) & (L - 1); const float ang = 6.283185307179586f * ((float)x / (float)L); v = f <= 16 ? cosf(ang) : sinf(ang); }
        feats[idx] = v; }
    __syncthreads();
    const float* w1 = P.in[18] + (size_t)l * 33 * 64; const float* b1 = P.in[19] + l * 64;
    const float* w2 = P.in[20] + (size_t)l * 64 * 64; const float* b2 = P.in[21] + l * 64;
    const float* w3 = P.in[22] + (size_t)l * 64 * 512; const float* b3 = P.in[23] + l * 512;
    { const int j = tid & 63, r0 = tid >> 6; float acc[8];
#pragma unroll
      for (int i = 0; i < 8; ++i) acc[i] = b1[j];
      for (int f = 0; f < 33; ++f) { const float w = w1[f * 64 + j];
#pragma unroll
          for (int i = 0; i < 8; ++i) acc[i] += feats[(r0 + 8 * i) * 33 + f] * w; }
#pragma unroll
      for (int i = 0; i < 8; ++i) h1[(r0 + 8 * i) * 65 + j] = acc[i]; }
    __syncthreads();
#pragma unroll 1
    for (int idx = tid; idx < 64 * 64; idx += 512) { const int a = (idx >> 6) * 65 + (idx & 63); h1[a] = sinf(h1[a]); }
    __syncthreads();
    { const int j = tid & 63, r0 = tid >> 6; float acc[8];
#pragma unroll
      for (int i = 0; i < 8; ++i) acc[i] = b2[j];
      for (int f = 0; f < 64; ++f) { const float w = w2[f * 64 + j];
#pragma unroll
          for (int i = 0; i < 8; ++i) acc[i] += h1[(r0 + 8 * i) * 65 + f] * w; }
#pragma unroll
      for (int i = 0; i < 8; ++i) h2[(r0 + 8 * i) * 65 + j] = acc[i]; }
    __syncthreads();
#pragma unroll 1
    for (int idx = tid; idx < 64 * 64; idx += 512) { const int a = (idx >> 6) * 65 + (idx & 63); h2[a] = sinf(h2[a]); }
    __syncthreads();
    { const int c = tid; const float bb = b3[c]; const int cc = c & 255;
      const float da = -3.0701134573253946f, db = -15.350567286626973f;
      const float delta = fabsf(da + (db - da) * ((float)cc / 255.f));
      float cs = 0.f;
      float* hf = (float*)(opaque_ws(P) + WS_HF) + (size_t)l * HF_LAYER + (Lsel ? (size_t)512 * SEQ : 0) + (size_t)c * L + t0;
#pragma unroll 1
      for (int rh = 0; rh < 4; ++rh) { float acc[16];
#pragma unroll
          for (int r = 0; r < 16; ++r) acc[r] = 0.f;
#pragma unroll 1
          for (int k = 0; k < 64; ++k) { const float w = w3[k * 512 + c];
#pragma unroll
              for (int r = 0; r < 16; ++r) acc[r] += h2[(rh * 16 + r) * 65 + k] * w; }
#pragma unroll
          for (int r = 0; r < 16; ++r) { const int t = t0 + rh * 16 + r; const float dist = fabsf((float)(t - L / 2)) / (float)(L / 2);
              const float v = (acc[r] + bb) * expf(-dist * delta); cs += fabsf(v); hf[rh * 16 + r] = v; } }
      ((float*)(opaque_ws(P) + WS_HFS))[((size_t)l * 36 + tile) * 512 + c] = cs; }
    __syncthreads();
}

DEVI void mod_item(const Params& P, int l, int chunk, float* lds) {
    const int tid = opaque_tid();
    float* sc = lds; float* red = lds + 9 * 1024;
    for (int idx = tid; idx < 9 * 1024; idx += 512) { const int r = idx >> 10, k = idx & 1023; const float v = r < 8 ? P.in[1][r * 1024 + k] : P.in[3][k]; sc[idx] = silu_prec(v); }
    __syncthreads();
    const int col = tid & 127, ks = tid >> 7; const int n = chunk * 128 + col;
    const float* w = P.in[4] + (size_t)l * 1024 * 9216 + (size_t)(ks * 256) * 9216 + n;
    float acc[9];
#pragma unroll
    for (int r = 0; r < 9; ++r) acc[r] = 0.f;
#pragma unroll 2
    for (int k = 0; k < 256; k += 4) { const float w0 = w[(size_t)k * 9216], w1 = w[(size_t)(k + 1) * 9216], w2 = w[(size_t)(k + 2) * 9216], w3 = w[(size_t)(k + 3) * 9216];
#pragma unroll
        for (int r = 0; r < 9; ++r) { const float4 s4 = *(const float4*)(sc + r * 1024 + ks * 256 + k); acc[r] += s4.x * w0 + s4.y * w1 + s4.z * w2 + s4.w * w3; } }
#pragma unroll
    for (int r = 0; r < 9; ++r) red[(ks * 9 + r) * 128 + col] = acc[r];
    __syncthreads();
    float* modout = (float*)(opaque_ws(P) + WS_MOD);
    for (int idx = tid; idx < 9 * 128; idx += 512) { const int r = idx >> 7, c = idx & 127;
        const float s = red[(0 * 9 + r) * 128 + c] + red[(1 * 9 + r) * 128 + c] + red[(2 * 9 + r) * 128 + c] + red[(3 * 9 + r) * 128 + c];
        modout[((size_t)l * 9 + r) * 9216 + chunk * 128 + c] = s + P.in[5][(size_t)l * 9216 + chunk * 128 + c]; }
    __syncthreads();
}

constexpr int N_FILT = DEPTH * 36, N_MODI = DEPTH * 72;
constexpr int CV_W13 = 16 * 22, CV_W2 = 44 * 4, CV_WIN = 16 * 13, CV_WOUT = 16 * 4;
constexpr int N_CV13 = DEPTH * 2 * CV_W13, N_CV2 = DEPTH * 2 * CV_W2, N_CVIN = DEPTH * CV_WIN, N_CVOUT = DEPTH * CV_WOUT;
constexpr int N_COPY = MT / 64, N_ROPE = 4, N_ZERO = 8, N_SB = DEPTH * 2 * 44, N_SBIN = DEPTH * 26;
constexpr int N_P0A = N_FILT + N_MODI + N_ROPE + N_ZERO + N_CV13 + N_CV2 + N_CVIN + N_CVOUT;
constexpr int N_P0B = N_SB + N_SBIN + N_COPY;

DEVI void sb_item(const Params& P, const float* W, int Nsrc, int type, const float* shiftp, float* out, int Nout, int chunk, float* lds) {
    const int tid = opaque_tid();
    float* sc = lds; float* red = lds + 9 * 1024;
    for (int idx = tid; idx < 9 * 1024; idx += 512) { const int r = idx >> 10, k = idx & 1023; sc[idx] = shiftp[(size_t)r * 9216 + k]; }
    __syncthreads();
    const int col = tid & 127, ks = tid >> 7; const int n = chunk * 128 + col; const int cm = colmap(type, n);
    const float* w = W + (size_t)(ks * 256) * Nsrc + (cm < 0 ? 0 : cm);
    float acc[9];
#pragma unroll
    for (int r = 0; r < 9; ++r) acc[r] = 0.f;
#pragma unroll 2
    for (int k = 0; k < 256; k += 4) { const float w0 = w[(size_t)k * Nsrc], w1 = w[(size_t)(k + 1) * Nsrc], w2 = w[(size_t)(k + 2) * Nsrc], w3 = w[(size_t)(k + 3) * Nsrc];
#pragma unroll
        for (int r = 0; r < 9; ++r) { const float4 s4 = *(const float4*)(sc + r * 1024 + ks * 256 + k); acc[r] += s4.x * w0 + s4.y * w1 + s4.z * w2 + s4.w * w3; } }
#pragma unroll
    for (int r = 0; r < 9; ++r) red[(ks * 9 + r) * 128 + col] = cm < 0 ? 0.f : acc[r];
    __syncthreads();
    for (int idx = tid; idx < 9 * 128; idx += 512) { const int r = idx >> 7, c = idx & 127;
        out[(size_t)r * Nout + chunk * 128 + c] = red[(0 * 9 + r) * 128 + c] + red[(1 * 9 + r) * 128 + c] + red[(2 * 9 + r) * 128 + c] + red[(3 * 9 + r) * 128 + c]; }
    __syncthreads();
}

DEVI void phase0a(const Params& P, unsigned char* smem) {
    const int tid = opaque_tid();
    float* lds = (float*)(smem + 1024);
    for (int it0 = opaque_bid(); it0 < N_P0A; it0 += gridDim.x) {
        int it = it0;
        if (it < N_FILT) { filt_item(P, it / 36, it % 36, lds); continue; } it -= N_FILT;
        if (it < N_MODI) { mod_item(P, it / 72, it % 72, lds); continue; } it -= N_MODI;
        if (it < N_ROPE) { const int t = it * 512 + tid; const int row = t >> 6, col = t & 63;
          float* rg = (float*)(opaque_ws(P) + WS_ROPEG) + (size_t)t * 64; float* rd = (float*)(opaque_ws(P) + WS_ROPED) + (size_t)t * 32;
          for (int j = 0; j < 16; ++j) { const float inv = expf(-(float)j / 16.f * 9.210340371976184f); const float ar = (float)row * inv, ac = (float)col * inv;
              rg[j] = cosf(ar); rg[16 + j] = cosf(ac); rg[32 + j] = sinf(ar); rg[48 + j] = sinf(ac); }
          for (int j = 0; j < 8; ++j) { const float inv = expf(-(float)j / 8.f * 9.210340371976184f); const float ar = (float)row * inv, ac = (float)col * inv;
              rd[j] = cosf(ar); rd[8 + j] = cosf(ac); rd[16 + j] = sinf(ar); rd[24 + j] = sinf(ac); }
          continue; } it -= N_ROPE;
        if (it < N_ZERO) { float* z = (float*)(opaque_ws(P) + WS_SSQ); const int n = DEPTH * 3 * MT; for (int i = it * 512 + tid; i < n; i += N_ZERO * 512) z[i] = 0.f; continue; } it -= N_ZERO;
        if (it < N_CV13) { const int lf = it / CV_W13, r = it % CV_W13; convert_tile(P.in[7] + (size_t)lf * 1024 * 5632, 5632, 1024, 0, (bf16_t*)(opaque_ws(P) + WS_W13) + (size_t)lf * 5632 * 1024, r / 22, r % 22, lds); continue; } it -= N_CV13;
        if (it < N_CV2) { const int lf = it / CV_W2, r = it % CV_W2; convert_tile(P.in[8] + (size_t)lf * 2816 * 1024, 1024, 2816, 1, (bf16_t*)(opaque_ws(P) + WS_W2) + (size_t)lf * 1024 * 2816, r / 4, r % 4, lds); continue; } it -= N_CV2;
        if (it < N_CVIN) { const int l = it / CV_WIN, r = it % CV_WIN; convert_tile(P.in[9] + (size_t)l * 1024 * NIN, NIN, 1024, 2, (bf16_t*)(opaque_ws(P) + WS_WIN) + (size_t)l * NPG * 1024, r / 13, r % 13, lds); continue; } it -= N_CVIN;
        if (it < N_CVOUT) { const int l = it / CV_WOUT, r = it % CV_WOUT; convert_tile(P.in[10] + (size_t)l * 1024 * 1024, 1024, 1024, 1, (bf16_t*)(opaque_ws(P) + WS_WOUT) + (size_t)l * 1024 * 1024, r / 4, r % 4, lds); continue; }
    }
}
DEVI void phase0b(const Params& P, unsigned char* smem) {
    const int tid = opaque_tid();
    float* lds = (float*)(smem + 1024);
    for (int it0 = opaque_bid(); it0 < N_P0B; it0 += gridDim.x) {
        int it = it0;
        if (it < N_SB) { const int lf = it / 44; const int l = lf >> 1, f = lf & 1;
            sb_item(P, P.in[7] + (size_t)lf * 1024 * 5632, 5632, 0, (const float*)(opaque_ws(P) + WS_MOD) + (size_t)l * 9 * 9216 + (f ? 6 : 0) * 1024, (float*)(opaque_ws(P) + WS_SB) + (size_t)lf * 9 * 5632, 5632, it % 44, lds); continue; } it -= N_SB;
        if (it < N_SBIN) { const int l = it / 26;
            sb_item(P, P.in[9] + (size_t)l * 1024 * NIN, NIN, 2, (const float*)(opaque_ws(P) + WS_MOD) + (size_t)l * 9 * 9216 + 3 * 1024, (float*)(opaque_ws(P) + WS_SBIN) + (size_t)l * 9 * NPG, NPG, it % 26, lds); continue; } it -= N_SBIN;
        {
            const int lane = tid & 63, wid = tid >> 6;
            float* hctx = (float*)(opaque_ws(P) + WS_HCTX); bf16_t* A = (bf16_t*)(opaque_ws(P) + WS_A); float* ssq = (float*)(opaque_ws(P) + WS_SSQ);
            const float* g = P.in[6]; const float* modl = (const float*)(opaque_ws(P) + WS_MOD);
#pragma unroll 2
            for (int rr = 0; rr < 8; ++rr) { const int row = it * 64 + wid * 8 + rr;
                const float* sp = row < MLAT ? P.in[0] + (size_t)row * D : P.in[2] + (size_t)(row - MLAT) * D;
                float* dp = row < MLAT ? P.out + (size_t)row * D : hctx + (size_t)(row - MLAT) * D;
                const int r9 = row < MLAT ? (row >> 11) : 8; const float* scl = modl + (size_t)r9 * 9216 + 1024;
                float ss = 0.f;
#pragma unroll
                for (int j = 0; j < 4; ++j) { const int col = 4 * lane + 256 * j; const float4 x = *(const float4*)(sp + col); *(float4*)(dp + col) = x;
                    ss += x.x * x.x + x.y * x.y + x.z * x.z + x.w * x.w;
                    const float4 g4 = *(const float4*)(g + col), s4 = *(const float4*)(scl + col);
                    uint2 o; o.x = pack2(x.x * g4.x * (1.f + s4.x), x.y * g4.y * (1.f + s4.y)); o.y = pack2(x.z * g4.z * (1.f + s4.z), x.w * g4.w * (1.f + s4.w));
                    *(uint2*)(A + (size_t)row * D + col) = o; }
                ss = wave_sum(ss);
                if (lane == 0) ssq[row] = ss; }
        }
    }
}

template <bool GATES> DEVI void norm_phase(const Params& P, int l, int which, unsigned char* smem) {
    const int tid = opaque_tid(), lane = tid & 63, wid = tid >> 6;
    const float* g = P.in[6] + (size_t)(l * 3 + which) * 1024;
    const float* modl = (const float*)(opaque_ws(P) + WS_MOD) + (size_t)l * 9 * 9216;
    const float* hctx = (const float*)(opaque_ws(P) + WS_HCTX);
    bf16_t* A = (bf16_t*)(opaque_ws(P) + WS_A);
    float* WgT = (float*)(smem + 1024);
    if (GATES) { const float* win = P.in[9] + (size_t)l * 1024 * NIN;
        for (int idx = tid; idx < 16384; idx += 512) { const int k = idx >> 4, jj = idx & 15; WgT[jj * 1024 + k] = win[(size_t)k * NIN + 1024 + jj]; }
        __syncthreads(); }
    float4 gv[4];
#pragma unroll
    for (int j = 0; j < 4; ++j) gv[j] = *(const float4*)(g + 4 * lane + 256 * j);
    for (int row = opaque_bid() * 8 + wid; row < MT; row += gridDim.x * 8) {
        const float* hp = row < MLAT ? P.out + (size_t)row * D : hctx + (size_t)(row - MLAT) * D;
        const int r9 = row < MLAT ? (row >> 11) : 8;
        const float* sh = modl + (size_t)r9 * 9216 + (3 * which) * 1024; const float* scl = sh + 1024;
        float4 x[4]; float ss = 0.f;
#pragma unroll
        for (int j = 0; j < 4; ++j) { x[j] = *(const float4*)(hp + 4 * lane + 256 * j); ss += x[j].x * x[j].x + x[j].y * x[j].y + x[j].z * x[j].z + x[j].w * x[j].w; }
        ss = wave_sum(ss);
        const float rstd = rsqrtf(ss * (1.f / 1024.f) + 1e-6f);
        float ga[16];
        if (GATES) {
#pragma unroll
            for (int jj = 0; jj < 16; ++jj) ga[jj] = 0.f; }
#pragma unroll
        for (int j = 0; j < 4; ++j) { const int col = 4 * lane + 256 * j;
            const float4 s4 = *(const float4*)(scl + col), h4 = *(const float4*)(sh + col);
            float4 y;
            y.x = x[j].x * rstd * gv[j].x * (1.f + s4.x) + h4.x; y.y = x[j].y * rstd * gv[j].y * (1.f + s4.y) + h4.y;
            y.z = x[j].z * rstd * gv[j].z * (1.f + s4.z) + h4.z; y.w = x[j].w * rstd * gv[j].w * (1.f + s4.w) + h4.w;
            uint2 o; o.x = pack2(y.x, y.y); o.y = pack2(y.z, y.w);
            *(uint2*)(A + (size_t)row * D + col) = o;
            if (GATES) {
#pragma unroll
                for (int jj = 0; jj < 16; ++jj) { const float4 w = *(const float4*)(WgT + jj * 1024 + col); ga[jj] += y.x * w.x + y.y * w.y + y.z * w.z + y.w * w.w; } } }
        if (GATES) { float outv = 0.f;
#pragma unroll
            for (int jj = 0; jj < 16; ++jj) { const float t = wave_sum(ga[jj]); if (lane == jj) outv = t; }
            if (lane < 16) ((float*)(opaque_ws(P) + WS_GATES))[(size_t)row * 16 + lane] = outv + P.in[11][l * 16 + lane]; }
    }
}

template <int LEN> DEVI void prep_seg(const bf16_t* __restrict__ src, const float* __restrict__ g, const float* __restrict__ rope, float scale, bf16_t* __restrict__ dst) {
    float x[LEN];
#pragma unroll
    for (int i = 0; i < LEN / 8; ++i) { const uint4 v = *(const uint4*)(src + 8 * i);
        x[8 * i + 0] = bflo(v.x); x[8 * i + 1] = bfhi(v.x); x[8 * i + 2] = bflo(v.y); x[8 * i + 3] = bfhi(v.y);
        x[8 * i + 4] = bflo(v.z); x[8 * i + 5] = bfhi(v.z); x[8 * i + 6] = bflo(v.w); x[8 * i + 7] = bfhi(v.w); }
    float ss = 0.f;
#pragma unroll
    for (int i = 0; i < LEN; ++i) ss += x[i] * x[i];
    const float rstd = rsqrtf(ss * (1.f / LEN) + 1e-6f);
#pragma unroll
    for (int i = 0; i < LEN; ++i) x[i] = x[i] * rstd * g[i];
    if (rope) {
#pragma unroll
        for (int j = 0; j < LEN / 2; ++j) { const float c = rope[j], s = rope[LEN / 2 + j]; const float a = x[j], b = x[j + LEN / 2]; x[j] = a * c - b * s; x[j + LEN / 2] = a * s + b * c; } }
#pragma unroll
    for (int i = 0; i < LEN / 8; ++i) { uint4 o;
        o.x = pack2(x[8 * i + 0] * scale, x[8 * i + 1] * scale); o.y = pack2(x[8 * i + 2] * scale, x[8 * i + 3] * scale);
        o.z = pack2(x[8 * i + 4] * scale, x[8 * i + 5] * scale); o.w = pack2(x[8 * i + 6] * scale, x[8 * i + 7] * scale);
        *(uint4*)(dst + 8 * i) = o; }
}
DEVI void unpack8(const uint4 v, float (&x)[8]) { x[0] = bflo(v.x); x[1] = bfhi(v.x); x[2] = bflo(v.y); x[3] = bfhi(v.y); x[4] = bflo(v.z); x[5] = bfhi(v.z); x[6] = bflo(v.w); x[7] = bfhi(v.w); }

DEVI void prep_phase(const Params& P, int l, unsigned char* smem) {
    const int tid = opaque_tid();
    const bf16_t* p = (const bf16_t*)(opaque_ws(P) + WS_P);
    bf16_t* Qb = (bf16_t*)(opaque_ws(P) + WS_Q); bf16_t* Kb = (bf16_t*)(opaque_ws(P) + WS_K); bf16_t* VT = (bf16_t*)(opaque_ws(P) + WS_VT);
    bf16_t* mlqk = (bf16_t*)(opaque_ws(P) + WS_MLQK); bf16_t* hyu = (bf16_t*)(opaque_ws(P) + WS_HYU);
    const float* ropeG = (const float*)(opaque_ws(P) + WS_ROPEG); const float* ropeD = (const float*)(opaque_ws(P) + WS_ROPED);
    const float* gqa_g = P.in[15] + l * 128; const float* diff_g = P.in[25] + l * 64;
    bf16_t* lt = (bf16_t*)(smem + 1024);
    constexpr int TR = 16, LS = TR + 8;
    for (int rt = opaque_bid(); rt < MT / TR; rt += gridDim.x) {
        const int row0 = rt * TR; const bool isctx = row0 >= MLAT;
        int b, t0, Ls;
        if (!isctx) { b = row0 >> 11; t0 = row0 & 2047; Ls = SEQ; } else { const int rc = row0 - MLAT; b = rc >> 8; t0 = rc & 255; Ls = CTX; }
        const int pp0 = isctx ? t0 : CTX + t0;
        for (int task = tid; task < TR * 22; task += 512) {
            if (task < TR * 6) { const int seg = task % 6, r = task / 6;
                const int srccol = seg < 4 ? 1024 + 64 * seg : 1280 + 64 * (seg - 4);
                const float* g = gqa_g + (seg < 4 ? 0 : 64); const float scale = seg < 4 ? 0.125f * LOG2E : 1.f;
                bf16_t* dst = seg < 4 ? Qb + (((size_t)b * 8 + seg) * KEYS + pp0 + r) * 64 : Kb + (((size_t)b * 6 + (seg - 4)) * KEYS + pp0 + r) * 64;
                const float* rope = isctx ? nullptr : ropeG + (size_t)(t0 + r) * 64;
                prep_seg<64>(p + (size_t)(row0 + r) * NP + srccol, g, rope, scale, dst);
            } else { const int tt = task - TR * 6; const int seg = tt & 15, r = tt >> 4; const int isk = seg >> 3, hh = (seg >> 1) & 3, s = seg & 1;
                const int srccol = (isk ? 2560 : 2304) + 64 * hh + 32 * s;
                const float* g = diff_g + isk * 32; const float scale = isk ? 1.f : 0.17677669529663687f * LOG2E;
                bf16_t* dst = isk ? Kb + (((size_t)b * 6 + 2 + hh) * KEYS + pp0 + r) * 64 + 32 * s : Qb + (((size_t)b * 8 + 4 + hh) * KEYS + pp0 + r) * 64 + 32 * s;
                const float* rope = isctx ? nullptr : ropeD + (size_t)(t0 + r) * 32;
                prep_seg<32>(p + (size_t)(row0 + r) * NP + srccol, g, rope, scale, dst);
            }
        }
        { const float* cw = P.in[12] + (size_t)l * 3 * 512; const float* cb = P.in[13] + (size_t)l * 512;
          for (int task = tid; task < TR * 64; task += 512) { const int cg8 = task & 63, r = task >> 6; const int c0 = cg8 * 8; const int t = t0 + r;
              const bf16_t* pr = p + (size_t)(row0 + r) * NP + c0;
              float xm[8], x0[8], xp[8];
              unpack8(*(const uint4*)pr, x0);
              if (t > 0) unpack8(*(const uint4*)(pr - NP), xm); else {
#pragma unroll
                  for (int i = 0; i < 8; ++i) xm[i] = 0.f; }
              if (t < Ls - 1) unpack8(*(const uint4*)(pr + NP), xp); else {
#pragma unroll
                  for (int i = 0; i < 8; ++i) xp[i] = 0.f; }
              const float sc = c0 < 256 ? 0.125f : 1.f;
              float y[8];
#pragma unroll
              for (int i = 0; i < 8; ++i) { const float v = cw[c0 + i] * xm[i] + cw[512 + c0 + i] * x0[i] + cw[1024 + c0 + i] * xp[i] + cb[c0 + i]; y[i] = silu_fast(v) * sc; }
              uint4 o4; o4.x = pack2(y[0], y[1]); o4.y = pack2(y[2], y[3]); o4.z = pack2(y[4], y[5]); o4.w = pack2(y[6], y[7]);
              *(uint4*)(mlqk + (size_t)(row0 + r) * 512 + c0) = o4; } }
        for (int task = tid; task < TR * 48; task += 512) { const int r = task & (TR - 1), ch = task / TR;
            const int srccol = ch < 16 ? 1408 + ch * 8 : 2816 + (ch - 16) * 8;
            const uint4 v = *(const uint4*)(p + (size_t)(row0 + r) * NP + srccol);
            bf16_t* d = lt + (size_t)(ch * 8) * LS + r;
            d[0] = (bf16_t)(v.x & 0xffff); d[LS] = (bf16_t)(v.x >> 16); d[2 * LS] = (bf16_t)(v.y & 0xffff); d[3 * LS] = (bf16_t)(v.y >> 16);
            d[4 * LS] = (bf16_t)(v.z & 0xffff); d[5 * LS] = (bf16_t)(v.z >> 16); d[6 * LS] = (bf16_t)(v.w & 0xffff); d[7 * LS] = (bf16_t)(v.w >> 16); }
        __syncthreads();
        static_assert(TR == 16, "V^T key permutation below assumes 16-row tiles");
        for (int task = tid; task < 384 * 2; task += 512) { const int dd = task >> 1, ch = task & 1; const int slot = dd >> 6, d = dd & 63;
            const uint4 v = *(const uint4*)(lt + (size_t)dd * LS + ch * 8);
            bf16_t* dst = VT + (((size_t)b * 6 + slot) * 64 + d) * KEYS + (pp0 & ~31) + ((pp0 >> 4) & 1) * 4;
            *(uint2*)(dst + (2 * ch) * 8) = make_uint2(v.x, v.y); *(uint2*)(dst + (2 * ch + 1) * 8) = make_uint2(v.z, v.w); }
        __syncthreads();
        { const float* cw = P.in[16] + (size_t)l * 3 * 768; const float* cb = P.in[17] + (size_t)l * 768;
          for (int task = tid; task < TR * 96; task += 512) { const int r = task & (TR - 1), ch = task / TR; const int c0 = ch * 8; const int t = t0 + r;
              const bf16_t* pr = p + (size_t)(row0 + r) * NP + 1536 + c0;
              float xm[8], x0[8], xp[8];
              unpack8(*(const uint4*)pr, x0);
              if (t > 0) unpack8(*(const uint4*)(pr - NP), xm); else {
#pragma unroll
                  for (int i = 0; i < 8; ++i) xm[i] = 0.f; }
              if (t < Ls - 1) unpack8(*(const uint4*)(pr + NP), xp); else {
#pragma unroll
                  for (int i = 0; i < 8; ++i) xp[i] = 0.f; }
              bf16_t* d = lt + (size_t)c0 * LS + r;
#pragma unroll
              for (int i = 0; i < 8; ++i) { const float v = cw[c0 + i] * xm[i] + cw[768 + c0 + i] * x0[i] + cw[1536 + c0 + i] * xp[i] + cb[c0 + i]; d[i * LS] = f2bf(v); } } }
        __syncthreads();
        for (int task = tid; task < 768 * (TR / 8); task += 512) { const int cc = task / (TR / 8), ch = task % (TR / 8);
            *(uint4*)(hyu + (size_t)cc * MT + row0 + ch * 8) = *(const uint4*)(lt + (size_t)cc * LS + ch * 8); }
        __syncthreads();
    }
}

template <bool DIFF> DEVI void attn_item(const Params& P, int l, int b, int hsel, int qb, bool isctx, unsigned char* smem) {
    const int tid = opaque_tid(), lane = tid & 63, wid = tid >> 6, fr = lane & 15, quad = lane >> 4;
    bf16_t* Ks0 = (bf16_t*)(smem + 1024); bf16_t* Vs0 = Ks0 + 2 * 64 * 72;
    const int nkt = (isctx ? CTX : KEYS) / 64;
    const int pq0 = (isctx ? 0 : CTX) + qb * 128 + wid * 16;
    const int slotk = DIFF ? 2 + hsel : hsel;
    const bf16_t* Kg = (const bf16_t*)(opaque_ws(P) + WS_K) + ((size_t)b * 6 + slotk) * KEYS * 64;
    const bf16_t* Vg = (const bf16_t*)(opaque_ws(P) + WS_VT) + ((size_t)b * 6 + slotk) * 64 * KEYS;
    const bf16_t* Qg = (const bf16_t*)(opaque_ws(P) + WS_Q);
    bf16x8 q[2][2];
#pragma unroll
    for (int s = 0; s < 2; ++s) { const int slotq = DIFF ? 4 + hsel : 2 * hsel + s;
        const bf16_t* qp = Qg + (((size_t)b * 8 + slotq) * KEYS + pq0 + fr) * 64 + quad * 8;
        q[s][0] = *(const bf16x8*)qp; q[s][1] = *(const bf16x8*)(qp + 32); }
    float M2;
    { const float* g = DIFF ? P.in[25] + l * 64 : P.in[15] + l * 128; const int n = DIFF ? 32 : 64;
      float a = lane < n ? fabsf(g[lane]) : 0.f, bb = lane < n ? fabsf(g[n + lane]) : 0.f; a = wave_max(a); bb = wave_max(bb);
      M2 = sqrtf((float)n) * a * bb * LOG2E; }
    f32x4 O[2][5];
#pragma unroll
    for (int s = 0; s < 2; ++s)
#pragma unroll
        for (int d = 0; d < 5; ++d) O[s][d] = (f32x4){0.f, 0.f, 0.f, 0.f};
    const f32x4 minit = (f32x4){-M2, -M2, -M2, -M2};
    const int lrow = tid >> 3, lch = (tid & 7) * 8;
    const bf16_t* kgp = Kg + (size_t)lrow * 64 + lch; const bf16_t* vgp = Vg + (size_t)lrow * KEYS + lch;
#define LDK(t) (*(const uint4*)(kgp + (size_t)(t) * 64 * 64))
#define LDV(t) (*(const uint4*)(vgp + (size_t)(t) * 64))
    uint4 k0r = LDK(0), v0r = LDV(0), k1r = k0r, v1r = v0r;
    constexpr int KSZ = 64 * 72, VSZ = 80 * 72;
    __syncthreads();
    *(uint4*)(Ks0 + lrow * 72 + lch) = k0r; *(uint4*)(Vs0 + lrow * 72 + lch) = v0r;
    if (nkt > 1) { k0r = LDK(1); v0r = LDV(1); }
    if (nkt > 2) { k1r = LDK(2); v1r = LDV(2); }
    __syncthreads();
    f32x4 S[2][4]; bf16x8 pbp[2][2];
    bf16x8 vones;
#pragma unroll
    for (int i = 0; i < 8; ++i) vones[i] = (short)0x3F80;
#define ATT_QK(KS) do { _Pragma("unroll") for (int ks = 0; ks < 4; ++ks) { const bf16_t* kp = (KS) + (ks * 16 + fr) * 72 + quad * 8; \
            const bf16x8 k0 = *(const bf16x8*)kp, k1 = *(const bf16x8*)(kp + 32); \
            if (!DIFF) { S[0][ks] = mfma16(k0, q[0][0], minit); S[1][ks] = mfma16(k0, q[1][0], minit); S[0][ks] = mfma16(k1, q[0][1], S[0][ks]); S[1][ks] = mfma16(k1, q[1][1], S[1][ks]); } \
            else { S[0][ks] = mfma16(k0, q[0][0], minit); S[1][ks] = mfma16(k1, q[0][1], minit); } } } while (0)
#define ATT_EXP(PB) do { _Pragma("unroll") for (int s = 0; s < 2; ++s) _Pragma("unroll") for (int kk = 0; kk < 2; ++kk) { float pv[8]; \
            _Pragma("unroll") for (int i = 0; i < 4; ++i) { pv[i] = __builtin_amdgcn_exp2f(S[s][2 * kk][i]); pv[4 + i] = __builtin_amdgcn_exp2f(S[s][2 * kk + 1][i]); } \
            union { uint4 u; bf16x8 v; } cv; cv.u.x = pack2(pv[0], pv[1]); cv.u.y = pack2(pv[2], pv[3]); cv.u.z = pack2(pv[4], pv[5]); cv.u.w = pack2(pv[6], pv[7]); \
            PB[s][kk] = cv.v; } } while (0)
#define ATT_PV(VS, PB) do { _Pragma("unroll") for (int ds = 0; ds < 5; ++ds) _Pragma("unroll") for (int kk = 0; kk < 2; ++kk) { const bf16x8 vf = ds < 4 ? *(const bf16x8*)((VS) + (ds * 16 + fr) * 72 + kk * 32 + quad * 8) : vones; \
            O[0][ds] = mfma16(vf, PB[0][kk], O[0][ds]); O[1][ds] = mfma16(vf, PB[1][kk], O[1][ds]); } } while (0)
#define ATT_NEXT(kt, VN) do { if ((kt) + 1 < nkt) { bf16_t* Kn = Ks0 + (((kt) + 1) & 1) * KSZ; bf16_t* Vn = Vs0 + (VN) * VSZ; \
            if (((kt) & 1) == 0) { *(uint4*)(Kn + lrow * 72 + lch) = k0r; *(uint4*)(Vn + lrow * 72 + lch) = v0r; if ((kt) + 3 < nkt) { k0r = LDK((kt) + 3); v0r = LDV((kt) + 3); } } \
            else { *(uint4*)(Kn + lrow * 72 + lch) = k1r; *(uint4*)(Vn + lrow * 72 + lch) = v1r; if ((kt) + 3 < nkt) { k1r = LDK((kt) + 3); v1r = LDV((kt) + 3); } } } } while (0)
    ATT_QK(Ks0); ATT_EXP(pbp); ATT_NEXT(0, 1);
    __syncthreads();
    int vprev = 0, vcur = 1, vnext = 2;
    for (int kt = 1; kt < nkt; ++kt) {
        ATT_QK(Ks0 + (kt & 1) * KSZ);
        bf16x8 pb[2][2];
        ATT_PV(Vs0 + vprev * VSZ, pbp);
        ATT_EXP(pb);
#pragma unroll
        for (int s = 0; s < 2; ++s)
#pragma unroll
            for (int kk = 0; kk < 2; ++kk) pbp[s][kk] = pb[s][kk];
        ATT_NEXT(kt, vnext);
        __syncthreads();
        const int t_ = vprev; vprev = vcur; vcur = vnext; vnext = t_;
    }
    ATT_PV(Vs0 + vprev * VSZ, pbp);
#undef ATT_QK
#undef ATT_EXP
#undef ATT_PV
#undef ATT_NEXT
    float lsum[2];
#pragma unroll
    for (int s = 0; s < 2; ++s) lsum[s] = __shfl(O[s][4][0], fr);
    const int pp = pq0 + fr;
    const size_t row = pp < CTX ? (size_t)MLAT + b * CTX + pp : (size_t)b * SEQ + (pp - CTX);
    bf16_t* cat = (bf16_t*)(opaque_ws(P) + WS_CAT);
    if (!DIFF) {
#pragma unroll
        for (int s = 0; s < 2; ++s) { const float inv = 1.f / lsum[s]; bf16_t* op = cat + row * D + 256 + (2 * hsel + s) * 64 + quad * 4;
#pragma unroll
            for (int ds = 0; ds < 4; ++ds) *(uint2*)(op + ds * 16) = pack4(O[s][ds] * inv); }
    } else {
        const float* lp = P.in[26] + l * 128;
        float a = lane < 32 ? lp[lane] * lp[32 + lane] : 0.f, c = lane < 32 ? lp[64 + lane] * lp[96 + lane] : 0.f; a = wave_sum(a); c = wave_sum(c);
        const float lam_init = 0.8f - 0.6f * expf(-0.3f * (float)l);
        const float lam = expf(a) - expf(c) + lam_init;
        const float i0 = 1.f / lsum[0], i1 = lam / lsum[1];
        f32x4 o[4]; float ss = 0.f;
#pragma unroll
        for (int ds = 0; ds < 4; ++ds) { o[ds] = O[0][ds] * i0 - O[1][ds] * i1; ss += o[ds][0] * o[ds][0] + o[ds][1] * o[ds][1] + o[ds][2] * o[ds][2] + o[ds][3] * o[ds][3]; }
        ss += __shfl_xor(ss, 16); ss += __shfl_xor(ss, 32);
        const float fac = rsqrtf(ss * (1.f / 64.f) + 1e-6f) * (1.f - lam_init);
        const float* sg = P.in[27] + l * 64;
        bf16_t* op = cat + row * D + 768 + hsel * 64 + quad * 4;
#pragma unroll
        for (int ds = 0; ds < 4; ++ds) { const f32x4 gg = *(const f32x4*)(sg + ds * 16 + quad * 4); *(uint2*)(op + ds * 16) = pack4(o[ds] * gg * fac); }
    }
}

#undef LDK
#undef LDV
DEVI void hy_build_E(const float* hs, float norm, int L, bf16_t* E, int NG) {
    const int lo = L / 2, hi = 3 * L / 2 - 1;
    for (int idx = threadIdx.x; idx < 8 * NG; idx += 512) { const int r = idx / NG, m = idx - r * NG; const int i0 = 8 * m + r;
        float v[8];
#pragma unroll
        for (int e = 0; e < 8; ++e) { const int i = i0 + e; v[e] = (i >= lo && i <= hi) ? hs[hi - i] * norm : 0.f; }
        uint4 o; o.x = pack2(v[0], v[1]); o.y = pack2(v[2], v[3]); o.z = pack2(v[4], v[5]); o.w = pack2(v[6], v[7]);
        *(uint4*)(E + ((size_t)r * NG + m) * 8) = o; }
}
template <int NT> DEVI void hy_conv_chain(const bf16_t* E, int NG, const bf16_t* Us, int ustride, int L, int tbase, int fr, int quad, f32x4 (&acc)[NT]) {
    int jlo = tbase - L / 2 + 1; jlo = jlo < 0 ? 0 : (jlo & ~31);
    int jhi = (tbase + 32 * (NT - 1) + 16 + L / 2 + 31) & ~31; jhi = jhi > L ? L : jhi;
    const bf16_t* Er = E + (size_t)(7 - (fr & 7)) * NG * 8;
    const bf16_t* ub = Us + (fr & 7) * ustride + quad * 8;
    const int ob = quad * 8 - tbase - fr + L - 1;
    bf16x8 F[NT];
#pragma unroll
    for (int i = 0; i < NT; ++i) { acc[i] = (f32x4){0.f, 0.f, 0.f, 0.f}; F[i] = *(const bf16x8*)(Er + (size_t)((jlo + ob - 32 * i) >> 3) * 8); }
    for (int jb = jlo; jb < jhi; jb += 32) {
        const bf16x8 bv = *(const bf16x8*)(ub + jb);
        bf16x8 Fn = F[0];
        if (jb + 32 < jhi) Fn = *(const bf16x8*)(Er + (size_t)((jb + 32 + ob) >> 3) * 8);
#pragma unroll
        for (int i = 0; i < NT; ++i) acc[i] = mfma16(F[i], bv, acc[i]);
#pragma unroll
        for (int i = NT - 1; i > 0; --i) F[i] = F[i - 1];
        F[0] = Fn;
    }
}
template <int NT> DEVI void hy_item(const Params& P, int l, int c, unsigned char* smem) {
    constexpr int Lsel = (NT == 2) ? 1 : 0;
    constexpr int L = Lsel ? CTX : SEQ; constexpr int NG = L / 4 + 2; constexpr int ustride = L + 8;
    const int tid = opaque_tid(), lane = tid & 63, wid = tid >> 6, fr = lane & 15, quad = lane >> 4;
    bf16_t* E = (bf16_t*)(smem + 1024); bf16_t* Us = E + (size_t)8 * NG * 8; bf16_t* Zs = Us + 8 * ustride;
    const float* hfs = (const float*)(opaque_ws(P) + WS_HFS) + (size_t)l * 36 * 512;
    float s0 = 0.f, s1 = 0.f;
    { const int tlo = Lsel ? 32 : 0, thi = Lsel ? 36 : 32; for (int t = tlo; t < thi; ++t) { s0 += hfs[t * 512 + c]; s1 += hfs[t * 512 + 256 + c]; } }
    const float* hf = (const float*)(opaque_ws(P) + WS_HF) + (size_t)l * HF_LAYER + (Lsel ? (size_t)512 * SEQ : 0);
    const bf16_t* hyu = (const bf16_t*)(opaque_ws(P) + WS_HYU); bf16_t* hyo = (bf16_t*)(opaque_ws(P) + WS_HYO);
    { float* hs = (float*)Zs; const float* src = hf + (size_t)c * L; for (int i = tid; i < L / 4; i += 512) *(float4*)(hs + 4 * i) = *(const float4*)(src + 4 * i); }
    { constexpr int nch = L / 8; for (int idx = tid; idx < 8 * nch; idx += 512) { const int bb = idx / nch, ch = idx - bb * nch;
          const size_t base = Lsel ? (size_t)MLAT + bb * CTX : (size_t)bb * SEQ;
          *(uint4*)(Us + bb * ustride + ch * 8) = *(const uint4*)(hyu + (size_t)c * MT + base + ch * 8); } }
    __syncthreads();
    hy_build_E((const float*)Zs, 1.f / s0, L, E, NG);
    __syncthreads();
    const float sk0 = P.in[24][(size_t)l * 512 + c], sk1 = P.in[24][(size_t)l * 512 + 256 + c];
    const size_t baseb = Lsel ? (size_t)MLAT + (fr & 7) * CTX : (size_t)(fr & 7) * SEQ;
    const int tbase = 16 * (wid & 1) + 32 * NT * (wid >> 1);
    f32x4 acc[NT];
    hy_conv_chain<NT>(E, NG, Us, ustride, L, tbase, fr, quad, acc);
    if (fr < 8) {
#pragma unroll
        for (int i = 0; i < NT; ++i) { const int t = tbase + 32 * i + quad * 4;
            const uint2 v4 = *(const uint2*)(Us + fr * ustride + t); const uint2 x4 = *(const uint2*)(hyu + (size_t)(256 + c) * MT + baseb + t);
            f32x4 z; z[0] = bflo(x4.x) * (acc[i][0] + sk0 * bflo(v4.x)); z[1] = bfhi(x4.x) * (acc[i][1] + sk0 * bfhi(v4.x));
            z[2] = bflo(x4.y) * (acc[i][2] + sk0 * bflo(v4.y)); z[3] = bfhi(x4.y) * (acc[i][3] + sk0 * bfhi(v4.y));
            *(uint2*)(Zs + fr * ustride + t) = pack4(z); } }
    __syncthreads();
    { float* hs = (float*)Us; const float* src = hf + (size_t)(256 + c) * L; for (int i = tid; i < L / 4; i += 512) *(float4*)(hs + 4 * i) = *(const float4*)(src + 4 * i); }
    __syncthreads();
    hy_build_E((const float*)Us, 1.f / s1, L, E, NG);
    __syncthreads();
    hy_conv_chain<NT>(E, NG, Zs, ustride, L, tbase, fr, quad, acc);
    if (fr < 8) {
#pragma unroll
        for (int i = 0; i < NT; ++i) { const int t = tbase + 32 * i + quad * 4;
            const uint2 v4 = *(const uint2*)(Zs + fr * ustride + t); const uint2 x4 = *(const uint2*)(hyu + (size_t)(512 + c) * MT + baseb + t);
            f32x4 z; z[0] = bflo(x4.x) * (acc[i][0] + sk1 * bflo(v4.x)); z[1] = bfhi(x4.x) * (acc[i][1] + sk1 * bfhi(v4.x));
            z[2] = bflo(x4.y) * (acc[i][2] + sk1 * bflo(v4.y)); z[3] = bfhi(x4.y) * (acc[i][3] + sk1 * bfhi(v4.y));
            *(uint2*)(hyo + (size_t)c * MT + baseb + t) = pack4(z); } }
}

DEVI void ml_item(const Params& P, int l, int b, int hh, int dir, unsigned char* smem) {
    const int tid = opaque_tid(), lane = tid & 63, wid = tid >> 6, fr = lane & 15, quad = lane >> 4;
    bf16_t* Qs = (bf16_t*)(smem + 1024); bf16_t* Qp = Qs + 64 * 72; bf16_t* Ks = Qp + 64 * 72; bf16_t* KTw = Ks + 64 * 72; bf16_t* Ss = KTw + 64 * 72;
    bf16_t* VT = Ss + 64 * 72; bf16_t* Cs = VT + 80 * 72;
    float* btm = (float*)(Cs + 80 * 72); float* aval = btm + 64; float* mrow = aval + 64; float* winter = mrow + 64; float* wg = winter + 64; float* sc = wg + 64;
    const bf16_t* mlqk = (const bf16_t*)(opaque_ws(P) + WS_MLQK); const bf16_t* p = (const bf16_t*)(opaque_ws(P) + WS_P); const float* gates = (const float*)(opaque_ws(P) + WS_GATES);
    float* mlh = (float*)(opaque_ws(P) + WS_MLH) + (size_t)dir * MT * 256;
    for (int i = tid; i < 80 * 72; i += 512) Cs[i] = 0;
    for (int i = tid; i < 16 * 72; i += 512) VT[64 * 72 + i] = (i < 72) ? (bf16_t)0x3F80 : (bf16_t)0;
    if (tid == 0) sc[0] = 0.f;
    const int tt = wid & 3, grp = wid >> 2;
    f32x4 Cacc[3];
#pragma unroll
    for (int j = 0; j < 3; ++j) Cacc[j] = (f32x4){0.f, 0.f, 0.f, 0.f};
    const int lr = tid & 63, lc0 = (tid >> 6) * 8;
    uint4 qreg, kreg, vreg; float gi = 0.f, gf = 0.f;
    { const int Ls = CTX; const size_t rowbase = (size_t)MLAT + b * CTX; const int pos = dir ? Ls - 1 - lr : lr; const size_t row = rowbase + pos;
      qreg = *(const uint4*)(mlqk + row * 512 + hh * 64 + lc0); kreg = *(const uint4*)(mlqk + row * 512 + 256 + hh * 64 + lc0); vreg = *(const uint4*)(p + row * NP + 512 + hh * 64 + lc0);
      if (tid < 64) { const float* gp = gates + row * 16 + dir * 8 + hh; gi = gp[0]; gf = gp[4]; } }
    __syncthreads();
#pragma unroll 1
    for (int ck = 0; ck < 36; ++ck) {
        const int seq = ck >= 4; const int Ls = seq ? SEQ : CTX; const size_t rowbase = seq ? (size_t)b * SEQ : (size_t)MLAT + b * CTX; const int kk = seq ? ck - 4 : ck;
        if (tid < 64) {
            float bsum = logsigmoid(gf);
#pragma unroll
            for (int o = 1; o < 64; o <<= 1) { const float t = __shfl_up(bsum, o); if (lane >= o) bsum += t; }
            const float a = gi - bsum; float pm = a;
#pragma unroll
            for (int o = 1; o < 64; o <<= 1) { const float t = __shfl_up(pm, o); if (lane >= o) pm = fmaxf(pm, t); }
            const float m = sc[0]; const float mt = bsum + fmaxf(m, pm);
            btm[lane] = bsum - mt; aval[lane] = a; mrow[lane] = mt; winter[lane] = expf(bsum + m - mt);
            const float bend = __shfl(bsum, 63), pmend = __shfl(pm, 63); const float mnew = bend + fmaxf(m, pmend);
            wg[lane] = expf(bend + a - mnew);
            if (lane == 0) { sc[1] = expf(bend + m - mnew); sc[2] = mnew; } }
        __syncthreads();
        { float qf[8], kf[8]; unpack8(qreg, qf); unpack8(kreg, kf);
          const float wi = winter[lr], wgs = wg[lr];
          *(uint4*)(Qs + lr * 72 + lc0) = qreg; *(uint4*)(Ks + lr * 72 + lc0) = kreg;
          uint4 o; o.x = pack2(qf[0] * wi, qf[1] * wi); o.y = pack2(qf[2] * wi, qf[3] * wi); o.z = pack2(qf[4] * wi, qf[5] * wi); o.w = pack2(qf[6] * wi, qf[7] * wi);
          *(uint4*)(Qp + lr * 72 + lc0) = o;
          const unsigned k01 = pack2(kf[0] * wgs, kf[1] * wgs), k23 = pack2(kf[2] * wgs, kf[3] * wgs), k45 = pack2(kf[4] * wgs, kf[5] * wgs), k67 = pack2(kf[6] * wgs, kf[7] * wgs);
          bf16_t* kt = KTw + lc0 * 72 + lr;
          kt[0] = (bf16_t)(k01 & 0xffff); kt[72] = (bf16_t)(k01 >> 16); kt[144] = (bf16_t)(k23 & 0xffff); kt[216] = (bf16_t)(k23 >> 16);
          kt[288] = (bf16_t)(k45 & 0xffff); kt[360] = (bf16_t)(k45 >> 16); kt[432] = (bf16_t)(k67 & 0xffff); kt[504] = (bf16_t)(k67 >> 16);
          bf16_t* vt = VT + lc0 * 72 + lr;
          vt[0] = (bf16_t)(vreg.x & 0xffff); vt[72] = (bf16_t)(vreg.x >> 16); vt[144] = (bf16_t)(vreg.y & 0xffff); vt[216] = (bf16_t)(vreg.y >> 16);
          vt[288] = (bf16_t)(vreg.z & 0xffff); vt[360] = (bf16_t)(vreg.z >> 16); vt[432] = (bf16_t)(vreg.w & 0xffff); vt[504] = (bf16_t)(vreg.w >> 16); }
        __syncthreads();
        if (ck + 1 < 36) { const int ck1 = ck + 1; const int seq1 = ck1 >= 4; const int Ls1 = seq1 ? SEQ : CTX; const size_t rb1 = seq1 ? (size_t)b * SEQ : (size_t)MLAT + b * CTX; const int kk1 = seq1 ? ck1 - 4 : ck1;
            const int pos = dir ? Ls1 - 1 - (kk1 * 64 + lr) : kk1 * 64 + lr; const size_t row = rb1 + pos;
            qreg = *(const uint4*)(mlqk + row * 512 + hh * 64 + lc0); kreg = *(const uint4*)(mlqk + row * 512 + 256 + hh * 64 + lc0); vreg = *(const uint4*)(p + row * NP + 512 + hh * 64 + lc0);
            if (tid < 64) { const float* gp = gates + row * 16 + dir * 8 + hh; gi = gp[0]; gf = gp[4]; } }
#pragma unroll
        for (int j = 0; j < 2; ++j) { const int ti = 2 * wid + j; const int st = ti >> 2, t2 = ti & 3;
            f32x4 sv = (f32x4){0.f, 0.f, 0.f, 0.f};
            if (st <= t2) {
#pragma unroll
                for (int k2 = 0; k2 < 2; ++k2) { const bf16x8 af = *(const bf16x8*)(Ks + (st * 16 + fr) * 72 + k2 * 32 + quad * 8); const bf16x8 bq = *(const bf16x8*)(Qs + (t2 * 16 + fr) * 72 + k2 * 32 + quad * 8);
                    sv = mfma16(af, bq, sv); }
                const int t = t2 * 16 + fr; const float bt = btm[t];
#pragma unroll
                for (int i = 0; i < 4; ++i) { const int s_ = st * 16 + quad * 4 + i; sv[i] = s_ <= t ? sv[i] * expf(bt + aval[s_]) : 0.f; } }
            *(uint2*)(Ss + (t2 * 16 + fr) * 72 + st * 16 + quad * 4) = pack4(sv); }
        __syncthreads();
        { f32x4 oacc[3];
#pragma unroll
          for (int j = 0; j < 3; ++j) oacc[j] = (f32x4){0.f, 0.f, 0.f, 0.f};
#pragma unroll
          for (int k2 = 0; k2 < 2; ++k2) { const bf16x8 bS = *(const bf16x8*)(Ss + (tt * 16 + fr) * 72 + k2 * 32 + quad * 8); const bf16x8 bQ = *(const bf16x8*)(Qp + (tt * 16 + fr) * 72 + k2 * 32 + quad * 8);
              const bf16x8 bK = *(const bf16x8*)(KTw + (tt * 16 + fr) * 72 + k2 * 32 + quad * 8);
#pragma unroll
              for (int j = 0; j < 3; ++j) { const int dt = j < 2 ? 2 * grp + j : 4;
                  const bf16x8 aV = *(const bf16x8*)(VT + (dt * 16 + fr) * 72 + k2 * 32 + quad * 8); const bf16x8 aC = *(const bf16x8*)(Cs + (dt * 16 + fr) * 72 + k2 * 32 + quad * 8);
                  oacc[j] = mfma16(aV, bS, oacc[j]); oacc[j] = mfma16(aC, bQ, oacc[j]);
                  if (k2 == 0) Cacc[j] = Cacc[j] * sc[1];
                  Cacc[j] = mfma16(aV, bK, Cacc[j]); } }
          const int t = tt * 16 + fr;
          const float den = __shfl(oacc[2][0], fr);
          const float inv = 1.f / fmaxf(fabsf(den), expf(-mrow[t]));
          const int pos = dir ? Ls - 1 - (kk * 64 + t) : kk * 64 + t; const size_t row = rowbase + pos;
#pragma unroll
          for (int j = 0; j < 2; ++j) { const f32x4 o = oacc[j] * inv; *(f32x4*)(mlh + row * 256 + hh * 64 + (2 * grp + j) * 16 + quad * 4) = o; } }
        __syncthreads();
#pragma unroll
        for (int j = 0; j < 3; ++j) { const int dt = j < 2 ? 2 * grp + j : 4;
#pragma unroll
            for (int i = 0; i < 4; ++i) Cs[(dt * 16 + quad * 4 + i) * 72 + tt * 16 + fr] = f2bf(Cacc[j][i]); }
        if (tid == 0) sc[0] = sc[2];
    }
}

constexpr int MX_ML = 64, MX_HYL = 256, MX_GQAL = 256, MX_DIFL = 512, MX_GQAC = 32, MX_DIFC = 64, MX_HYC = 256;
constexpr int MX_TOTAL = MX_ML + MX_HYL + MX_GQAL + MX_DIFL + MX_GQAC + MX_DIFC + MX_HYC;

DEVI void mixer_phase(const Params& P, int cidx, int l, unsigned char* smem) {
    unsigned* ctr = (unsigned*)(opaque_ws(P) + WS_CTL) + cidx;
    int* s_item = (int*)smem;
    for (;;) {
        __syncthreads();
        if (threadIdx.x == 0) *s_item = (int)atomicAdd(ctr, 1u);
        __syncthreads();
        int it = *s_item;
        if (it >= (l == DEPTH - 1 ? MX_ML + MX_HYL + MX_GQAL + MX_DIFL : MX_TOTAL)) break;
        if (it < MX_ML) { ml_item(P, l, it >> 3, (it >> 1) & 3, it & 1, smem);
#ifdef PROBE_ML2
            __syncthreads(); ml_item(P, l, it >> 3, (it >> 1) & 3, it & 1, smem);
#endif
            continue; } it -= MX_ML;
#ifndef PROBE_MX
#define PROBE_MX 0
#endif
        if (it < MX_HYL) { for (int pr = 0; pr < (PROBE_MX == 1 ? 2 : 1); ++pr) { if (pr) __syncthreads(); hy_item<16>(P, l, it, smem); } continue; } it -= MX_HYL;
        if (it < MX_GQAL) { for (int pr = 0; pr < (PROBE_MX == 2 ? 2 : 1); ++pr) { if (pr) __syncthreads(); attn_item<false>(P, l, it >> 5, (it >> 4) & 1, it & 15, false, smem); } continue; } it -= MX_GQAL;
        if (it < MX_DIFL) { for (int pr = 0; pr < (PROBE_MX == 3 ? 2 : 1); ++pr) { if (pr) __syncthreads(); attn_item<true>(P, l, it >> 6, (it >> 4) & 3, it & 15, false, smem); } continue; } it -= MX_DIFL;
        if (it < MX_GQAC) { attn_item<false>(P, l, it >> 2, (it >> 1) & 1, it & 1, true, smem); continue; } it -= MX_GQAC;
        if (it < MX_DIFC) { attn_item<true>(P, l, it >> 3, (it >> 1) & 3, it & 1, true, smem); continue; } it -= MX_DIFC;
        hy_item<2>(P, l, it, smem);
    }
}

DEVI void final_phase(const Params& P, int l, unsigned char* smem) {
    const int tid = opaque_tid();
    const float* mlh0 = (const float*)(opaque_ws(P) + WS_MLH); const float* mlh1 = mlh0 + (size_t)MT * 256;
    const bf16_t* p = (const bf16_t*)(opaque_ws(P) + WS_P); const bf16_t* hyo = (const bf16_t*)(opaque_ws(P) + WS_HYO);
    bf16_t* cat = (bf16_t*)(opaque_ws(P) + WS_CAT);
    const float* ng = P.in[14] + (size_t)l * 256;
    bf16_t* lt = (bf16_t*)(smem + 1024);
    constexpr int TR = 32;
    const int ntile = ((l == DEPTH - 1 ? MLAT : MT) + TR - 1) / TR;
    for (int rt = opaque_bid(); rt < ntile; rt += gridDim.x) { const int row0 = rt * TR;
        for (int task = tid; task < TR * 64; task += 512) { const int r = task >> 6, c4 = (task & 63) * 4; const size_t row = row0 + r;
            const float4 a = *(const float4*)(mlh0 + row * 256 + c4), bq = *(const float4*)(mlh1 + row * 256 + c4);
            float4 h; h.x = a.x + bq.x; h.y = a.y + bq.y; h.z = a.z + bq.z; h.w = a.w + bq.w;
            float ss = h.x * h.x + h.y * h.y + h.z * h.z + h.w * h.w;
            ss += __shfl_xor(ss, 1); ss += __shfl_xor(ss, 2); ss += __shfl_xor(ss, 4); ss += __shfl_xor(ss, 8);
            const float rstd = rsqrtf(ss * (1.f / 64.f) + 1e-6f);
            const float4 g4 = *(const float4*)(ng + c4);
            const uint2 ov = *(const uint2*)(p + row * NP + 768 + c4);
            f32x4 y; y[0] = h.x * rstd * g4.x * sigmoid_fast(bflo(ov.x)); y[1] = h.y * rstd * g4.y * sigmoid_fast(bfhi(ov.x));
            y[2] = h.z * rstd * g4.z * sigmoid_fast(bflo(ov.y)); y[3] = h.w * rstd * g4.w * sigmoid_fast(bfhi(ov.y));
            *(uint2*)(cat + row * D + c4) = pack4(y); }
        for (int task = tid; task < 256 * (TR / 8); task += 512) { const int c = task / (TR / 8), ch = task % (TR / 8);
            const uint4 v = *(const uint4*)(hyo + (size_t)c * MT + row0 + ch * 8);
            bf16_t* d = lt + (size_t)(ch * 8) * 264 + c;
            d[0] = (bf16_t)(v.x & 0xffff); d[264] = (bf16_t)(v.x >> 16); d[528] = (bf16_t)(v.y & 0xffff); d[792] = (bf16_t)(v.y >> 16);
            d[1056] = (bf16_t)(v.z & 0xffff); d[1320] = (bf16_t)(v.z >> 16); d[1584] = (bf16_t)(v.w & 0xffff); d[1848] = (bf16_t)(v.w >> 16); }
        __syncthreads();
        for (int task = tid; task < TR * 32; task += 512) { const int r = task >> 5, c8 = (task & 31) * 8;
            *(uint4*)(cat + (size_t)(row0 + r) * D + 512 + c8) = *(const uint4*)(lt + (size_t)r * 264 + c8); }
        __syncthreads();
    }
}

#ifndef REPSTEP
#define REPSTEP -1
#endif
#define XBAR() do { XcdBarrier xb_; xb_.bar = (unsigned*)(opaque_ws(P) + WS_BAR); xb_.x = xb_xcc_id(); xb_.st = (volatile LAS3 unsigned*)(smem + 16); xcd_barrier(xb_); } while (0)
__global__ void __launch_bounds__(512) mega_fwd(Params P) {
    extern __shared__ __attribute__((aligned(16))) unsigned char smem[];
    cg::grid_group grid = cg::this_grid();
    if (threadIdx.x < 8) ((volatile LAS3 unsigned*)(smem + 16))[threadIdx.x] = 0u;
    __syncthreads();
    if (blockIdx.x == 0) { for (int i = threadIdx.x; i < (4096 + 16384) / 4; i += 512) ((unsigned*)(P.ws + WS_CTL))[i] = 0u; }
    phase0a(P, smem);
    grid.sync();
#ifdef PROBE_P0A
    phase0a(P, smem);
    grid.sync();
#endif
    (void)xcd_barrier_post((unsigned*)(opaque_ws(P) + WS_BAR), (volatile LAS3 unsigned*)(smem + 16));
    phase0b(P, smem);
    XBAR();
#ifdef PROBE_P0B
    phase0b(P, smem);
    XBAR();
#endif
    constexpr int NS = 10;
#ifdef PROBE_S
    unsigned long long pacc = 0;
#endif
#pragma unroll 1
    for (int step = 0; step < DEPTH * NS; ++step) {
        const int l = step / NS, s = step - l * NS;
#ifdef PROBE_S
        unsigned long long pt0 = 0; if (s == PROBE_S) pt0 = __builtin_amdgcn_s_memrealtime();
#endif
        if (s == 4) prep_phase(P, l, smem);
        else if (s == 5) mixer_phase(P, l, l, smem);
        else if (s == 6) final_phase(P, l, smem);
        else {
            int opA = 0, partA = 0, lA = l, opB = 0, partB = 0, B0 = 0, R = 0;
            const bool last = (l == DEPTH - 1);
            switch (s) {
            case 0: if (l > 0) { opA = 6; partA = 1; lA = l - 1; B0 = 32; R = 3; } opB = 1; break;
            case 1: opA = 2; opB = 1; partB = 1; break;
            case 2: opA = 2; partA = 1; opB = 3; B0 = 32; R = 3; break;
            case 3: opA = 3; partA = 1; break;
            case 7: opA = 4; break;
            case 8: if (!last) { opA = 4; partA = 1; B0 = 32; R = 1; } opB = 5; break;
            default: opA = 6; if (!last) { opB = 5; partB = 1; } break;
            }
#pragma unroll 1
            for (int jj = 0; jj < 2; ++jj) {
                const int op = jj ? opB : opA, part = jj ? partB : partA, lj = jj ? l : lA;
                if (op == 0) continue;
                unsigned char* ws = opaque_ws(P);
                const float* modl = (const float*)(ws + WS_MOD) + (size_t)lj * 9 * 9216;
                float* ssqb = (float*)(ws + WS_SSQ);
                GemmJob J;
                J.nM = part ? 8 : 64; J.pm0 = part ? 64 : 0; J.B0 = jj ? B0 : 0; J.R = jj ? R : 0; J.nK = 1; J.order = 0; J.K = 1024; J.ld = 1024;
                J.hl = P.out; J.hc = (float*)(ws + WS_HCTX); J.gates = (float*)(ws + WS_GATES); J.gb = P.in[11] + lj * 16;
                J.obf = nullptr; J.gate = modl; J.fac = 0.f; J.aout = nullptr; J.ng = P.in[6]; J.nscale = modl; J.ssq = ssqb; J.Sb = nullptr;
                if (op == 1 || op == 5) { const int f = op == 1 ? 0 : 1; J.A = (const bf16_t*)(ws + WS_A); J.Bt = (const bf16_t*)(ws + WS_W13) + (size_t)(lj * 2 + f) * 5632 * 1024; J.nN = 22; J.epi = 0; J.obf = (bf16_t*)(ws + WS_HID);
                    J.ssq = ssqb + (size_t)(lj * 3 + (f ? 2 : 0)) * MT; J.Sb = (const float*)(ws + WS_SB) + (size_t)(lj * 2 + f) * 9 * 5632; }
                else if (op == 2 || op == 6) { const int f = op == 2 ? 0 : 1; J.A = (const bf16_t*)(ws + WS_HID); J.Bt = (const bf16_t*)(ws + WS_W2) + (size_t)(lj * 2 + f) * 1024 * 2816; J.nN = 4; J.K = 2816; J.ld = 2816; J.epi = 1;
                    J.gate = modl + (f == 0 ? 2 : 8) * 1024; J.fac = 0.5f;
                    const bool fuse = (f == 0) || (lj + 1 < DEPTH); const int ln = (f == 1 && lj + 1 < DEPTH) ? lj + 1 : lj;
                    J.aout = fuse ? (bf16_t*)(ws + WS_A) : (bf16_t*)nullptr; J.ng = P.in[6] + (size_t)(ln * 3 + (f == 0 ? 1 : 0)) * 1024;
                    J.nscale = (const float*)(ws + WS_MOD) + (size_t)ln * 9 * 9216 + (f == 0 ? 4 : 1) * 1024; J.ssq = ssqb + (size_t)(ln * 3 + (f == 0 ? 1 : 0)) * MT; }
                else if (op == 3) { J.A = (const bf16_t*)(ws + WS_A); J.Bt = (const bf16_t*)(ws + WS_WIN) + (size_t)lj * NPG * 1024; J.nN = 13; J.epi = 2; J.obf = (bf16_t*)(ws + WS_P);
                    J.ssq = ssqb + (size_t)(lj * 3 + 1) * MT; J.Sb = (const float*)(ws + WS_SBIN) + (size_t)lj * 9 * NPG; }
                else { J.A = (const bf16_t*)(ws + WS_CAT); J.Bt = (const bf16_t*)(ws + WS_WOUT) + (size_t)lj * 1024 * 1024; J.nN = 4; J.epi = 1; J.gate = modl + 5 * 1024; J.fac = 1.f;
                    J.aout = (bf16_t*)(ws + WS_A); J.ng = P.in[6] + (size_t)(lj * 3 + 2) * 1024; J.nscale = modl + 7 * 1024; J.ssq = ssqb + (size_t)(lj * 3 + 2) * MT; }
                run_job(smem, J);
            }
        }
        XBAR();
#ifdef PROBE_S
        if (s == PROBE_S) pacc += __builtin_amdgcn_s_memrealtime() - pt0;
#endif
    }
#ifdef PROBE_EPI
    if (blockIdx.x == 0) { const unsigned pe = *(volatile LAS3 unsigned*)(smem + 32); const unsigned long long t1 = __builtin_amdgcn_s_memrealtime(); while (__builtin_amdgcn_s_memrealtime() - t1 < 4ull * pe) __builtin_amdgcn_s_sleep(8); }
#endif
#ifdef PROBE_S
    if (blockIdx.x == 0) { const unsigned long long t1 = __builtin_amdgcn_s_memrealtime(); while (__builtin_amdgcn_s_memrealtime() - t1 < 4ull * pacc) __builtin_amdgcn_s_sleep(8); }
#endif
}

extern "C" void kernel_launch(void* const* d_in, const int* in_sizes, int n_in, void* d_out, int out_size, void* d_ws, size_t ws_size, hipStream_t stream) {
    static int grid_blocks = 0;
    if (grid_blocks == 0) {
        if (n_in != 28 || ws_size < WS_END) { fprintf(stderr, "kernel_launch: unexpected n_in %d or ws_size %zu (need %zu)\n", n_in, ws_size, (size_t)WS_END); grid_blocks = -1; return; }
        int dev = 0, cus = 0, per_cu = 0;
        hipGetDevice(&dev);
        hipDeviceGetAttribute(&cus, hipDeviceAttributeMultiprocessorCount, dev);
        if (hipFuncSetAttribute((const void*)mega_fwd, hipFuncAttributeMaxDynamicSharedMemorySize, LDS_BYTES) != hipSuccess) { fprintf(stderr, "kernel_launch: hipFuncSetAttribute failed\n"); }
        if (hipOccupancyMaxActiveBlocksPerMultiprocessor(&per_cu, (const void*)mega_fwd, 512, LDS_BYTES) != hipSuccess || per_cu < 1) { fprintf(stderr, "kernel_launch: occupancy query gave %d\n", per_cu); per_cu = 1; }
        (void)hipGetLastError();
        grid_blocks = cus;
    }
    if (grid_blocks < 0) return;
    Params p{};
    for (int i = 0; i < 28; ++i) p.in[i] = (const float*)d_in[i];
    p.out = (float*)d_out; p.ws = (unsigned char*)d_ws;
    void* args[] = {&p};
    hipError_t e = hipLaunchCooperativeKernel((const void*)mega_fwd, dim3(grid_blocks), dim3(512), args, LDS_BYTES, stream);
    if (e != hipSuccess) fprintf(stderr, "cooperative launch failed: %s (grid %d)\n", hipGetErrorString(e), grid_blocks);
}
```

```cpp
#define REPSTEP -1
#include <hip/hip_runtime.h>
#include <hip/hip_cooperative_groups.h>
#include <cstdio>
namespace cg = cooperative_groups;
__device__ __forceinline__ int opaque_tid() { int t = threadIdx.x; asm volatile("" : "+v"(t)); return t; }
__device__ __forceinline__ int opaque_bid() { int b = blockIdx.x; asm volatile("" : "+s"(b)); return b; }
namespace pg8 {
#define PG8_LAS __attribute__((address_space(3)))
typedef unsigned short bf16_t;
typedef short bf16x8 __attribute__((ext_vector_type(8)));
typedef float f32x4 __attribute__((ext_vector_type(4)));
typedef unsigned u32x4 __attribute__((ext_vector_type(4)));
constexpr int BM = 256, BK = 64, HALF = 128, HTB = HALF * BK * 2  , STAGE_BYTES = 8 * HTB, NXCD = 8, WGM = 8;

__host__ __device__ __forceinline__ int lds_byte(int r, int c) { const int st = (r >> 4) * 2 + (c >> 5), rr = r & 15, cc = c & 31, ob = rr * 64 + cc * 2; return st * 1024 + (ob ^ (((ob >> 9) & 1) << 5)); }
__host__ __device__ __forceinline__ void stage_rc(int b, int& R, int& C) { const int st = b / 1024, sb = b % 1024, swz = sb ^ (((sb >> 9) & 1) << 5); R = (st >> 1) * 16 + swz / 64; C = (st & 1) * 32 + (swz % 64) / 2; }
__host__ __device__ __forceinline__ int perm32(int rho) { const int n = rho >> 4, i = rho & 15; return 8 * (i >> 2) + 4 * n + (i & 3); }

struct Unit { int pm, pn, kp; };
struct Gemm { const bf16_t* A; const bf16_t* Bt; int M, N, K, ld; };

struct StaticOrder {
    int nM, nN, nwg, G, c;
    __host__ __device__ void init(int M, int N, int G_, int c_) { nM = M / BM; nN = N / BM; nwg = nM * nN; G = G_; c = c_; }
    __host__ __device__ bool next(int i, Unit& u) const { return at((long)i * G + c, u); }
    __host__ __device__ bool at(const long L, Unit& u) const {
        if (L >= nwg) return false;
        int wgid = (int)L; { const int q = nwg / NXCD, r = nwg % NXCD, xcd = wgid % NXCD, off = wgid / NXCD; wgid = (xcd < r ? xcd * (q + 1) : r * (q + 1) + (xcd - r) * q) + off; }
        const int nig = WGM * nN, gid = wgid / nig, fm = gid * WGM, gsz = (nM - fm) < WGM ? (nM - fm) : WGM;
        u.pm = fm + ((wgid % nig) % gsz); u.pn = (wgid % nig) / gsz; u.kp = 0; return true;
    }
    __device__ __forceinline__ void a_ready(const Unit&) const {}
    __device__ __forceinline__ void done(const Unit&) const {}
};
struct SplitOrder {
    int nN, nK, total, G, c;
    __host__ __device__ void init(int nM_, int nN_, int nK_, int G_, int c_) { nN = nN_; nK = nK_; total = nM_ * nN_ * nK_; G = G_; c = c_; }
    __host__ __device__ bool next(int i, Unit& u) const { const int L = i * G + c; if (L >= total) return false; u.kp = L % nK; const int r = L / nK; u.pn = r % nN; u.pm = r / nN; return true; }
    __device__ __forceinline__ void a_ready(const Unit&) const {}
    __device__ __forceinline__ void done(const Unit&) const {}
};
__device__ __forceinline__ unsigned cvt_pk_bf16(float lo, float hi) { unsigned r; asm volatile("v_cvt_pk_bf16_f32 %0, %1, %2" : "=v"(r) : "v"(lo), "v"(hi)); return r; }
template <class Epi, class Sched, bool STAMP = false>
__device__ __forceinline__ void gemm_phase(PG8_LAS unsigned char* lds, const Gemm g, const Sched& S, const Epi& E, unsigned long long* stamps) {
    const int tid = opaque_tid(), wid = __builtin_amdgcn_readfirstlane(tid >> 6), lane = tid & 63, wr = wid >> 2, wc = wid & 3, fr = lane & 15, fq = lane >> 4;
    const int K = g.K, LD = g.ld, nt = K / BK;
    int ts_lo = 0, ts_hi = 0, nts = 0; const unsigned long long rt_entry = STAMP ? (unsigned long long)wall_clock64() : 0ull;
#define PG8_STAMP() do { if (STAMP && wid == 0 && nts < 64) { const unsigned long long _c = (unsigned long long)clock64(); \
        ts_lo = (lane == nts) ? (int)(unsigned)_c : ts_lo; ts_hi = (lane == nts) ? (int)(unsigned)(_c >> 32) : ts_hi; ++nts; } } while (0)
    PG8_STAMP();
    unsigned voffA[2], voffB[2];
#pragma unroll
    for (int i = 0; i < 2; ++i) { int R, C; stage_rc(tid * 16 + i * 8192, R, C); const int Rb = Epi::PERM ? ((R & ~31) + perm32(R & 31)) : R;
        voffA[i] = (unsigned)(R * LD + C) * 2u; voffB[i] = (unsigned)(Rb * LD + C) * 2u; }
    const size_t kstep = (size_t)(BK * 2);
    const size_t hstep = (size_t)HALF * LD * 2; const size_t kpstep = (size_t)K * 2;
    const size_t tstep = 2 * hstep;
    const unsigned ldsw = (unsigned)wid * 1024u;
    const int aoff = lds_byte(wr * 64 + fr, fq * 8), boff = lds_byte(wc * 32 + fr, fq * 8);
#define PG8_SA(b, h) (((b) * 2 + (h)) * HTB)
#define PG8_SB(b, h) ((4 + (b) * 2 + (h)) * HTB)
#define PG8_STAGE(bufoff, gbase, voff) do { _Pragma("unroll") for (int _i = 0; _i < 2; ++_i) \
        __builtin_amdgcn_global_load_lds((const unsigned*)((const char*)(gbase) + (voff)[_i]), (PG8_LAS unsigned*)(lds + (bufoff) + ldsw + _i * 8192), 16, 0, 0); } while (0)
#define PG8_LDA(dst, b, h) do { _Pragma("unroll") for (int m = 0; m < 4; ++m) _Pragma("unroll") for (int k = 0; k < 2; ++k) dst[m][k] = *(const PG8_LAS bf16x8*)(lds + PG8_SA(b, h) + aoff + m * 2048 + k * 1024); } while (0)
#define PG8_LDB(dst, b, h) do { _Pragma("unroll") for (int n = 0; n < 2; ++n) _Pragma("unroll") for (int k = 0; k < 2; ++k) dst[n][k] = *(const PG8_LAS bf16x8*)(lds + PG8_SB(b, h) + boff + n * 2048 + k * 1024); } while (0)
#define PG8_MMA(ai, bj, At, Bt) do { __builtin_amdgcn_s_setprio(1); _Pragma("unroll") for (int m = 0; m < 4; ++m) _Pragma("unroll") for (int n = 0; n < 2; ++n) _Pragma("unroll") for (int k = 0; k < 2; ++k) \
        acc[ai][bj][m][n] = __builtin_amdgcn_mfma_f32_16x16x32_bf16(Bt[n][k], At[m][k], acc[ai][bj][m][n], 0, 0, 0); __builtin_amdgcn_s_setprio(0); } while (0)
#define PG8_WAIT_V(n) asm volatile("s_waitcnt vmcnt(" #n ")" ::: "memory")
#define PG8_WAIT_L(n) asm volatile("s_waitcnt lgkmcnt(" #n ")" ::: "memory")
#define PG8_BAR __builtin_amdgcn_s_barrier()
#define PG8_SCHED __builtin_amdgcn_sched_barrier(0)
    Unit cur, nxt; int ui = 0;
    if (!S.next(0, cur)) return;
    f32x4 acc[2][2][4][2];
#pragma unroll
    for (int a = 0; a < 2; ++a)
#pragma unroll
        for (int b = 0; b < 2; ++b)
#pragma unroll
            for (int m = 0; m < 4; ++m)
#pragma unroll
                for (int n = 0; n < 2; ++n) acc[a][b][m][n] = (f32x4){0.f, 0.f, 0.f, 0.f};
    bf16x8 At[4][2], B0[2][2], B1[2][2];
    const char* cA = (const char*)g.A + (size_t)cur.pm * tstep + (size_t)cur.kp * kpstep; const char* cB = (const char*)g.Bt + (size_t)cur.pn * tstep + (size_t)cur.kp * kpstep;
    S.a_ready(cur);
    PG8_STAGE(PG8_SB(0, 0), cB, voffB); PG8_STAGE(PG8_SA(0, 0), cA, voffA); PG8_STAGE(PG8_SB(0, 1), cB + hstep, voffB); PG8_STAGE(PG8_SA(0, 1), cA + hstep, voffA);
    if (wr == 1) PG8_BAR;
    PG8_WAIT_V(4); PG8_BAR;
    PG8_STAGE(PG8_SB(1, 0), cB + kstep, voffB); PG8_STAGE(PG8_SA(1, 0), cA + kstep, voffA); PG8_STAGE(PG8_SB(1, 1), cB + hstep + kstep, voffB);
    PG8_WAIT_V(6); PG8_BAR;
    PG8_STAMP();
    for (;;) {
        const bool has_next = S.next(ui + 1, nxt);
        const char* nA = has_next ? (const char*)g.A + (size_t)nxt.pm * tstep + (size_t)nxt.kp * kpstep : cA; const char* nB = has_next ? (const char*)g.Bt + (size_t)nxt.pn * tstep + (size_t)nxt.kp * kpstep : cB;
        for (int t = 0; t < nt; t += 2) {
            const bool last = (t == nt - 2);
            const char* a1 = cA + (size_t)(t + 1) * kstep;
            const char* a2 = last ? nA : cA + (size_t)(t + 2) * kstep; const char* b2 = last ? nB : cB + (size_t)(t + 2) * kstep;
            const char* a3 = a2 + kstep; const char* b3 = b2 + kstep;
            if (last && has_next) S.a_ready(nxt);
            PG8_LDB(B0, 0, 0); PG8_SCHED; PG8_LDA(At, 0, 0); PG8_STAGE(PG8_SA(1, 1), a1 + hstep, voffA);
            PG8_WAIT_L(8); PG8_BAR; PG8_WAIT_L(0); PG8_MMA(0, 0, At, B0); PG8_BAR; PG8_SCHED;
            PG8_LDB(B1, 0, 1); PG8_STAGE(PG8_SB(0, 0), b2, voffB);
            PG8_BAR; PG8_WAIT_L(0); PG8_MMA(0, 1, At, B1); PG8_BAR;
            PG8_LDA(At, 0, 1); PG8_STAGE(PG8_SA(0, 0), a2, voffA);
            PG8_BAR; PG8_WAIT_L(0); PG8_MMA(1, 0, At, B0); PG8_BAR; PG8_SCHED;
            PG8_STAGE(PG8_SB(0, 1), b2 + hstep, voffB);
            PG8_WAIT_V(6); PG8_BAR; PG8_MMA(1, 1, At, B1); PG8_BAR;
            PG8_LDB(B0, 1, 0); PG8_SCHED; PG8_LDA(At, 1, 0); PG8_STAGE(PG8_SA(0, 1), a2 + hstep, voffA);
            PG8_WAIT_L(8); PG8_BAR; PG8_WAIT_L(0); PG8_MMA(0, 0, At, B0); PG8_BAR; PG8_SCHED;
            PG8_LDB(B1, 1, 1); PG8_STAGE(PG8_SB(1, 0), b3, voffB);
            PG8_BAR; PG8_WAIT_L(0); PG8_MMA(0, 1, At, B1); PG8_BAR;
            PG8_LDA(At, 1, 1); PG8_STAGE(PG8_SA(1, 0), a3, voffA);
            PG8_BAR; PG8_WAIT_L(0); PG8_MMA(1, 0, At, B0); PG8_BAR; PG8_SCHED;
            PG8_STAGE(PG8_SB(1, 1), b3 + hstep, voffB);
            PG8_WAIT_V(6); PG8_BAR; PG8_MMA(1, 1, At, B1); PG8_BAR;
        }
        PG8_STAMP();
#ifdef PROBE_EPI
        const unsigned long long pe0 = __builtin_amdgcn_s_memrealtime();
#endif
        if constexpr (!Epi::AFTER_DRAIN) { E(acc, cur, nxt, has_next, wr, wc, fr, fq); S.done(cur); }
#ifdef PROBE_EPI
        asm volatile("s_waitcnt vmcnt(0)" ::: "memory");
        if (tid == 0) { *(volatile PG8_LAS unsigned*)(lds - 1024 + 32) += (unsigned)(__builtin_amdgcn_s_memrealtime() - pe0); }
#endif
        PG8_STAMP();
        if (!has_next) break;
#pragma unroll
        for (int a = 0; a < 2; ++a)
#pragma unroll
            for (int b = 0; b < 2; ++b)
#pragma unroll
                for (int m = 0; m < 4; ++m)
#pragma unroll
                    for (int n = 0; n < 2; ++n) acc[a][b][m][n] = (f32x4){0.f, 0.f, 0.f, 0.f};
        cur = nxt; cA = nA; cB = nB; ++ui;
    }
    PG8_WAIT_V(0);
    if (wr == 0) PG8_BAR;
    PG8_BAR;
    if constexpr (Epi::AFTER_DRAIN) { E.fused(acc, cur, wr, wc, fr, fq, lds, wid, lane); S.done(cur); }
    PG8_STAMP();
    if (STAMP && wid == 0) { stamps[lane] = lane < nts ? (((unsigned long long)(unsigned)ts_hi << 32) | (unsigned)ts_lo) : 0ull;
        if (lane == 62) stamps[62] = rt_entry; if (lane == 63) stamps[63] = (unsigned long long)wall_clock64(); }
#undef PG8_STAMP
#undef PG8_SA
#undef PG8_SB
#undef PG8_STAGE
#undef PG8_LDA
#undef PG8_LDB
#undef PG8_MMA
#undef PG8_WAIT_V
#undef PG8_WAIT_L
#undef PG8_BAR
#undef PG8_SCHED
}
}

using pg8::bf16_t; using pg8::bf16x8; using pg8::f32x4;
#define DEVI __device__ __forceinline__
#define LAS3 __attribute__((address_space(3)))
#define G1 __attribute__((address_space(1)))

constexpr int D = 1024, NB = 8, SEQ = 2048, CTX = 256, DEPTH = 4, FF = 2816, NIN = 3088, NP = 3072, NPG = 3328;
constexpr int MLAT = NB * SEQ, MCTX = NB * CTX, MT = MLAT + MCTX, KEYS = CTX + SEQ;
constexpr float LOG2E = 1.4426950408889634f;
constexpr int LDS_BYTES = 160 * 1024;
#ifndef SKIPMASK
#define SKIPMASK 0
#endif
#ifndef GM
#define GM 0
#endif
#ifndef P0M
#define P0M 0
#endif

constexpr size_t al256(size_t x) { return (x + 255) & ~(size_t)255; }
constexpr size_t WS_CTL = 0;
constexpr size_t WS_BAR = 4096;
constexpr size_t WS_MOD = 4096 + 16384;
constexpr size_t WS_W13 = WS_MOD + al256((size_t)DEPTH * 9 * 9216 * 4);
constexpr size_t WS_W2 = WS_W13 + al256((size_t)DEPTH * 2 * 5632 * 1024 * 2);
constexpr size_t WS_WIN = WS_W2 + al256((size_t)DEPTH * 2 * 1024 * 2816 * 2);
constexpr size_t WS_WOUT = WS_WIN + al256((size_t)DEPTH * NPG * 1024 * 2);
constexpr size_t WS_HF = WS_WOUT + al256((size_t)DEPTH * 1024 * 1024 * 2);
constexpr size_t HF_LAYER = (size_t)512 * (SEQ + CTX);
constexpr size_t WS_HFS = WS_HF + al256((size_t)DEPTH * HF_LAYER * 4);
constexpr size_t WS_ROPEG = WS_HFS + al256((size_t)DEPTH * 36 * 512 * 4);
constexpr size_t WS_ROPED = WS_ROPEG + al256((size_t)SEQ * 64 * 4);
constexpr size_t WS_HCTX = WS_ROPED + al256((size_t)SEQ * 32 * 4);
constexpr size_t WS_A = WS_HCTX + al256((size_t)MCTX * D * 4);
constexpr size_t WS_P = WS_A + al256((size_t)MT * D * 2);
constexpr size_t WS_HID = WS_P + al256((size_t)MT * NP * 2);
constexpr size_t WS_GATES = WS_HID + al256((size_t)MT * FF * 2);
constexpr size_t WS_CAT = WS_GATES + al256((size_t)MT * 16 * 4);
constexpr size_t WS_Q = WS_CAT + al256((size_t)MT * D * 2);
constexpr size_t WS_K = WS_Q + al256((size_t)NB * 8 * KEYS * 64 * 2);
constexpr size_t WS_VT = WS_K + al256((size_t)NB * 6 * KEYS * 64 * 2);
constexpr size_t WS_MLQK = WS_VT + al256((size_t)NB * 6 * KEYS * 64 * 2);
constexpr size_t WS_HYU = WS_MLQK + al256((size_t)MT * 512 * 4);
constexpr size_t WS_HYO = WS_HYU + al256((size_t)768 * MT * 2);
constexpr size_t WS_MLH = WS_HYO + al256((size_t)256 * MT * 2);
constexpr size_t WS_SB = WS_MLH + al256((size_t)2 * MT * 256 * 4);
constexpr size_t WS_SBIN = WS_SB + al256((size_t)DEPTH * 2 * 9 * 5632 * 4);
constexpr size_t WS_SSQ = WS_SBIN + al256((size_t)DEPTH * 9 * NPG * 4);
constexpr size_t WS_END = WS_SSQ + al256((size_t)DEPTH * 3 * MT * 4);
static_assert((size_t)MT * FF * 2 <= (size_t)MT * NP * 2, "HID must fit in P region");

struct Params { const float* in[28]; float* out; unsigned char* ws; };
__device__ __forceinline__ unsigned char* opaque_ws(const Params& P) { unsigned char* w = P.ws; asm volatile("" : "+s"(w)); return w; }

DEVI bf16_t f2bf(float f) { unsigned u = __float_as_uint(f); u += 0x7FFFu + ((u >> 16) & 1u); return (bf16_t)(u >> 16); }
typedef __bf16 bf16x2_t __attribute__((ext_vector_type(2)));
DEVI unsigned pack2(float lo, float hi) { bf16x2_t v; v[0] = (__bf16)lo; v[1] = (__bf16)hi; return __builtin_bit_cast(unsigned, v); }
DEVI float bflo(unsigned u) { return __uint_as_float(u << 16); }
DEVI float bfhi(unsigned u) { return __uint_as_float(u & 0xffff0000u); }
DEVI float bf2f(bf16_t b) { return __uint_as_float(((unsigned)b) << 16); }
DEVI float wave_sum(float v) { for (int o = 32; o; o >>= 1) v += __shfl_xor(v, o); return v; }
DEVI float wave_max(float v) { for (int o = 32; o; o >>= 1) v = fmaxf(v, __shfl_xor(v, o)); return v; }
DEVI float silu_fast(float a) { return a * __builtin_amdgcn_rcpf(1.f + __builtin_amdgcn_exp2f(a * -1.4426950408889634f)); }
DEVI float silu_prec(float a) { return a / (1.f + expf(-a)); }
DEVI float sigmoid_fast(float a) { return __builtin_amdgcn_rcpf(1.f + __builtin_amdgcn_exp2f(a * -1.4426950408889634f)); }
DEVI float logsigmoid(float x) { return x >= 0.f ? -log1pf(expf(-x)) : x - log1pf(expf(x)); }
DEVI uint2 pack4(f32x4 v) { uint2 r; r.x = pack2(v[0], v[1]); r.y = pack2(v[2], v[3]); return r; }
typedef unsigned u32x2 __attribute__((ext_vector_type(2)));
DEVI u32x2 pack4v(f32x4 v) { u32x2 r; r[0] = pack2(v[0], v[1]); r[1] = pack2(v[2], v[3]); return r; }
DEVI f32x4 mfma16(bf16x8 a, bf16x8 b, f32x4 c) { return __builtin_amdgcn_mfma_f32_16x16x32_bf16(a, b, c, 0, 0, 0); }


#define XB_TMO      128
#define XB_XCNT(j)  (256  + 64 * (j))
#define XB_XSUB(j)  (1280 + 64 * (j))
#define XB_XGEN(j)  (2304 + 64 * (j))
#define XB_TOP      3328
#define XB_TOPGEN   3392
#define XCD_BAR_WORDS 3456
#define XB_SPIN_CAP (1u << 20)
DEVI unsigned xb_ld(unsigned* p)              { return __hip_atomic_load(p, __ATOMIC_RELAXED, __HIP_MEMORY_SCOPE_AGENT); }
DEVI unsigned xb_add(unsigned* p, unsigned v) { return __hip_atomic_fetch_add(p, v, __ATOMIC_RELAXED, __HIP_MEMORY_SCOPE_AGENT); }
DEVI unsigned xb_xcc_id() { return (unsigned)__builtin_amdgcn_s_getreg((3 << 11) | 20) & 0xFu; }
#define XB_SPIN(cond, bar) do { unsigned _sp = 0; while (cond) { __builtin_amdgcn_s_sleep(1); \
    if ((++_sp & 255u) == 0u) { if (xb_ld(&(bar)[XB_TMO])) break; if (_sp > XB_SPIN_CAP) { atomicAdd(&(bar)[XB_TMO], 1u); break; } } } } while (0)
struct XcdBarrier { unsigned* bar; unsigned x; volatile LAS3 unsigned* st; };
DEVI XcdBarrier xcd_barrier_post(unsigned* bar, volatile LAS3 unsigned* st) {
    XcdBarrier b; b.bar = bar; b.x = xb_xcc_id(); b.st = st;
    if (threadIdx.x == 0) (void)xb_add(&bar[XB_XCNT(b.x)], 1u);
    return b;
}
DEVI void xcd_barrier_complete(unsigned* bar, unsigned x, unsigned& nloc, unsigned& nx) {
    const unsigned G = gridDim.x * gridDim.y * gridDim.z;
    unsigned sum, cnt, mine, sp = 0u;
    for (;;) {
        sum = 0u; cnt = 0u; mine = 0u;
#pragma unroll
        for (unsigned j = 0; j < 16; ++j) { const unsigned c = xb_ld(&bar[XB_XCNT(j)]); sum += c; cnt += (c > 0u) ? 1u : 0u; mine = (j == x) ? c : mine; }
        if (sum == G) break;
        __builtin_amdgcn_s_sleep(1);
        if ((++sp & 255u) == 0u) { if (xb_ld(&bar[XB_TMO])) break; if (sp > XB_SPIN_CAP) { atomicAdd(&bar[XB_TMO], 1u); break; } }
    }
    nloc = mine > 0u ? mine : 1u; nx = cnt > 0u ? cnt : 1u;
}
#ifndef USE_XCD
#define USE_XCD 1
#endif
DEVI void xcd_barrier(const XcdBarrier& b) {
#if !USE_XCD
    cg::this_grid().sync(); return;
#endif
    asm volatile("s_waitcnt vmcnt(0)" ::: "memory");
    __syncthreads();
    if (threadIdx.x == 0) {
        unsigned* bar = b.bar;
        __builtin_amdgcn_s_waitcnt(0);
        unsigned nloc = b.st[0], nx = b.st[1];
        if (nloc == 0u) { xcd_barrier_complete(bar, b.x, nloc, nx); b.st[0] = nloc; b.st[1] = nx; }
        const unsigned old = xb_add(&bar[XB_XSUB(b.x)], 1u);
        const unsigned gen = old / nloc;
        if (old + 1u == (gen + 1u) * nloc) {
            __builtin_amdgcn_fence(__ATOMIC_RELEASE, "agent");
            asm volatile("s_waitcnt vmcnt(0)" ::: "memory");
            const unsigned og = xb_add(&bar[XB_TOP], 1u);
            const unsigned tg = og / nx;
            if (og + 1u == (tg + 1u) * nx) xb_add(&bar[XB_TOPGEN], 1u);
            else XB_SPIN(xb_ld(&bar[XB_TOPGEN]) == tg, bar);
            __builtin_amdgcn_fence(__ATOMIC_ACQUIRE, "agent");
            xb_add(&bar[XB_XGEN(b.x)], 1u);
            asm volatile("s_waitcnt vmcnt(0)" ::: "memory");
        } else {
            XB_SPIN(xb_ld(&bar[XB_XGEN(b.x)]) == gen, bar);
            __builtin_amdgcn_fence(__ATOMIC_ACQUIRE, "agent");
            asm volatile("s_waitcnt vmcnt(0)" ::: "memory");
        }
    }
    __syncthreads();
}

constexpr int EPW_OFF = 1024 + 131072, EPW_STRIDE = 192 * 4;
DEVI void epw_fill(unsigned char* smem, int mode, const pg8::Unit& u, int wid, int lane, const float* ssq_, const float* Sb_, int sbstride, float (&v)[3]) {
    const G1 float* ssq = (const G1 float*)ssq_; const G1 float* Sb = (const G1 float*)Sb_;
    const int wr = wid >> 2, wc = wid & 3; const int r9 = u.pm < 64 ? (u.pm >> 3) : 8;
#pragma unroll
    for (int k = 0; k < 2; ++k) { const int idx = lane + 64 * k; const int ai = idx >> 6, m = (idx >> 4) & 3, f = idx & 15; v[k] = ssq[u.pm * 256 + ai * 128 + wr * 64 + m * 16 + f]; }
    { const int bj = lane >> 5, c = lane & 31; v[2] = Sb[(size_t)r9 * sbstride + u.pn * 256 + bj * 128 + wc * 32 + c]; }
    (void)mode; (void)smem;
}
DEVI void epw_store(unsigned char* smem, int wid, int lane, const float (&v)[3]) {
    float* w = (float*)(smem + EPW_OFF + wid * EPW_STRIDE);
    w[lane] = rsqrtf(v[0] * (1.f / 1024.f) + 1e-6f); w[64 + lane] = rsqrtf(v[1] * (1.f / 1024.f) + 1e-6f); w[128 + lane] = v[2];
}
struct EpiSwiglu {
    static constexpr bool PERM = false, AFTER_DRAIN = false;
    static DEVI void apply(const f32x4 (&acc)[2][2][4][2], const pg8::Unit& u, int wr, int wc, int fr, int fq, bf16_t* H_, const float* epw) {
        G1 bf16_t* H = (G1 bf16_t*)H_;
        const int row0 = u.pm * 256 + wr * 64 + fr, col0 = u.pn * 128 + wc * 32 + 4 * fq;
        f32x4 sa[2], sb[2];
#pragma unroll
        for (int n = 0; n < 2; ++n) { sa[n] = *(const f32x4*)(epw + 128 + n * 16 + 4 * fq); sb[n] = *(const f32x4*)(epw + 160 + n * 16 + 4 * fq); }
#pragma unroll
        for (int ai = 0; ai < 2; ++ai)
#pragma unroll
            for (int m = 0; m < 4; ++m) { const int row = row0 + ai * 128 + m * 16; G1 bf16_t* rowp = H + (size_t)row * FF + col0;
                const float rstd = epw[(ai * 4 + m) * 16 + fr];
#pragma unroll
                for (int n = 0; n < 2; ++n) { const f32x4 a = acc[ai][0][m][n] * rstd + sa[n], b = acc[ai][1][m][n] * rstd + sb[n]; f32x4 v;
#pragma unroll
                    for (int i = 0; i < 4; ++i) v[i] = silu_fast(a[i]) * b[i];
                    *(G1 u32x2*)(rowp + n * 16) = pack4v(v); } }
    }
};
struct EpiResid {
    static constexpr bool PERM = false, AFTER_DRAIN = false;
    static DEVI void apply(const f32x4 (&acc)[2][2][4][2], const pg8::Unit& u, int wr, int wc, int fr, int fq, float* hl_, float* hc_, const float* gate_, float fac, bf16_t* aout_, const float* ng_, const float* nscale_, float* ssq_) {
        G1 float* hl = (G1 float*)hl_; G1 float* hc = (G1 float*)hc_; const G1 float* gate = (const G1 float*)gate_; G1 bf16_t* aout = (G1 bf16_t*)aout_; const G1 float* ng = (const G1 float*)ng_; const G1 float* nscale = (const G1 float*)nscale_;
        const int row0 = u.pm * 256 + wr * 64 + fr, col0 = u.pn * 256 + wc * 32 + 4 * fq;
        const int r9 = u.pm < 64 ? (u.pm >> 3) : 8;
        const G1 float* gp = gate + (size_t)r9 * 9216 + col0;
        f32x4 gv[2][2];
#pragma unroll
        for (int bj = 0; bj < 2; ++bj)
#pragma unroll
            for (int n = 0; n < 2; ++n) gv[bj][n] = *(const G1 f32x4*)(gp + bj * 128 + n * 16) * fac;
        if (aout_ == nullptr) {
#pragma unroll
            for (int ai = 0; ai < 2; ++ai)
#pragma unroll
                for (int m = 0; m < 4; ++m) { const int row = row0 + ai * 128 + m * 16;
                    G1 float* rowp = (row < MLAT ? hl + (size_t)row * D : hc + (size_t)(row - MLAT) * D) + col0;
#pragma unroll
                    for (int bj = 0; bj < 2; ++bj)
#pragma unroll
                        for (int n = 0; n < 2; ++n) { G1 f32x4* p = (G1 f32x4*)(rowp + bj * 128 + n * 16); *p = *p + gv[bj][n] * acc[ai][bj][m][n]; } }
        } else {
            f32x4 gs[2][2];
#pragma unroll
            for (int bj = 0; bj < 2; ++bj)
#pragma unroll
                for (int n = 0; n < 2; ++n) { const int c = col0 + bj * 128 + n * 16; gs[bj][n] = *(const G1 f32x4*)(ng + c) * (*(const G1 f32x4*)(nscale + (size_t)r9 * 9216 + c) + 1.f); }
#pragma unroll
            for (int ai = 0; ai < 2; ++ai)
#pragma unroll
                for (int m = 0; m < 4; ++m) { const int row = row0 + ai * 128 + m * 16;
                    G1 float* rowp = (row < MLAT ? hl + (size_t)row * D : hc + (size_t)(row - MLAT) * D) + col0;
                    G1 bf16_t* ap = aout + (size_t)row * D + col0;
                    float ss = 0.f;
#pragma unroll
                    for (int bj = 0; bj < 2; ++bj)
#pragma unroll
                        for (int n = 0; n < 2; ++n) { G1 f32x4* p = (G1 f32x4*)(rowp + bj * 128 + n * 16); const f32x4 hn = *p + gv[bj][n] * acc[ai][bj][m][n]; *p = hn;
                            ss += hn[0] * hn[0] + hn[1] * hn[1] + hn[2] * hn[2] + hn[3] * hn[3];
                            *(G1 u32x2*)(ap + bj * 128 + n * 16) = pack4v(hn * gs[bj][n]); }
                    ss += __shfl_xor(ss, 16); ss += __shfl_xor(ss, 32);
                    if (fq == 0) atomicAdd((float*)((G1 float*)ssq_ + row), ss); }
        }
    }
};
struct EpiP {
    static constexpr bool PERM = false, AFTER_DRAIN = false;
    static DEVI void apply(const f32x4 (&acc)[2][2][4][2], const pg8::Unit& u, int wr, int wc, int fr, int fq, bf16_t* Pp_, const float* epw, float* gates_, const float* gb_) {
        G1 bf16_t* Pp = (G1 bf16_t*)Pp_; G1 float* gates = (G1 float*)gates_; const G1 float* gb = (const G1 float*)gb_;
        const int row0 = u.pm * 256 + wr * 64 + fr, col0 = u.pn * 256 + wc * 32 + 4 * fq;
        if (u.pn < 12) {
            f32x4 sv[2][2];
#pragma unroll
            for (int bj = 0; bj < 2; ++bj)
#pragma unroll
                for (int n = 0; n < 2; ++n) sv[bj][n] = *(const f32x4*)(epw + 128 + bj * 32 + n * 16 + 4 * fq);
#pragma unroll
            for (int ai = 0; ai < 2; ++ai)
#pragma unroll
                for (int m = 0; m < 4; ++m) { const int row = row0 + ai * 128 + m * 16; G1 bf16_t* rowp = Pp + (size_t)row * NP + col0;
                    const float rstd = epw[(ai * 4 + m) * 16 + fr];
#pragma unroll
                    for (int bj = 0; bj < 2; ++bj)
#pragma unroll
                        for (int n = 0; n < 2; ++n) *(G1 u32x2*)(rowp + bj * 128 + n * 16) = pack4v(acc[ai][bj][m][n] * rstd + sv[bj][n]); }
        } else if (wc == 0) {
            const f32x4 sv = *(const f32x4*)(epw + 128 + 4 * fq) + *(const G1 f32x4*)(gb + 4 * fq);
#pragma unroll
            for (int ai = 0; ai < 2; ++ai)
#pragma unroll
                for (int m = 0; m < 4; ++m) { const int row = row0 + ai * 128 + m * 16;
                    const float rstd = epw[(ai * 4 + m) * 16 + fr];
                    *(G1 f32x4*)(gates + (size_t)row * 16 + 4 * fq) = acc[ai][0][m][0] * rstd + sv; }
        }
    }
};
template <class Epi> DEVI void run_gemm(unsigned char* smem, const bf16_t* A, const bf16_t* Bt, int Mrows, int N, int K, const Epi& E) {
    pg8::StaticOrder S; S.init(Mrows, N, (int)gridDim.x, opaque_bid());
    pg8::Gemm g; g.A = A; g.Bt = Bt; g.M = Mrows; g.N = N; g.K = K; g.ld = K;
    pg8::gemm_phase<Epi, pg8::StaticOrder, false>((LAS3 unsigned char*)(smem + 1024), g, S, E, nullptr);
}
template <class Epi> DEVI void run_gemm_split(unsigned char* smem, const bf16_t* A, const bf16_t* Bt, int nM, int nN, int K, int KP, const Epi& E) {
    pg8::SplitOrder S; S.init(nM, nN, K / KP, (int)gridDim.x, opaque_bid());
    pg8::Gemm g; g.A = A; g.Bt = Bt; g.M = nM * 256; g.N = nN * 256; g.K = KP; g.ld = K;
    pg8::gemm_phase<Epi, pg8::SplitOrder, false>((LAS3 unsigned char*)(smem + 1024), g, S, E, nullptr);
}
struct EpiResidCtxAtomic {
    static constexpr bool PERM = false, AFTER_DRAIN = false;
    static DEVI void apply(const f32x4 (&acc)[2][2][4][2], const pg8::Unit& u, int wr, int wc, int fr, int fq, float* hc, const float* gate, float fac) {
        const int row0 = u.pm * 256 + wr * 64 + fr, col0 = u.pn * 256 + wc * 32 + 4 * fq;
        const float* gp = gate + (size_t)8 * 9216 + col0;
#pragma unroll
        for (int bj = 0; bj < 2; ++bj)
#pragma unroll
            for (int n = 0; n < 2; ++n) { const f32x4 gv = *(const f32x4*)(gp + bj * 128 + n * 16) * fac;
                float* cp = hc + (size_t)row0 * D + col0 + bj * 128 + n * 16;
#pragma unroll
                for (int ai = 0; ai < 2; ++ai)
#pragma unroll
                    for (int m = 0; m < 4; ++m) { const f32x4 v = gv * acc[ai][bj][m][n]; float* q = cp + (size_t)(ai * 128 + m * 16) * D;
#pragma unroll
                        for (int i = 0; i < 4; ++i) unsafeAtomicAdd(q + i, v[i]); } }
    }
};


struct UniOrder {
    int mode; pg8::StaticOrder so; pg8::SplitOrder sp; int pm0, B0, R;
    DEVI bool next(int i, pg8::Unit& u) const {
        if (mode) return sp.next(i, u);
        const int G = so.G, c = so.c; long L;
        if (c < B0) L = (long)R * (G - B0) + (long)i * G + c;
        else L = i < R ? (long)i * (G - B0) + (c - B0) : (long)R * (G - B0) + (long)(i - R) * G + c;
        if (!so.at(L, u)) return false;
        u.pm += pm0; return true; }
    DEVI void a_ready(const pg8::Unit&) const {}
    DEVI void done(const pg8::Unit&) const {}
};
struct GemmJob { const bf16_t* A; const bf16_t* Bt; int nM, nN, nK, K, ld, order, epi, pm0, B0, R; bf16_t* obf; float* hl; float* hc; const float* gate; float fac; bf16_t* aout; const float* ng; const float* nscale; float* ssq; const float* Sb; float* gates; const float* gb; };
struct EpiParams { int mode; float fac; bf16_t* obf; float* hl; float* hc; const float* gate; bf16_t* aout; const float* ng; const float* nscale; float* ssq; const float* Sb; float* gates; const float* gb; };
struct UniEpi {
    static constexpr bool PERM = false, AFTER_DRAIN = false;
    const EpiParams* ep; unsigned char* smem;
    DEVI void operator()(const f32x4 (&acc)[2][2][4][2], const pg8::Unit& u, const pg8::Unit& nx, bool has_next, int wr, int wc, int fr, int fq) const {
        const int mode = __builtin_amdgcn_readfirstlane(ep->mode);
        if (mode == 1) { EpiResid::apply(acc, u, wr, wc, fr, fq, ep->hl, ep->hc, ep->gate, ep->fac, ep->aout, ep->ng, ep->nscale, ep->ssq); return; }
        const int wid = wr * 4 + wc, lane = fq * 16 + fr;
        const float* epw = (const float*)(smem + EPW_OFF + wid * EPW_STRIDE);
        float pf[3] = {1.f, 1.f, 0.f};
        if (has_next) epw_fill(smem, mode, nx, wid, lane, ep->ssq, ep->Sb, mode == 0 ? 5632 : NPG, pf);
        if (mode == 0) EpiSwiglu::apply(acc, u, wr, wc, fr, fq, ep->obf, epw);
        else EpiP::apply(acc, u, wr, wc, fr, fq, ep->obf, epw, ep->gates, ep->gb);
        if (has_next) epw_store(smem, wid, lane, pf);
    }
};
DEVI void run_job(unsigned char* smem, const GemmJob& J) {
    UniOrder S; S.mode = J.order; S.so.init(J.nM * 256, J.nN * 256, (int)gridDim.x, opaque_bid()); S.sp.init(J.nM, J.nN, J.nK, (int)gridDim.x, opaque_bid()); S.pm0 = J.pm0; S.B0 = J.B0; S.R = J.R;
    pg8::Gemm g; g.A = J.A; g.Bt = J.Bt; g.M = J.nM * 256; g.N = J.nN * 256; g.K = J.K; g.ld = J.ld;
    EpiParams* ep = (EpiParams*)(smem + 64);
    __syncthreads();
    if (threadIdx.x == 0) { ep->mode = J.epi; ep->fac = J.fac; ep->obf = J.obf; ep->hl = J.hl; ep->hc = J.hc; ep->gate = J.gate; ep->aout = J.aout; ep->ng = J.ng; ep->nscale = J.nscale; ep->ssq = J.ssq; ep->Sb = J.Sb; ep->gates = J.gates; ep->gb = J.gb; }
    __syncthreads();
    UniEpi E; E.ep = ep; E.smem = smem;
    if (J.epi != 1) { pg8::Unit u0; if (S.next(0, u0)) { const int tid_ = opaque_tid(); float pf[3]; epw_fill(smem, J.epi, u0, tid_ >> 6, tid_ & 63, J.ssq, J.Sb, J.epi == 0 ? 5632 : NPG, pf); epw_store(smem, tid_ >> 6, tid_ & 63, pf); } }
    pg8::gemm_phase<UniEpi, UniOrder, false>((LAS3 unsigned char*)(smem + 1024), g, S, E, nullptr);
}

DEVI int colmap(int type, int n) {
    if (type == 0) { const int pn = n >> 8, bj = (n >> 7) & 1, jj = n & 127; return bj * FF + pn * 128 + jj; }
    if (type == 2) return n < 1024 ? n : (n < 3072 ? n + 16 : (n < 3088 ? n - 3072 + 1024 : -1));
    return n;
}
DEVI void convert_tile(const float* __restrict__ src, int Nsrc, int K, int type, bf16_t* __restrict__ dst, int kt, int nt, float* lt) {
    const int tid = opaque_tid(), k0 = kt * 64, n0 = nt * 256;
    { const int nn = tid & 255, kk0 = tid >> 8; const int col = colmap(type, n0 + nn);
      const float* s = src + (size_t)k0 * Nsrc + (col < 0 ? 0 : col);
#pragma unroll 8
      for (int i = 0; i < 32; ++i) { const int kk = kk0 + 2 * i; const float v = s[(size_t)kk * Nsrc]; lt[nn * 65 + kk] = col < 0 ? 0.f : v; } }
    __syncthreads();
    { const int kp = (tid & 31) * 2, nn0 = tid >> 5;
#pragma unroll 4
      for (int i = 0; i < 16; ++i) { const int nn = nn0 + 16 * i;
          *(unsigned*)(dst + (size_t)(n0 + nn) * K + k0 + kp) = pack2(lt[nn * 65 + kp], lt[nn * 65 + kp + 1]); } }
    __syncthreads();
}

DEVI void filt_item(const Params& P, int l, int tile, float* lds) {
    const int tid = opaque_tid();
    const int Lsel = tile >= 32; const int L = Lsel ? CTX : SEQ; const int t0 = (Lsel ? tile - 32 : tile) * 64;
    float* feats = lds; float* h1 = lds + 64 * 33; float* h2 = h1 + 64 * 65;
#pragma unroll 1
    for (int idx = tid; idx < 64 * 33; idx += 512) { const int r = idx / 33, f = idx - r * 33; const int t = t0 + r; float v;
        if (f == 0) v = (float)t / (float)L;
        else { const int band = f <= 16 ? f : f - 16; const int x = (t * band) & (L - 1); const float ang = 6.283185307179586f * ((float)x / (float)L); v = f <= 16 ? cosf(ang) : sinf(ang); }
        feats[idx] = v; }
    __syncthreads();
    const float* w1 = P.in[18] + (size_t)l * 33 * 64; const float* b1 = P.in[19] + l * 64;
    const float* w2 = P.in[20] + (size_t)l * 64 * 64; const float* b2 = P.in[21] + l * 64;
    const float* w3 = P.in[22] + (size_t)l * 64 * 512; const float* b3 = P.in[23] + l * 512;
    { const int j = tid & 63, r0 = tid >> 6; float acc[8];
#pragma unroll
      for (int i = 0; i < 8; ++i) acc[i] = b1[j];
      for (int f = 0; f < 33; ++f) { const float w = w1[f * 64 + j];
#pragma unroll
          for (int i = 0; i < 8; ++i) acc[i] += feats[(r0 + 8 * i) * 33 + f] * w; }
#pragma unroll
      for (int i = 0; i < 8; ++i) h1[(r0 + 8 * i) * 65 + j] = acc[i]; }
    __syncthreads();
#pragma unroll 1
    for (int idx = tid; idx < 64 * 64; idx += 512) { const int a = (idx >> 6) * 65 + (idx & 63); h1[a] = sinf(h1[a]); }
    __syncthreads();
    { const int j = tid & 63, r0 = tid >> 6; float acc[8];
#pragma unroll
      for (int i = 0; i < 8; ++i) acc[i] = b2[j];
      for (int f = 0; f < 64; ++f) { const float w = w2[f * 64 + j];
#pragma unroll
          for (int i = 0; i < 8; ++i) acc[i] += h1[(r0 + 8 * i) * 65 + f] * w; }
#pragma unroll
      for (int i = 0; i < 8; ++i) h2[(r0 + 8 * i) * 65 + j] = acc[i]; }
    __syncthreads();
#pragma unroll 1
    for (int idx = tid; idx < 64 * 64; idx += 512) { const int a = (idx >> 6) * 65 + (idx & 63); h2[a] = sinf(h2[a]); }
    __syncthreads();
    { const int c = tid; const float bb = b3[c]; const int cc = c & 255;
      const float da = -3.0701134573253946f, db = -15.350567286626973f;
      const float delta = fabsf(da + (db - da) * ((float)cc / 255.f));
      float cs = 0.f;
      float* hf = (float*)(opaque_ws(P) + WS_HF) + (size_t)l * HF_LAYER + (Lsel ? (size_t)512 * SEQ : 0) + (size_t)c * L + t0;
#pragma unroll 1
      for (int rh = 0; rh < 4; ++rh) { float acc[16];
#pragma unroll
          for (int r = 0; r < 16; ++r) acc[r] = 0.f;
#pragma unroll 1
          for (int k = 0; k < 64; ++k) { const float w = w3[k * 512 + c];
#pragma unroll
              for (int r = 0; r < 16; ++r) acc[r] += h2[(rh * 16 + r) * 65 + k] * w; }
#pragma unroll
          for (int r = 0; r < 16; ++r) { const int t = t0 + rh * 16 + r; const float dist = fabsf((float)(t - L / 2)) / (float)(L / 2);
              const float v = (acc[r] + bb) * expf(-dist * delta); cs += fabsf(v); hf[rh * 16 + r] = v; } }
      ((float*)(opaque_ws(P) + WS_HFS))[((size_t)l * 36 + tile) * 512 + c] = cs; }
    __syncthreads();
}

DEVI void mod_item(const Params& P, int l, int chunk, float* lds) {
    const int tid = opaque_tid();
    float* sc = lds; float* red = lds + 9 * 1024;
    for (int idx = tid; idx < 9 * 1024; idx += 512) { const int r = idx >> 10, k = idx & 1023; const float v = r < 8 ? P.in[1][r * 1024 + k] : P.in[3][k]; sc[idx] = silu_prec(v); }
    __syncthreads();
    const int col = tid & 127, ks = tid >> 7; const int n = chunk * 128 + col;
    const float* w = P.in[4] + (size_t)l * 1024 * 9216 + (size_t)(ks * 256) * 9216 + n;
    float acc[9];
#pragma unroll
    for (int r = 0; r < 9; ++r) acc[r] = 0.f;
#pragma unroll 2
    for (int k = 0; k < 256; k += 4) { const float w0 = w[(size_t)k * 9216], w1 = w[(size_t)(k + 1) * 9216], w2 = w[(size_t)(k + 2) * 9216], w3 = w[(size_t)(k + 3) * 9216];
#pragma unroll
        for (int r = 0; r < 9; ++r) { const float4 s4 = *(const float4*)(sc + r * 1024 + ks * 256 + k); acc[r] += s4.x * w0 + s4.y * w1 + s4.z * w2 + s4.w * w3; } }
#pragma unroll
    for (int r = 0; r < 9; ++r) red[(ks * 9 + r) * 128 + col] = acc[r];
    __syncthreads();
    float* modout = (float*)(opaque_ws(P) + WS_MOD);
    for (int idx = tid; idx < 9 * 128; idx += 512) { const int r = idx >> 7, c = idx & 127;
        const float s = red[(0 * 9 + r) * 128 + c] + red[(1 * 9 + r) * 128 + c] + red[(2 * 9 + r) * 128 + c] + red[(3 * 9 + r) * 128 + c];
        modout[((size_t)l * 9 + r) * 9216 + chunk * 128 + c] = s + P.in[5][(size_t)l * 9216 + chunk * 128 + c]; }
    __syncthreads();
}

constexpr int N_FILT = DEPTH * 36, N_MODI = DEPTH * 72;
constexpr int CV_W13 = 16 * 22, CV_W2 = 44 * 4, CV_WIN = 16 * 13, CV_WOUT = 16 * 4;
constexpr int N_CV13 = DEPTH * 2 * CV_W13, N_CV2 = DEPTH * 2 * CV_W2, N_CVIN = DEPTH * CV_WIN, N_CVOUT = DEPTH * CV_WOUT;
constexpr int N_COPY = MT / 64, N_ROPE = 4, N_ZERO = 8, N_SB = DEPTH * 2 * 44, N_SBIN = DEPTH * 26;
constexpr int N_P0A = N_FILT + N_MODI + N_ROPE + N_ZERO + N_CV13 + N_CV2 + N_CVIN + N_CVOUT;
constexpr int N_P0B = N_SB + N_SBIN + N_COPY;

DEVI void sb_item(const Params& P, const float* W, int Nsrc, int type, const float* shiftp, float* out, int Nout, int chunk, float* lds) {
    const int tid = opaque_tid();
    float* sc = lds; float* red = lds + 9 * 1024;
    for (int idx = tid; idx < 9 * 1024; idx += 512) { const int r = idx >> 10, k = idx & 1023; sc[idx] = shiftp[(size_t)r * 9216 + k]; }
    __syncthreads();
    const int col = tid & 127, ks = tid >> 7; const int n = chunk * 128 + col; const int cm = colmap(type, n);
    const float* w = W + (size_t)(ks * 256) * Nsrc + (cm < 0 ? 0 : cm);
    float acc[9];
#pragma unroll
    for (int r = 0; r < 9; ++r) acc[r] = 0.f;
#pragma unroll 2
    for (int k = 0; k < 256; k += 4) { const float w0 = w[(size_t)k * Nsrc], w1 = w[(size_t)(k + 1) * Nsrc], w2 = w[(size_t)(k + 2) * Nsrc], w3 = w[(size_t)(k + 3) * Nsrc];
#pragma unroll
        for (int r = 0; r < 9; ++r) { const float4 s4 = *(const float4*)(sc + r * 1024 + ks * 256 + k); acc[r] += s4.x * w0 + s4.y * w1 + s4.z * w2 + s4.w * w3; } }
#pragma unroll
    for (int r = 0; r < 9; ++r) red[(ks * 9 + r) * 128 + col] = cm < 0 ? 0.f : acc[r];
    __syncthreads();
    for (int idx = tid; idx < 9 * 128; idx += 512) { const int r = idx >> 7, c = idx & 127;
        out[(size_t)r * Nout + chunk * 128 + c] = red[(0 * 9 + r) * 128 + c] + red[(1 * 9 + r) * 128 + c] + red[(2 * 9 + r) * 128 + c] + red[(3 * 9 + r) * 128 + c]; }
    __syncthreads();
}

DEVI void phase0a(const Params& P, unsigned char* smem) {
    const int tid = opaque_tid();
    float* lds = (float*)(smem + 1024);
    for (int it0 = opaque_bid(); it0 < N_P0A; it0 += gridDim.x) {
        int it = it0;
        if (it < N_FILT) { filt_item(P, it / 36, it % 36, lds); continue; } it -= N_FILT;
        if (it < N_MODI) { mod_item(P, it / 72, it % 72, lds); continue; } it -= N_MODI;
        if (it < N_ROPE) { const int t = it * 512 + tid; const int row = t >> 6, col = t & 63;
          float* rg = (float*)(opaque_ws(P) + WS_ROPEG) + (size_t)t * 64; float* rd = (float*)(opaque_ws(P) + WS_ROPED) + (size_t)t * 32;
          for (int j = 0; j < 16; ++j) { const float inv = expf(-(float)j / 16.f * 9.210340371976184f); const float ar = (float)row * inv, ac = (float)col * inv;
              rg[j] = cosf(ar); rg[16 + j] = cosf(ac); rg[32 + j] = sinf(ar); rg[48 + j] = sinf(ac); }
          for (int j = 0; j < 8; ++j) { const float inv = expf(-(float)j / 8.f * 9.210340371976184f); const float ar = (float)row * inv, ac = (float)col * inv;
              rd[j] = cosf(ar); rd[8 + j] = cosf(ac); rd[16 + j] = sinf(ar); rd[24 + j] = sinf(ac); }
          continue; } it -= N_ROPE;
        if (it < N_ZERO) { float* z = (float*)(opaque_ws(P) + WS_SSQ); const int n = DEPTH * 3 * MT; for (int i = it * 512 + tid; i < n; i += N_ZERO * 512) z[i] = 0.f; continue; } it -= N_ZERO;
        if (it < N_CV13) { const int lf = it / CV_W13, r = it % CV_W13; convert_tile(P.in[7] + (size_t)lf * 1024 * 5632, 5632, 1024, 0, (bf16_t*)(opaque_ws(P) + WS_W13) + (size_t)lf * 5632 * 1024, r / 22, r % 22, lds); continue; } it -= N_CV13;
        if (it < N_CV2) { const int lf = it / CV_W2, r = it % CV_W2; convert_tile(P.in[8] + (size_t)lf * 2816 * 1024, 1024, 2816, 1, (bf16_t*)(opaque_ws(P) + WS_W2) + (size_t)lf * 1024 * 2816, r / 4, r % 4, lds); continue; } it -= N_CV2;
        if (it < N_CVIN) { const int l = it / CV_WIN, r = it % CV_WIN; convert_tile(P.in[9] + (size_t)l * 1024 * NIN, NIN, 1024, 2, (bf16_t*)(opaque_ws(P) + WS_WIN) + (size_t)l * NPG * 1024, r / 13, r % 13, lds); continue; } it -= N_CVIN;
        if (it < N_CVOUT) { const int l = it / CV_WOUT, r = it % CV_WOUT; convert_tile(P.in[10] + (size_t)l * 1024 * 1024, 1024, 1024, 1, (bf16_t*)(opaque_ws(P) + WS_WOUT) + (size_t)l * 1024 * 1024, r / 4, r % 4, lds); continue; }
    }
}
DEVI void phase0b(const Params& P, unsigned char* smem) {
    const int tid = opaque_tid();
    float* lds = (float*)(smem + 1024);
    for (int it0 = opaque_bid(); it0 < N_P0B; it0 += gridDim.x) {
        int it = it0;
        if (it < N_SB) { const int lf = it / 44; const int l = lf >> 1, f = lf & 1;
            sb_item(P, P.in[7] + (size_t)lf * 1024 * 5632, 5632, 0, (const float*)(opaque_ws(P) + WS_MOD) + (size_t)l * 9 * 9216 + (f ? 6 : 0) * 1024, (float*)(opaque_ws(P) + WS_SB) + (size_t)lf * 9 * 5632, 5632, it % 44, lds); continue; } it -= N_SB;
        if (it < N_SBIN) { const int l = it / 26;
            sb_item(P, P.in[9] + (size_t)l * 1024 * NIN, NIN, 2, (const float*)(opaque_ws(P) + WS_MOD) + (size_t)l * 9 * 9216 + 3 * 1024, (float*)(opaque_ws(P) + WS_SBIN) + (size_t)l * 9 * NPG, NPG, it % 26, lds); continue; } it -= N_SBIN;
        {
            const int lane = tid & 63, wid = tid >> 6;
            float* hctx = (float*)(opaque_ws(P) + WS_HCTX); bf16_t* A = (bf16_t*)(opaque_ws(P) + WS_A); float* ssq = (float*)(opaque_ws(P) + WS_SSQ);
            const float* g = P.in[6]; const float* modl = (const float*)(opaque_ws(P) + WS_MOD);
#pragma unroll 2
            for (int rr = 0; rr < 8; ++rr) { const int row = it * 64 + wid * 8 + rr;
                const float* sp = row < MLAT ? P.in[0] + (size_t)row * D : P.in[2] + (size_t)(row - MLAT) * D;
                float* dp = row < MLAT ? P.out + (size_t)row * D : hctx + (size_t)(row - MLAT) * D;
                const int r9 = row < MLAT ? (row >> 11) : 8; const float* scl = modl + (size_t)r9 * 9216 + 1024;
                float ss = 0.f;
#pragma unroll
                for (int j = 0; j < 4; ++j) { const int col = 4 * lane + 256 * j; const float4 x = *(const float4*)(sp + col); *(float4*)(dp + col) = x;
                    ss += x.x * x.x + x.y * x.y + x.z * x.z + x.w * x.w;
                    const float4 g4 = *(const float4*)(g + col), s4 = *(const float4*)(scl + col);
                    uint2 o; o.x = pack2(x.x * g4.x * (1.f + s4.x), x.y * g4.y * (1.f + s4.y)); o.y = pack2(x.z * g4.z * (1.f + s4.z), x.w * g4.w * (1.f + s4.w));
                    *(uint2*)(A + (size_t)row * D + col) = o; }
                ss = wave_sum(ss);
                if (lane == 0) ssq[row] = ss; }
        }
    }
}

template <bool GATES> DEVI void norm_phase(const Params& P, int l, int which, unsigned char* smem) {
    const int tid = opaque_tid(), lane = tid & 63, wid = tid >> 6;
    const float* g = P.in[6] + (size_t)(l * 3 + which) * 1024;
    const float* modl = (const float*)(opaque_ws(P) + WS_MOD) + (size_t)l * 9 * 9216;
    const float* hctx = (const float*)(opaque_ws(P) + WS_HCTX);
    bf16_t* A = (bf16_t*)(opaque_ws(P) + WS_A);
    float* WgT = (float*)(smem + 1024);
    if (GATES) { const float* win = P.in[9] + (size_t)l * 1024 * NIN;
        for (int idx = tid; idx < 16384; idx += 512) { const int k = idx >> 4, jj = idx & 15; WgT[jj * 1024 + k] = win[(size_t)k * NIN + 1024 + jj]; }
        __syncthreads(); }
    float4 gv[4];
#pragma unroll
    for (int j = 0; j < 4; ++j) gv[j] = *(const float4*)(g + 4 * lane + 256 * j);
    for (int row = opaque_bid() * 8 + wid; row < MT; row += gridDim.x * 8) {
        const float* hp = row < MLAT ? P.out + (size_t)row * D : hctx + (size_t)(row - MLAT) * D;
        const int r9 = row < MLAT ? (row >> 11) : 8;
        const float* sh = modl + (size_t)r9 * 9216 + (3 * which) * 1024; const float* scl = sh + 1024;
        float4 x[4]; float ss = 0.f;
#pragma unroll
        for (int j = 0; j < 4; ++j) { x[j] = *(const float4*)(hp + 4 * lane + 256 * j); ss += x[j].x * x[j].x + x[j].y * x[j].y + x[j].z * x[j].z + x[j].w * x[j].w; }
        ss = wave_sum(ss);
        const float rstd = rsqrtf(ss * (1.f / 1024.f) + 1e-6f);
        float ga[16];
        if (GATES) {
#pragma unroll
            for (int jj = 0; jj < 16; ++jj) ga[jj] = 0.f; }
#pragma unroll
        for (int j = 0; j < 4; ++j) { const int col = 4 * lane + 256 * j;
            const float4 s4 = *(const float4*)(scl + col), h4 = *(const float4*)(sh + col);
            float4 y;
            y.x = x[j].x * rstd * gv[j].x * (1.f + s4.x) + h4.x; y.y = x[j].y * rstd * gv[j].y * (1.f + s4.y) + h4.y;
            y.z = x[j].z * rstd * gv[j].z * (1.f + s4.z) + h4.z; y.w = x[j].w * rstd * gv[j].w * (1.f + s4.w) + h4.w;
            uint2 o; o.x = pack2(y.x, y.y); o.y = pack2(y.z, y.w);
            *(uint2*)(A + (size_t)row * D + col) = o;
            if (GATES) {
#pragma unroll
                for (int jj = 0; jj < 16; ++jj) { const float4 w = *(const float4*)(WgT + jj * 1024 + col); ga[jj] += y.x * w.x + y.y * w.y + y.z * w.z + y.w * w.w; } } }
        if (GATES) { float outv = 0.f;
#pragma unroll
            for (int jj = 0; jj < 16; ++jj) { const float t = wave_sum(ga[jj]); if (lane == jj) outv = t; }
            if (lane < 16) ((float*)(opaque_ws(P) + WS_GATES))[(size_t)row * 16 + lane] = outv + P.in[11][l * 16 + lane]; }
    }
}

template <int LEN> DEVI void prep_seg(const bf16_t* __restrict__ src, const float* __restrict__ g, const float* __restrict__ rope, float scale, bf16_t* __restrict__ dst) {
    float x[LEN];
#pragma unroll
    for (int i = 0; i < LEN / 8; ++i) { const uint4 v = *(const uint4*)(src + 8 * i);
        x[8 * i + 0] = bflo(v.x); x[8 * i + 1] = bfhi(v.x); x[8 * i + 2] = bflo(v.y); x[8 * i + 3] = bfhi(v.y);
        x[8 * i + 4] = bflo(v.z); x[8 * i + 5] = bfhi(v.z); x[8 * i + 6] = bflo(v.w); x[8 * i + 7] = bfhi(v.w); }
    float ss = 0.f;
#pragma unroll
    for (int i = 0; i < LEN; ++i) ss += x[i] * x[i];
    const float rstd = rsqrtf(ss * (1.f / LEN) + 1e-6f);
#pragma unroll
    for (int i = 0; i < LEN; ++i) x[i] = x[i] * rstd * g[i];
    if (rope) {
#pragma unroll
        for (int j = 0; j < LEN / 2; ++j) { const float c = rope[j], s = rope[LEN / 2 + j]; const float a = x[j], b = x[j + LEN / 2]; x[j] = a * c - b * s; x[j + LEN / 2] = a * s + b * c; } }
#pragma unroll
    for (int i = 0; i < LEN / 8; ++i) { uint4 o;
        o.x = pack2(x[8 * i + 0] * scale, x[8 * i + 1] * scale); o.y = pack2(x[8 * i + 2] * scale, x[8 * i + 3] * scale);
        o.z = pack2(x[8 * i + 4] * scale, x[8 * i + 5] * scale); o.w = pack2(x[8 * i + 6] * scale, x[8 * i + 7] * scale);
        *(uint4*)(dst + 8 * i) = o; }
}
DEVI void unpack8(const uint4 v, float (&x)[8]) { x[0] = bflo(v.x); x[1] = bfhi(v.x); x[2] = bflo(v.y); x[3] = bfhi(v.y); x[4] = bflo(v.z); x[5] = bfhi(v.z); x[6] = bflo(v.w); x[7] = bfhi(v.w); }

DEVI void prep_phase(const Params& P, int l, unsigned char* smem) {
    const int tid = opaque_tid();
    const bf16_t* p = (const bf16_t*)(opaque_ws(P) + WS_P);
    bf16_t* Qb = (bf16_t*)(opaque_ws(P) + WS_Q); bf16_t* Kb = (bf16_t*)(opaque_ws(P) + WS_K); bf16_t* VT = (bf16_t*)(opaque_ws(P) + WS_VT);
    bf16_t* mlqk = (bf16_t*)(opaque_ws(P) + WS_MLQK); bf16_t* hyu = (bf16_t*)(opaque_ws(P) + WS_HYU);
    const float* ropeG = (const float*)(opaque_ws(P) + WS_ROPEG); const float* ropeD = (const float*)(opaque_ws(P) + WS_ROPED);
    const float* gqa_g = P.in[15] + l * 128; const float* diff_g = P.in[25] + l * 64;
    bf16_t* lt = (bf16_t*)(smem + 1024);
    constexpr int TR = 16, LS = TR + 8;
    for (int rt = opaque_bid(); rt < MT / TR; rt += gridDim.x) {
        const int row0 = rt * TR; const bool isctx = row0 >= MLAT;
        int b, t0, Ls;
        if (!isctx) { b = row0 >> 11; t0 = row0 & 2047; Ls = SEQ; } else { const int rc = row0 - MLAT; b = rc >> 8; t0 = rc & 255; Ls = CTX; }
        const int pp0 = isctx ? t0 : CTX + t0;
        for (int task = tid; task < TR * 22; task += 512) {
            if (task < TR * 6) { const int seg = task % 6, r = task / 6;
                const int srccol = seg < 4 ? 1024 + 64 * seg : 1280 + 64 * (seg - 4);
                const float* g = gqa_g + (seg < 4 ? 0 : 64); const float scale = seg < 4 ? 0.125f * LOG2E : 1.f;
                bf16_t* dst = seg < 4 ? Qb + (((size_t)b * 8 + seg) * KEYS + pp0 + r) * 64 : Kb + (((size_t)b * 6 + (seg - 4)) * KEYS + pp0 + r) * 64;
                const float* rope = isctx ? nullptr : ropeG + (size_t)(t0 + r) * 64;
                prep_seg<64>(p + (size_t)(row0 + r) * NP + srccol, g, rope, scale, dst);
            } else { const int tt = task - TR * 6; const int seg = tt & 15, r = tt >> 4; const int isk = seg >> 3, hh = (seg >> 1) & 3, s = seg & 1;
                const int srccol = (isk ? 2560 : 2304) + 64 * hh + 32 * s;
                const float* g = diff_g + isk * 32; const float scale = isk ? 1.f : 0.17677669529663687f * LOG2E;
                bf16_t* dst = isk ? Kb + (((size_t)b * 6 + 2 + hh) * KEYS + pp0 + r) * 64 + 32 * s : Qb + (((size_t)b * 8 + 4 + hh) * KEYS + pp0 + r) * 64 + 32 * s;
                const float* rope = isctx ? nullptr : ropeD + (size_t)(t0 + r) * 32;
                prep_seg<32>(p + (size_t)(row0 + r) * NP + srccol, g, rope, scale, dst);
            }
        }
        { const float* cw = P.in[12] + (size_t)l * 3 * 512; const float* cb = P.in[13] + (size_t)l * 512;
          for (int task = tid; task < TR * 64; task += 512) { const int cg8 = task & 63, r = task >> 6; const int c0 = cg8 * 8; const int t = t0 + r;
              const bf16_t* pr = p + (size_t)(row0 + r) * NP + c0;
              float xm[8], x0[8], xp[8];
              unpack8(*(const uint4*)pr, x0);
              if (t > 0) unpack8(*(const uint4*)(pr - NP), xm); else {
#pragma unroll
                  for (int i = 0; i < 8; ++i) xm[i] = 0.f; }
              if (t < Ls - 1) unpack8(*(const uint4*)(pr + NP), xp); else {
#pragma unroll
                  for (int i = 0; i < 8; ++i) xp[i] = 0.f; }
              const float sc = c0 < 256 ? 0.125f : 1.f;
              float y[8];
#pragma unroll
              for (int i = 0; i < 8; ++i) { const float v = cw[c0 + i] * xm[i] + cw[512 + c0 + i] * x0[i] + cw[1024 + c0 + i] * xp[i] + cb[c0 + i]; y[i] = silu_fast(v) * sc; }
              uint4 o4; o4.x = pack2(y[0], y[1]); o4.y = pack2(y[2], y[3]); o4.z = pack2(y[4], y[5]); o4.w = pack2(y[6], y[7]);
              *(uint4*)(mlqk + (size_t)(row0 + r) * 512 + c0) = o4; } }
        for (int task = tid; task < TR * 48; task += 512) { const int r = task & (TR - 1), ch = task / TR;
            const int srccol = ch < 16 ? 1408 + ch * 8 : 2816 + (ch - 16) * 8;
            const uint4 v = *(const uint4*)(p + (size_t)(row0 + r) * NP + srccol);
            bf16_t* d = lt + (size_t)(ch * 8) * LS + r;
            d[0] = (bf16_t)(v.x & 0xffff); d[LS] = (bf16_t)(v.x >> 16); d[2 * LS] = (bf16_t)(v.y & 0xffff); d[3 * LS] = (bf16_t)(v.y >> 16);
            d[4 * LS] = (bf16_t)(v.z & 0xffff); d[5 * LS] = (bf16_t)(v.z >> 16); d[6 * LS] = (bf16_t)(v.w & 0xffff); d[7 * LS] = (bf16_t)(v.w >> 16); }
        __syncthreads();
        static_assert(TR == 16, "V^T key permutation below assumes 16-row tiles");
        for (int task = tid; task < 384 * 2; task += 512) { const int dd = task >> 1, ch = task & 1; const int slot = dd >> 6, d = dd & 63;
            const uint4 v = *(const uint4*)(lt + (size_t)dd * LS + ch * 8);
            bf16_t* dst = VT + (((size_t)b * 6 + slot) * 64 + d) * KEYS + (pp0 & ~31) + ((pp0 >> 4) & 1) * 4;
            *(uint2*)(dst + (2 * ch) * 8) = make_uint2(v.x, v.y); *(uint2*)(dst + (2 * ch + 1) * 8) = make_uint2(v.z, v.w); }
        __syncthreads();
        { const float* cw = P.in[16] + (size_t)l * 3 * 768; const float* cb = P.in[17] + (size_t)l * 768;
          for (int task = tid; task < TR * 96; task += 512) { const int r = task & (TR - 1), ch = task / TR; const int c0 = ch * 8; const int t = t0 + r;
              const bf16_t* pr = p + (size_t)(row0 + r) * NP + 1536 + c0;
              float xm[8], x0[8], xp[8];
              unpack8(*(const uint4*)pr, x0);
              if (t > 0) unpack8(*(const uint4*)(pr - NP), xm); else {
#pragma unroll
                  for (int i = 0; i < 8; ++i) xm[i] = 0.f; }
              if (t < Ls - 1) unpack8(*(const uint4*)(pr + NP), xp); else {
#pragma unroll
                  for (int i = 0; i < 8; ++i) xp[i] = 0.f; }
              bf16_t* d = lt + (size_t)c0 * LS + r;
#pragma unroll
              for (int i = 0; i < 8; ++i) { const float v = cw[c0 + i] * xm[i] + cw[768 + c0 + i] * x0[i] + cw[1536 + c0 + i] * xp[i] + cb[c0 + i]; d[i * LS] = f2bf(v); } } }
        __syncthreads();
        for (int task = tid; task < 768 * (TR / 8); task += 512) { const int cc = task / (TR / 8), ch = task % (TR / 8);
            *(uint4*)(hyu + (size_t)cc * MT + row0 + ch * 8) = *(const uint4*)(lt + (size_t)cc * LS + ch * 8); }
        __syncthreads();
    }
}

template <bool DIFF> DEVI void attn_item(const Params& P, int l, int b, int hsel, int qb, bool isctx, unsigned char* smem) {
    const int tid = opaque_tid(), lane = tid & 63, wid = tid >> 6, fr = lane & 15, quad = lane >> 4;
    bf16_t* Ks0 = (bf16_t*)(smem + 1024); bf16_t* Vs0 = Ks0 + 2 * 64 * 72;
    const int nkt = (isctx ? CTX : KEYS) / 64;
    const int pq0 = (isctx ? 0 : CTX) + qb * 128 + wid * 16;
    const int slotk = DIFF ? 2 + hsel : hsel;
    const bf16_t* Kg = (const bf16_t*)(opaque_ws(P) + WS_K) + ((size_t)b * 6 + slotk) * KEYS * 64;
    const bf16_t* Vg = (const bf16_t*)(opaque_ws(P) + WS_VT) + ((size_t)b * 6 + slotk) * 64 * KEYS;
    const bf16_t* Qg = (const bf16_t*)(opaque_ws(P) + WS_Q);
    bf16x8 q[2][2];
#pragma unroll
    for (int s = 0; s < 2; ++s) { const int slotq = DIFF ? 4 + hsel : 2 * hsel + s;
        const bf16_t* qp = Qg + (((size_t)b * 8 + slotq) * KEYS + pq0 + fr) * 64 + quad * 8;
        q[s][0] = *(const bf16x8*)qp; q[s][1] = *(const bf16x8*)(qp + 32); }
    float M2;
    { const float* g = DIFF ? P.in[25] + l * 64 : P.in[15] + l * 128; const int n = DIFF ? 32 : 64;
      float a = lane < n ? fabsf(g[lane]) : 0.f, bb = lane < n ? fabsf(g[n + lane]) : 0.f; a = wave_max(a); bb = wave_max(bb);
      M2 = sqrtf((float)n) * a * bb * LOG2E; }
    f32x4 O[2][5];
#pragma unroll
    for (int s = 0; s < 2; ++s)
#pragma unroll
        for (int d = 0; d < 5; ++d) O[s][d] = (f32x4){0.f, 0.f, 0.f, 0.f};
    const f32x4 minit = (f32x4){-M2, -M2, -M2, -M2};
    const int lrow = tid >> 3, lch = (tid & 7) * 8;
    const bf16_t* kgp = Kg + (size_t)lrow * 64 + lch; const bf16_t* vgp = Vg + (size_t)lrow * KEYS + lch;
#define LDK(t) (*(const uint4*)(kgp + (size_t)(t) * 64 * 64))
#define LDV(t) (*(const uint4*)(vgp + (size_t)(t) * 64))
    uint4 k0r = LDK(0), v0r = LDV(0), k1r = k0r, v1r = v0r;
    constexpr int KSZ = 64 * 72, VSZ = 80 * 72;
    __syncthreads();
    *(uint4*)(Ks0 + lrow * 72 + lch) = k0r; *(uint4*)(Vs0 + lrow * 72 + lch) = v0r;
    if (nkt > 1) { k0r = LDK(1); v0r = LDV(1); }
    if (nkt > 2) { k1r = LDK(2); v1r = LDV(2); }
    __syncthreads();
    f32x4 S[2][4]; bf16x8 pbp[2][2];
    bf16x8 vones;
#pragma unroll
    for (int i = 0; i < 8; ++i) vones[i] = (short)0x3F80;
#define ATT_QK(KS) do { _Pragma("unroll") for (int ks = 0; ks < 4; ++ks) { const bf16_t* kp = (KS) + (ks * 16 + fr) * 72 + quad * 8; \
            const bf16x8 k0 = *(const bf16x8*)kp, k1 = *(const bf16x8*)(kp + 32); \
            if (!DIFF) { S[0][ks] = mfma16(k0, q[0][0], minit); S[1][ks] = mfma16(k0, q[1][0], minit); S[0][ks] = mfma16(k1, q[0][1], S[0][ks]); S[1][ks] = mfma16(k1, q[1][1], S[1][ks]); } \
            else { S[0][ks] = mfma16(k0, q[0][0], minit); S[1][ks] = mfma16(k1, q[0][1], minit); } } } while (0)
#define ATT_EXP(PB) do { _Pragma("unroll") for (int s = 0; s < 2; ++s) _Pragma("unroll") for (int kk = 0; kk < 2; ++kk) { float pv[8]; \
            _Pragma("unroll") for (int i = 0; i < 4; ++i) { pv[i] = __builtin_amdgcn_exp2f(S[s][2 * kk][i]); pv[4 + i] = __builtin_amdgcn_exp2f(S[s][2 * kk + 1][i]); } \
            union { uint4 u; bf16x8 v; } cv; cv.u.x = pack2(pv[0], pv[1]); cv.u.y = pack2(pv[2], pv[3]); cv.u.z = pack2(pv[4], pv[5]); cv.u.w = pack2(pv[6], pv[7]); \
            PB[s][kk] = cv.v; } } while (0)
#define ATT_PV(VS, PB) do { _Pragma("unroll") for (int ds = 0; ds < 5; ++ds) _Pragma("unroll") for (int kk = 0; kk < 2; ++kk) { const bf16x8 vf = ds < 4 ? *(const bf16x8*)((VS) + (ds * 16 + fr) * 72 + kk * 32 + quad * 8) : vones; \
            O[0][ds] = mfma16(vf, PB[0][kk], O[0][ds]); O[1][ds] = mfma16(vf, PB[1][kk], O[1][ds]); } } while (0)
#define ATT_NEXT(kt, VN) do { if ((kt) + 1 < nkt) { bf16_t* Kn = Ks0 + (((kt) + 1) & 1) * KSZ; bf16_t* Vn = Vs0 + (VN) * VSZ; \
            if (((kt) & 1) == 0) { *(uint4*)(Kn + lrow * 72 + lch) = k0r; *(uint4*)(Vn + lrow * 72 + lch) = v0r; if ((kt) + 3 < nkt) { k0r = LDK((kt) + 3); v0r = LDV((kt) + 3); } } \
            else { *(uint4*)(Kn + lrow * 72 + lch) = k1r; *(uint4*)(Vn + lrow * 72 + lch) = v1r; if ((kt) + 3 < nkt) { k1r = LDK((kt) + 3); v1r = LDV((kt) + 3); } } } } while (0)
    ATT_QK(Ks0); ATT_EXP(pbp); ATT_NEXT(0, 1);
    __syncthreads();
    int vprev = 0, vcur = 1, vnext = 2;
    for (int kt = 1; kt < nkt; ++kt) {
        ATT_QK(Ks0 + (kt & 1) * KSZ);
        bf16x8 pb[2][2];
        ATT_PV(Vs0 + vprev * VSZ, pbp);
        ATT_EXP(pb);
#pragma unroll
        for (int s = 0; s < 2; ++s)
#pragma unroll
            for (int kk = 0; kk < 2; ++kk) pbp[s][kk] = pb[s][kk];
        ATT_NEXT(kt, vnext);
        __syncthreads();
        const int t_ = vprev; vprev = vcur; vcur = vnext; vnext = t_;
    }
    ATT_PV(Vs0 + vprev * VSZ, pbp);
#undef ATT_QK
#undef ATT_EXP
#undef ATT_PV
#undef ATT_NEXT
    float lsum[2];
#pragma unroll
    for (int s = 0; s < 2; ++s) lsum[s] = __shfl(O[s][4][0], fr);
    const int pp = pq0 + fr;
    const size_t row = pp < CTX ? (size_t)MLAT + b * CTX + pp : (size_t)b * SEQ + (pp - CTX);
    bf16_t* cat = (bf16_t*)(opaque_ws(P) + WS_CAT);
    if (!DIFF) {
#pragma unroll
        for (int s = 0; s < 2; ++s) { const float inv = 1.f / lsum[s]; bf16_t* op = cat + row * D + 256 + (2 * hsel + s) * 64 + quad * 4;
#pragma unroll
            for (int ds = 0; ds < 4; ++ds) *(uint2*)(op + ds * 16) = pack4(O[s][ds] * inv); }
    } else {
        const float* lp = P.in[26] + l * 128;
        float a = lane < 32 ? lp[lane] * lp[32 + lane] : 0.f, c = lane < 32 ? lp[64 + lane] * lp[96 + lane] : 0.f; a = wave_sum(a); c = wave_sum(c);
        const float lam_init = 0.8f - 0.6f * expf(-0.3f * (float)l);
        const float lam = expf(a) - expf(c) + lam_init;
        const float i0 = 1.f / lsum[0], i1 = lam / lsum[1];
        f32x4 o[4]; float ss = 0.f;
#pragma unroll
        for (int ds = 0; ds < 4; ++ds) { o[ds] = O[0][ds] * i0 - O[1][ds] * i1; ss += o[ds][0] * o[ds][0] + o[ds][1] * o[ds][1] + o[ds][2] * o[ds][2] + o[ds][3] * o[ds][3]; }
        ss += __shfl_xor(ss, 16); ss += __shfl_xor(ss, 32);
        const float fac = rsqrtf(ss * (1.f / 64.f) + 1e-6f) * (1.f - lam_init);
        const float* sg = P.in[27] + l * 64;
        bf16_t* op = cat + row * D + 768 + hsel * 64 + quad * 4;
#pragma unroll
        for (int ds = 0; ds < 4; ++ds) { const f32x4 gg = *(const f32x4*)(sg + ds * 16 + quad * 4); *(uint2*)(op + ds * 16) = pack4(o[ds] * gg * fac); }
    }
}

#undef LDK
#undef LDV
DEVI void hy_build_E(const float* hs, float norm, int L, bf16_t* E, int NG) {
    const int lo = L / 2, hi = 3 * L / 2 - 1;
    for (int idx = threadIdx.x; idx < 8 * NG; idx += 512) { const int r = idx / NG, m = idx - r * NG; const int i0 = 8 * m + r;
        float v[8];
#pragma unroll
        for (int e = 0; e < 8; ++e) { const int i = i0 + e; v[e] = (i >= lo && i <= hi) ? hs[hi - i] * norm : 0.f; }
        uint4 o; o.x = pack2(v[0], v[1]); o.y = pack2(v[2], v[3]); o.z = pack2(v[4], v[5]); o.w = pack2(v[6], v[7]);
        *(uint4*)(E + ((size_t)r * NG + m) * 8) = o; }
}
template <int NT> DEVI void hy_conv_chain(const bf16_t* E, int NG, const bf16_t* Us, int ustride, int L, int tbase, int fr, int quad, f32x4 (&acc)[NT]) {
    int jlo = tbase - L / 2 + 1; jlo = jlo < 0 ? 0 : (jlo & ~31);
    int jhi = (tbase + 32 * (NT - 1) + 16 + L / 2 + 31) & ~31; jhi = jhi > L ? L : jhi;
    const bf16_t* Er = E + (size_t)(7 - (fr & 7)) * NG * 8;
    const bf16_t* ub = Us + (fr & 7) * ustride + quad * 8;
    const int ob = quad * 8 - tbase - fr + L - 1;
    bf16x8 F[NT];
#pragma unroll
    for (int i = 0; i < NT; ++i) { acc[i] = (f32x4){0.f, 0.f, 0.f, 0.f}; F[i] = *(const bf16x8*)(Er + (size_t)((jlo + ob - 32 * i) >> 3) * 8); }
    for (int jb = jlo; jb < jhi; jb += 32) {
        const bf16x8 bv = *(const bf16x8*)(ub + jb);
        bf16x8 Fn = F[0];
        if (jb + 32 < jhi) Fn = *(const bf16x8*)(Er + (size_t)((jb + 32 + ob) >> 3) * 8);
#pragma unroll
        for (int i = 0; i < NT; ++i) acc[i] = mfma16(F[i], bv, acc[i]);
#pragma unroll
        for (int i = NT - 1; i > 0; --i) F[i] = F[i - 1];
        F[0] = Fn;
    }
}
template <int NT> DEVI void hy_item(const Params& P, int l, int c, unsigned char* smem) {
    constexpr int Lsel = (NT == 2) ? 1 : 0;
    constexpr int L = Lsel ? CTX : SEQ; constexpr int NG = L / 4 + 2; constexpr int ustride = L + 8;
    const int tid = opaque_tid(), lane = tid & 63, wid = tid >> 6, fr = lane & 15, quad = lane >> 4;
    bf16_t* E = (bf16_t*)(smem + 1024); bf16_t* Us = E + (size_t)8 * NG * 8; bf16_t* Zs = Us + 8 * ustride;
    const float* hfs = (const float*)(opaque_ws(P) + WS_HFS) + (size_t)l * 36 * 512;
    float s0 = 0.f, s1 = 0.f;
    { const int tlo = Lsel ? 32 : 0, thi = Lsel ? 36 : 32; for (int t = tlo; t < thi; ++t) { s0 += hfs[t * 512 + c]; s1 += hfs[t * 512 + 256 + c]; } }
    const float* hf = (const float*)(opaque_ws(P) + WS_HF) + (size_t)l * HF_LAYER + (Lsel ? (size_t)512 * SEQ : 0);
    const bf16_t* hyu = (const bf16_t*)(opaque_ws(P) + WS_HYU); bf16_t* hyo = (bf16_t*)(opaque_ws(P) + WS_HYO);
    { float* hs = (float*)Zs; const float* src = hf + (size_t)c * L; for (int i = tid; i < L / 4; i += 512) *(float4*)(hs + 4 * i) = *(const float4*)(src + 4 * i); }
    { constexpr int nch = L / 8; for (int idx = tid; idx < 8 * nch; idx += 512) { const int bb = idx / nch, ch = idx - bb * nch;
          const size_t base = Lsel ? (size_t)MLAT + bb * CTX : (size_t)bb * SEQ;
          *(uint4*)(Us + bb * ustride + ch * 8) = *(const uint4*)(hyu + (size_t)c * MT + base + ch * 8); } }
    __syncthreads();
    hy_build_E((const float*)Zs, 1.f / s0, L, E, NG);
    __syncthreads();
    const float sk0 = P.in[24][(size_t)l * 512 + c], sk1 = P.in[24][(size_t)l * 512 + 256 + c];
    const size_t baseb = Lsel ? (size_t)MLAT + (fr & 7) * CTX : (size_t)(fr & 7) * SEQ;
    const int tbase = 16 * (wid & 1) + 32 * NT * (wid >> 1);
    f32x4 acc[NT];
    hy_conv_chain<NT>(E, NG, Us, ustride, L, tbase, fr, quad, acc);
    if (fr < 8) {
#pragma unroll
        for (int i = 0; i < NT; ++i) { const int t = tbase + 32 * i + quad * 4;
            const uint2 v4 = *(const uint2*)(Us + fr * ustride + t); const uint2 x4 = *(const uint2*)(hyu + (size_t)(256 + c) * MT + baseb + t);
            f32x4 z; z[0] = bflo(x4.x) * (acc[i][0] + sk0 * bflo(v4.x)); z[1] = bfhi(x4.x) * (acc[i][1] + sk0 * bfhi(v4.x));
            z[2] = bflo(x4.y) * (acc[i][2] + sk0 * bflo(v4.y)); z[3] = bfhi(x4.y) * (acc[i][3] + sk0 * bfhi(v4.y));
            *(uint2*)(Zs + fr * ustride + t) = pack4(z); } }
    __syncthreads();
    { float* hs = (float*)Us; const float* src = hf + (size_t)(256 + c) * L; for (int i = tid; i < L / 4; i += 512) *(float4*)(hs + 4 * i) = *(const float4*)(src + 4 * i); }
    __syncthreads();
    hy_build_E((const float*)Us, 1.f / s1, L, E, NG);
    __syncthreads();
    hy_conv_chain<NT>(E, NG, Zs, ustride, L, tbase, fr, quad, acc);
    if (fr < 8) {
#pragma unroll
        for (int i = 0; i < NT; ++i) { const int t = tbase + 32 * i + quad * 4;
            const uint2 v4 = *(const uint2*)(Zs + fr * ustride + t); const uint2 x4 = *(const uint2*)(hyu + (size_t)(512 + c) * MT + baseb + t);
            f32x4 z; z[0] = bflo(x4.x) * (acc[i][0] + sk1 * bflo(v4.x)); z[1] = bfhi(x4.x) * (acc[i][1] + sk1 * bfhi(v4.x));
            z[2] = bflo(x4.y) * (acc[i][2] + sk1 * bflo(v4.y)); z[3] = bfhi(x4.y) * (acc[i][3] + sk1 * bfhi(v4.y));
            *(uint2*)(hyo + (size_t)c * MT + baseb + t) = pack4(z); } }
}

DEVI void ml_item(const Params& P, int l, int b, int hh, int dir, unsigned char* smem) {
    const int tid = opaque_tid(), lane = tid & 63, wid = tid >> 6, fr = lane & 15, quad = lane >> 4;
    bf16_t* Qs = (bf16_t*)(smem + 1024); bf16_t* Qp = Qs + 64 * 72; bf16_t* Ks = Qp + 64 * 72; bf16_t* KTw = Ks + 64 * 72; bf16_t* Ss = KTw + 64 * 72;
    bf16_t* VT = Ss + 64 * 72; bf16_t* Cs = VT + 80 * 72;
    float* btm = (float*)(Cs + 80 * 72); float* aval = btm + 64; float* mrow = aval + 64; float* winter = mrow + 64; float* wg = winter + 64; float* sc = wg + 64;
    const bf16_t* mlqk = (const bf16_t*)(opaque_ws(P) + WS_MLQK); const bf16_t* p = (const bf16_t*)(opaque_ws(P) + WS_P); const float* gates = (const float*)(opaque_ws(P) + WS_GATES);
    float* mlh = (float*)(opaque_ws(P) + WS_MLH) + (size_t)dir * MT * 256;
    for (int i = tid; i < 80 * 72; i += 512) Cs[i] = 0;
    for (int i = tid; i < 16 * 72; i += 512) VT[64 * 72 + i] = (i < 72) ? (bf16_t)0x3F80 : (bf16_t)0;
    if (tid == 0) sc[0] = 0.f;
    const int tt = wid & 3, grp = wid >> 2;
    f32x4 Cacc[3];
#pragma unroll
    for (int j = 0; j < 3; ++j) Cacc[j] = (f32x4){0.f, 0.f, 0.f, 0.f};
    const int lr = tid & 63, lc0 = (tid >> 6) * 8;
    uint4 qreg, kreg, vreg; float gi = 0.f, gf = 0.f;
    { const int Ls = CTX; const size_t rowbase = (size_t)MLAT + b * CTX; const int pos = dir ? Ls - 1 - lr : lr; const size_t row = rowbase + pos;
      qreg = *(const uint4*)(mlqk + row * 512 + hh * 64 + lc0); kreg = *(const uint4*)(mlqk + row * 512 + 256 + hh * 64 + lc0); vreg = *(const uint4*)(p + row * NP + 512 + hh * 64 + lc0);
      if (tid < 64) { const float* gp = gates + row * 16 + dir * 8 + hh; gi = gp[0]; gf = gp[4]; } }
    __syncthreads();
#pragma unroll 1
    for (int ck = 0; ck < 36; ++ck) {
        const int seq = ck >= 4; const int Ls = seq ? SEQ : CTX; const size_t rowbase = seq ? (size_t)b * SEQ : (size_t)MLAT + b * CTX; const int kk = seq ? ck - 4 : ck;
        if (tid < 64) {
            float bsum = logsigmoid(gf);
#pragma unroll
            for (int o = 1; o < 64; o <<= 1) { const float t = __shfl_up(bsum, o); if (lane >= o) bsum += t; }
            const float a = gi - bsum; float pm = a;
#pragma unroll
            for (int o = 1; o < 64; o <<= 1) { const float t = __shfl_up(pm, o); if (lane >= o) pm = fmaxf(pm, t); }
            const float m = sc[0]; const float mt = bsum + fmaxf(m, pm);
            btm[lane] = bsum - mt; aval[lane] = a; mrow[lane] = mt; winter[lane] = expf(bsum + m - mt);
            const float bend = __shfl(bsum, 63), pmend = __shfl(pm, 63); const float mnew = bend + fmaxf(m, pmend);
            wg[lane] = expf(bend + a - mnew);
            if (lane == 0) { sc[1] = expf(bend + m - mnew); sc[2] = mnew; } }
        __syncthreads();
        { float qf[8], kf[8]; unpack8(qreg, qf); unpack8(kreg, kf);
          const float wi = winter[lr], wgs = wg[lr];
          *(uint4*)(Qs + lr * 72 + lc0) = qreg; *(uint4*)(Ks + lr * 72 + lc0) = kreg;
          uint4 o; o.x = pack2(qf[0] * wi, qf[1] * wi); o.y = pack2(qf[2] * wi, qf[3] * wi); o.z = pack2(qf[4] * wi, qf[5] * wi); o.w = pack2(qf[6] * wi, qf[7] * wi);
          *(uint4*)(Qp + lr * 72 + lc0) = o;
          const unsigned k01 = pack2(kf[0] * wgs, kf[1] * wgs), k23 = pack2(kf[2] * wgs, kf[3] * wgs), k45 = pack2(kf[4] * wgs, kf[5] * wgs), k67 = pack2(kf[6] * wgs, kf[7] * wgs);
          bf16_t* kt = KTw + lc0 * 72 + lr;
          kt[0] = (bf16_t)(k01 & 0xffff); kt[72] = (bf16_t)(k01 >> 16); kt[144] = (bf16_t)(k23 & 0xffff); kt[216] = (bf16_t)(k23 >> 16);
          kt[288] = (bf16_t)(k45 & 0xffff); kt[360] = (bf16_t)(k45 >> 16); kt[432] = (bf16_t)(k67 & 0xffff); kt[504] = (bf16_t)(k67 >> 16);
          bf16_t* vt = VT + lc0 * 72 + lr;
          vt[0] = (bf16_t)(vreg.x & 0xffff); vt[72] = (bf16_t)(vreg.x >> 16); vt[144] = (bf16_t)(vreg.y & 0xffff); vt[216] = (bf16_t)(vreg.y >> 16);
          vt[288] = (bf16_t)(vreg.z & 0xffff); vt[360] = (bf16_t)(vreg.z >> 16); vt[432] = (bf16_t)(vreg.w & 0xffff); vt[504] = (bf16_t)(vreg.w >> 16); }
        __syncthreads();
        if (ck + 1 < 36) { const int ck1 = ck + 1; const int seq1 = ck1 >= 4; const int Ls1 = seq1 ? SEQ : CTX; const size_t rb1 = seq1 ? (size_t)b * SEQ : (size_t)MLAT + b * CTX; const int kk1 = seq1 ? ck1 - 4 : ck1;
            const int pos = dir ? Ls1 - 1 - (kk1 * 64 + lr) : kk1 * 64 + lr; const size_t row = rb1 + pos;
            qreg = *(const uint4*)(mlqk + row * 512 + hh * 64 + lc0); kreg = *(const uint4*)(mlqk + row * 512 + 256 + hh * 64 + lc0); vreg = *(const uint4*)(p + row * NP + 512 + hh * 64 + lc0);
            if (tid < 64) { const float* gp = gates + row * 16 + dir * 8 + hh; gi = gp[0]; gf = gp[4]; } }
#pragma unroll
        for (int j = 0; j < 2; ++j) { const int ti = 2 * wid + j; const int st = ti >> 2, t2 = ti & 3;
            f32x4 sv = (f32x4){0.f, 0.f, 0.f, 0.f};
            if (st <= t2) {
#pragma unroll
                for (int k2 = 0; k2 < 2; ++k2) { const bf16x8 af = *(const bf16x8*)(Ks + (st * 16 + fr) * 72 + k2 * 32 + quad * 8); const bf16x8 bq = *(const bf16x8*)(Qs + (t2 * 16 + fr) * 72 + k2 * 32 + quad * 8);
                    sv = mfma16(af, bq, sv); }
                const int t = t2 * 16 + fr; const float bt = btm[t];
#pragma unroll
                for (int i = 0; i < 4; ++i) { const int s_ = st * 16 + quad * 4 + i; sv[i] = s_ <= t ? sv[i] * expf(bt + aval[s_]) : 0.f; } }
            *(uint2*)(Ss + (t2 * 16 + fr) * 72 + st * 16 + quad * 4) = pack4(sv); }
        __syncthreads();
        { f32x4 oacc[3];
#pragma unroll
          for (int j = 0; j < 3; ++j) oacc[j] = (f32x4){0.f, 0.f, 0.f, 0.f};
#pragma unroll
          for (int k2 = 0; k2 < 2; ++k2) { const bf16x8 bS = *(const bf16x8*)(Ss + (tt * 16 + fr) * 72 + k2 * 32 + quad * 8); const bf16x8 bQ = *(const bf16x8*)(Qp + (tt * 16 + fr) * 72 + k2 * 32 + quad * 8);
              const bf16x8 bK = *(const bf16x8*)(KTw + (tt * 16 + fr) * 72 + k2 * 32 + quad * 8);
#pragma unroll
              for (int j = 0; j < 3; ++j) { const int dt = j < 2 ? 2 * grp + j : 4;
                  const bf16x8 aV = *(const bf16x8*)(VT + (dt * 16 + fr) * 72 + k2 * 32 + quad * 8); const bf16x8 aC = *(const bf16x8*)(Cs + (dt * 16 + fr) * 72 + k2 * 32 + quad * 8);
                  oacc[j] = mfma16(aV, bS, oacc[j]); oacc[j] = mfma16(aC, bQ, oacc[j]);
                  if (k2 == 0) Cacc[j] = Cacc[j] * sc[1];
                  Cacc[j] = mfma16(aV, bK, Cacc[j]); } }
          const int t = tt * 16 + fr;
          const float den = __shfl(oacc[2][0], fr);
          const float inv = 1.f / fmaxf(fabsf(den), expf(-mrow[t]));
          const int pos = dir ? Ls - 1 - (kk * 64 + t) : kk * 64 + t; const size_t row = rowbase + pos;
#pragma unroll
          for (int j = 0; j < 2; ++j) { const f32x4 o = oacc[j] * inv; *(f32x4*)(mlh + row * 256 + hh * 64 + (2 * grp + j) * 16 + quad * 4) = o; } }
        __syncthreads();
#pragma unroll
        for (int j = 0; j < 3; ++j) { const int dt = j < 2 ? 2 * grp + j : 4;
#pragma unroll
            for (int i = 0; i < 4; ++i) Cs[(dt * 16 + quad * 4 + i) * 72 + tt * 16 + fr] = f2bf(Cacc[j][i]); }
        if (tid == 0) sc[0] = sc[2];
    }
}

constexpr int MX_ML = 64, MX_HYL = 256, MX_GQAL = 256, MX_DIFL = 512, MX_GQAC = 32, MX_DIFC = 64, MX_HYC = 256;
constexpr int MX_TOTAL = MX_ML + MX_HYL + MX_GQAL + MX_DIFL + MX_GQAC + MX_DIFC + MX_HYC;

DEVI void mixer_phase(const Params& P, int cidx, int l, unsigned char* smem) {
    unsigned* ctr = (unsigned*)(opaque_ws(P) + WS_CTL) + cidx;
    int* s_item = (int*)smem;
    for (;;) {
        __syncthreads();
        if (threadIdx.x == 0) *s_item = (int)atomicAdd(ctr, 1u);
        __syncthreads();
        int it = *s_item;
        if (it >= (l == DEPTH - 1 ? MX_ML + MX_HYL + MX_GQAL + MX_DIFL : MX_TOTAL)) break;
        if (it < MX_ML) { ml_item(P, l, it >> 3, (it >> 1) & 3, it & 1, smem);
#ifdef PROBE_ML2
            __syncthreads(); ml_item(P, l, it >> 3, (it >> 1) & 3, it & 1, smem);
#endif
            continue; } it -= MX_ML;
#ifndef PROBE_MX
#define PROBE_MX 0
#endif
        if (it < MX_DIFL) { for (int pr = 0; pr < (PROBE_MX == 3 ? 2 : 1); ++pr) { if (pr) __syncthreads(); attn_item<true>(P, l, it >> 6, (it >> 4) & 3, it & 15, false, smem); } continue; } it -= MX_DIFL;
        if (it < MX_GQAL) { for (int pr = 0; pr < (PROBE_MX == 2 ? 2 : 1); ++pr) { if (pr) __syncthreads(); attn_item<false>(P, l, it >> 5, (it >> 4) & 1, it & 15, false, smem); } continue; } it -= MX_GQAL;
        if (it < MX_HYL) { for (int pr = 0; pr < (PROBE_MX == 1 ? 2 : 1); ++pr) { if (pr) __syncthreads(); hy_item<16>(P, l, it, smem); } continue; } it -= MX_HYL;
        if (it < MX_GQAC) { attn_item<false>(P, l, it >> 2, (it >> 1) & 1, it & 1, true, smem); continue; } it -= MX_GQAC;
        if (it < MX_DIFC) { attn_item<true>(P, l, it >> 3, (it >> 1) & 3, it & 1, true, smem); continue; } it -= MX_DIFC;
        hy_item<2>(P, l, it, smem);
    }
}

DEVI void final_phase(const Params& P, int l, unsigned char* smem) {
    const int tid = opaque_tid();
    const float* mlh0 = (const float*)(opaque_ws(P) + WS_MLH); const float* mlh1 = mlh0 + (size_t)MT * 256;
    const bf16_t* p = (const bf16_t*)(opaque_ws(P) + WS_P); const bf16_t* hyo = (const bf16_t*)(opaque_ws(P) + WS_HYO);
    bf16_t* cat = (bf16_t*)(opaque_ws(P) + WS_CAT);
    const float* ng = P.in[14] + (size_t)l * 256;
    bf16_t* lt = (bf16_t*)(smem + 1024);
    constexpr int TR = 32;
    const int ntile = ((l == DEPTH - 1 ? MLAT : MT) + TR - 1) / TR;
    for (int rt = opaque_bid(); rt < ntile; rt += gridDim.x) { const int row0 = rt * TR;
        for (int task = tid; task < TR * 64; task += 512) { const int r = task >> 6, c4 = (task & 63) * 4; const size_t row = row0 + r;
            const float4 a = *(const float4*)(mlh0 + row * 256 + c4), bq = *(const float4*)(mlh1 + row * 256 + c4);
            float4 h; h.x = a.x + bq.x; h.y = a.y + bq.y; h.z = a.z + bq.z; h.w = a.w + bq.w;
            float ss = h.x * h.x + h.y * h.y + h.z * h.z + h.w * h.w;
            ss += __shfl_xor(ss, 1); ss += __shfl_xor(ss, 2); ss += __shfl_xor(ss, 4); ss += __shfl_xor(ss, 8);
            const float rstd = rsqrtf(ss * (1.f / 64.f) + 1e-6f);
            const float4 g4 = *(const float4*)(ng + c4);
            const uint2 ov = *(const uint2*)(p + row * NP + 768 + c4);
            f32x4 y; y[0] = h.x * rstd * g4.x * sigmoid_fast(bflo(ov.x)); y[1] = h.y * rstd * g4.y * sigmoid_fast(bfhi(ov.x));
            y[2] = h.z * rstd * g4.z * sigmoid_fast(bflo(ov.y)); y[3] = h.w * rstd * g4.w * sigmoid_fast(bfhi(ov.y));
            *(uint2*)(cat + row * D + c4) = pack4(y); }
        for (int task = tid; task < 256 * (TR / 8); task += 512) { const int c = task / (TR / 8), ch = task % (TR / 8);
            const uint4 v = *(const uint4*)(hyo + (size_t)c * MT + row0 + ch * 8);
            bf16_t* d = lt + (size_t)(ch * 8) * 264 + c;
            d[0] = (bf16_t)(v.x & 0xffff); d[264] = (bf16_t)(v.x >> 16); d[528] = (bf16_t)(v.y & 0xffff); d[792] = (bf16_t)(v.y >> 16);
            d[1056] = (bf16_t)(v.z & 0xffff); d[1320] = (bf16_t)(v.z >> 16); d[1584] = (bf16_t)(v.w & 0xffff); d[1848] = (bf16_t)(v.w >> 16); }
        __syncthreads();
        for (int task = tid; task < TR * 32; task += 512) { const int r = task >> 5, c8 = (task & 31) * 8;
            *(uint4*)(cat + (size_t)(row0 + r) * D + 512 + c8) = *(const uint4*)(lt + (size_t)r * 264 + c8); }
        __syncthreads();
    }
}

#ifndef REPSTEP
#define REPSTEP -1
#endif
#define XBAR() do { XcdBarrier xb_; xb_.bar = (unsigned*)(opaque_ws(P) + WS_BAR); xb_.x = xb_xcc_id(); xb_.st = (volatile LAS3 unsigned*)(smem + 16); xcd_barrier(xb_); } while (0)
__global__ void __launch_bounds__(512) mega_fwd(Params P) {
    extern __shared__ __attribute__((aligned(16))) unsigned char smem[];
    cg::grid_group grid = cg::this_grid();
    if (threadIdx.x < 8) ((volatile LAS3 unsigned*)(smem + 16))[threadIdx.x] = 0u;
    __syncthreads();
    if (blockIdx.x == 0) { for (int i = threadIdx.x; i < (4096 + 16384) / 4; i += 512) ((unsigned*)(P.ws + WS_CTL))[i] = 0u; }
    phase0a(P, smem);
    grid.sync();
#ifdef PROBE_P0A
    phase0a(P, smem);
    grid.sync();
#endif
    (void)xcd_barrier_post((unsigned*)(opaque_ws(P) + WS_BAR), (volatile LAS3 unsigned*)(smem + 16));
    phase0b(P, smem);
    XBAR();
#ifdef PROBE_P0B
    phase0b(P, smem);
    XBAR();
#endif
    constexpr int NS = 10;
#ifdef PROBE_S
    unsigned long long pacc = 0;
#endif
#pragma unroll 1
    for (int step = 0; step < DEPTH * NS; ++step) {
        const int l = step / NS, s = step - l * NS;
#ifdef PROBE_S
        unsigned long long pt0 = 0; if (s == PROBE_S) pt0 = __builtin_amdgcn_s_memrealtime();
#endif
        if (s == 4) prep_phase(P, l, smem);
        else if (s == 5) mixer_phase(P, l, l, smem);
        else if (s == 6) final_phase(P, l, smem);
        else {
            int opA = 0, partA = 0, lA = l, opB = 0, partB = 0, B0 = 0, R = 0;
            const bool last = (l == DEPTH - 1);
            switch (s) {
            case 0: if (l > 0) { opA = 6; partA = 1; lA = l - 1; B0 = 32; R = 3; } opB = 1; break;
            case 1: opA = 2; opB = 1; partB = 1; break;
            case 2: opA = 2; partA = 1; opB = 3; B0 = 32; R = 3; break;
            case 3: opA = 3; partA = 1; break;
            case 7: opA = 4; break;
            case 8: if (!last) { opA = 4; partA = 1; B0 = 32; R = 1; } opB = 5; break;
            default: opA = 6; if (!last) { opB = 5; partB = 1; } break;
            }
#pragma unroll 1
            for (int jj = 0; jj < 2; ++jj) {
                const int op = jj ? opB : opA, part = jj ? partB : partA, lj = jj ? l : lA;
                if (op == 0) continue;
                unsigned char* ws = opaque_ws(P);
                const float* modl = (const float*)(ws + WS_MOD) + (size_t)lj * 9 * 9216;
                float* ssqb = (float*)(ws + WS_SSQ);
                GemmJob J;
                J.nM = part ? 8 : 64; J.pm0 = part ? 64 : 0; J.B0 = jj ? B0 : 0; J.R = jj ? R : 0; J.nK = 1; J.order = 0; J.K = 1024; J.ld = 1024;
                J.hl = P.out; J.hc = (float*)(ws + WS_HCTX); J.gates = (float*)(ws + WS_GATES); J.gb = P.in[11] + lj * 16;
                J.obf = nullptr; J.gate = modl; J.fac = 0.f; J.aout = nullptr; J.ng = P.in[6]; J.nscale = modl; J.ssq = ssqb; J.Sb = nullptr;
                if (op == 1 || op == 5) { const int f = op == 1 ? 0 : 1; J.A = (const bf16_t*)(ws + WS_A); J.Bt = (const bf16_t*)(ws + WS_W13) + (size_t)(lj * 2 + f) * 5632 * 1024; J.nN = 22; J.epi = 0; J.obf = (bf16_t*)(ws + WS_HID);
                    J.ssq = ssqb + (size_t)(lj * 3 + (f ? 2 : 0)) * MT; J.Sb = (const float*)(ws + WS_SB) + (size_t)(lj * 2 + f) * 9 * 5632; }
                else if (op == 2 || op == 6) { const int f = op == 2 ? 0 : 1; J.A = (const bf16_t*)(ws + WS_HID); J.Bt = (const bf16_t*)(ws + WS_W2) + (size_t)(lj * 2 + f) * 1024 * 2816; J.nN = 4; J.K = 2816; J.ld = 2816; J.epi = 1;
                    J.gate = modl + (f == 0 ? 2 : 8) * 1024; J.fac = 0.5f;
                    const bool fuse = (f == 0) || (lj + 1 < DEPTH); const int ln = (f == 1 && lj + 1 < DEPTH) ? lj + 1 : lj;
                    J.aout = fuse ? (bf16_t*)(ws + WS_A) : (bf16_t*)nullptr; J.ng = P.in[6] + (size_t)(ln * 3 + (f == 0 ? 1 : 0)) * 1024;
                    J.nscale = (const float*)(ws + WS_MOD) + (size_t)ln * 9 * 9216 + (f == 0 ? 4 : 1) * 1024; J.ssq = ssqb + (size_t)(ln * 3 + (f == 0 ? 1 : 0)) * MT; }
                else if (op == 3) { J.A = (const bf16_t*)(ws + WS_A); J.Bt = (const bf16_t*)(ws + WS_WIN) + (size_t)lj * NPG * 1024; J.nN = 13; J.epi = 2; J.obf = (bf16_t*)(ws + WS_P);
                    J.ssq = ssqb + (size_t)(lj * 3 + 1) * MT; J.Sb = (const float*)(ws + WS_SBIN) + (size_t)lj * 9 * NPG; }
                else { J.A = (const bf16_t*)(ws + WS_CAT); J.Bt = (const bf16_t*)(ws + WS_WOUT) + (size_t)lj * 1024 * 1024; J.nN = 4; J.epi = 1; J.gate = modl + 5 * 1024; J.fac = 1.f;
                    J.aout = (bf16_t*)(ws + WS_A); J.ng = P.in[6] + (size_t)(lj * 3 + 2) * 1024; J.nscale = modl + 7 * 1024; J.ssq = ssqb + (size_t)(lj * 3 + 2) * MT; }
                run_job(smem, J);
            }
        }
        XBAR();
#ifdef PROBE_S
        if (s == PROBE_S) pacc += __builtin_amdgcn_s_memrealtime() - pt0;
#endif
    }
#ifdef PROBE_EPI
    if (blockIdx.x == 0) { const unsigned pe = *(volatile LAS3 unsigned*)(smem + 32); const unsigned long long t1 = __builtin_amdgcn_s_memrealtime(); while (__builtin_amdgcn_s_memrealtime() - t1 < 4ull * pe) __builtin_amdgcn_s_sleep(8); }
#endif
#ifdef PROBE_S
    if (blockIdx.x == 0) { const unsigned long long t1 = __builtin_amdgcn_s_memrealtime(); while (__builtin_amdgcn_s_memrealtime() - t1 < 4ull * pacc) __builtin_amdgcn_s_sleep(8); }
#endif
}

extern "C" void kernel_launch(void* const* d_in, const int* in_sizes, int n_in, void* d_out, int out_size, void* d_ws, size_t ws_size, hipStream_t stream) {
    static int grid_blocks = 0;
    if (grid_blocks == 0) {
        if (n_in != 28 || ws_size < WS_END) { fprintf(stderr, "kernel_launch: unexpected n_in %d or ws_size %zu (need %zu)\n", n_in, ws_size, (size_t)WS_END); grid_blocks = -1; return; }
        int dev = 0, cus = 0, per_cu = 0;
        hipGetDevice(&dev);
        hipDeviceGetAttribute(&cus, hipDeviceAttributeMultiprocessorCount, dev);
        if (hipFuncSetAttribute((const void*)mega_fwd, hipFuncAttributeMaxDynamicSharedMemorySize, LDS_BYTES) != hipSuccess) { fprintf(stderr, "kernel_launch: hipFuncSetAttribute failed\n"); }
        if (hipOccupancyMaxActiveBlocksPerMultiprocessor(&per_cu, (const void*)mega_fwd, 512, LDS_BYTES) != hipSuccess || per_cu < 1) { fprintf(stderr, "kernel_launch: occupancy query gave %d\n", per_cu); per_cu = 1; }
        (void)hipGetLastError();
        grid_blocks = cus;
    }
    if (grid_blocks < 0) return;
    Params p{};
    for (int i = 0; i < 28; ++i) p.in[i] = (const float*)d_in[i];
    p.out = (float*)d_out; p.ws = (unsigned char*)d_ws;
    void* args[] = {&p};
    hipError_t e = hipLaunchCooperativeKernel((const void*)mega_fwd, dim3(grid_blocks), dim3(512), args, LDS_BYTES, stream);
    if (e != hipSuccess) fprintf(stderr, "cooperative launch failed: %s (grid %d)\n", hipGetErrorString(e), grid_blocks);
}
```

```cpp
#define REPSTEP -1
#include <hip/hip_runtime.h>
#include <hip/hip_cooperative_groups.h>
#include <cstdio>
namespace cg = cooperative_groups;
__device__ __forceinline__ int opaque_tid() { int t = threadIdx.x; asm volatile("" : "+v"(t)); return t; }
__device__ __forceinline__ int opaque_bid() { int b = blockIdx.x; asm volatile("" : "+s"(b)); return b; }
namespace pg8 {
#define PG8_LAS __attribute__((address_space(3)))
typedef unsigned short bf16_t;
typedef short bf16x8 __attribute__((ext_vector_type(8)));
typedef float f32x4 __attribute__((ext_vector_type(4)));
typedef unsigned u32x4 __attribute__((ext_vector_type(4)));
constexpr int BM = 256, BK = 64, HALF = 128, HTB = HALF * BK * 2  , STAGE_BYTES = 8 * HTB, NXCD = 8, WGM = 8;

__host__ __device__ __forceinline__ int lds_byte(int r, int c) { const int st = (r >> 4) * 2 + (c >> 5), rr = r & 15, cc = c & 31, ob = rr * 64 + cc * 2; return st * 1024 + (ob ^ (((ob >> 9) & 1) << 5)); }
__host__ __device__ __forceinline__ void stage_rc(int b, int& R, int& C) { const int st = b / 1024, sb = b % 1024, swz = sb ^ (((sb >> 9) & 1) << 5); R = (st >> 1) * 16 + swz / 64; C = (st & 1) * 32 + (swz % 64) / 2; }
__host__ __device__ __forceinline__ int perm32(int rho) { const int n = rho >> 4, i = rho & 15; return 8 * (i >> 2) + 4 * n + (i & 3); }

struct Unit { int pm, pn, kp; };
struct Gemm { const bf16_t* A; const bf16_t* Bt; int M, N, K, ld; };

struct StaticOrder {
    int nM, nN, nwg, G, c;
    __host__ __device__ void init(int M, int N, int G_, int c_) { nM = M / BM; nN = N / BM; nwg = nM * nN; G = G_; c = c_; }
    __host__ __device__ bool next(int i, Unit& u) const { return at((long)i * G + c, u); }
    __host__ __device__ bool at(const long L, Unit& u) const {
        if (L >= nwg) return false;
        int wgid = (int)L; { const int q = nwg / NXCD, r = nwg % NXCD, xcd = wgid % NXCD, off = wgid / NXCD; wgid = (xcd < r ? xcd * (q + 1) : r * (q + 1) + (xcd - r) * q) + off; }
        const int nig = WGM * nN, gid = wgid / nig, fm = gid * WGM, gsz = (nM - fm) < WGM ? (nM - fm) : WGM;
        u.pm = fm + ((wgid % nig) % gsz); u.pn = (wgid % nig) / gsz; u.kp = 0; return true;
    }
    __device__ __forceinline__ void a_ready(const Unit&) const {}
    __device__ __forceinline__ void done(const Unit&) const {}
};
struct SplitOrder {
    int nN, nK, total, G, c;
    __host__ __device__ void init(int nM_, int nN_, int nK_, int G_, int c_) { nN = nN_; nK = nK_; total = nM_ * nN_ * nK_; G = G_; c = c_; }
    __host__ __device__ bool next(int i, Unit& u) const { const int L = i * G + c; if (L >= total) return false; u.kp = L % nK; const int r = L / nK; u.pn = r % nN; u.pm = r / nN; return true; }
    __device__ __forceinline__ void a_ready(const Unit&) const {}
    __device__ __forceinline__ void done(const Unit&) const {}
};
__device__ __forceinline__ unsigned cvt_pk_bf16(float lo, float hi) { unsigned r; asm volatile("v_cvt_pk_bf16_f32 %0, %1, %2" : "=v"(r) : "v"(lo), "v"(hi)); return r; }
template <class Epi, class Sched, bool STAMP = false>
__device__ __forceinline__ void gemm_phase(PG8_LAS unsigned char* lds, const Gemm g, const Sched& S, const Epi& E, unsigned long long* stamps) {
    const int tid = opaque_tid(), wid = __builtin_amdgcn_readfirstlane(tid >> 6), lane = tid & 63, wr = wid >> 2, wc = wid & 3, fr = lane & 15, fq = lane >> 4;
    const int K = g.K, LD = g.ld, nt = K / BK;
    int ts_lo = 0, ts_hi = 0, nts = 0; const unsigned long long rt_entry = STAMP ? (unsigned long long)wall_clock64() : 0ull;
#define PG8_STAMP() do { if (STAMP && wid == 0 && nts < 64) { const unsigned long long _c = (unsigned long long)clock64(); \
        ts_lo = (lane == nts) ? (int)(unsigned)_c : ts_lo; ts_hi = (lane == nts) ? (int)(unsigned)(_c >> 32) : ts_hi; ++nts; } } while (0)
    PG8_STAMP();
    unsigned voffA[2], voffB[2];
#pragma unroll
    for (int i = 0; i < 2; ++i) { int R, C; stage_rc(tid * 16 + i * 8192, R, C); const int Rb = Epi::PERM ? ((R & ~31) + perm32(R & 31)) : R;
        voffA[i] = (unsigned)(R * LD + C) * 2u; voffB[i] = (unsigned)(Rb * LD + C) * 2u; }
    const size_t kstep = (size_t)(BK * 2);
    const size_t hstep = (size_t)HALF * LD * 2; const size_t kpstep = (size_t)K * 2;
    const size_t tstep = 2 * hstep;
    const unsigned ldsw = (unsigned)wid * 1024u;
    const int aoff = lds_byte(wr * 64 + fr, fq * 8), boff = lds_byte(wc * 32 + fr, fq * 8);
#define PG8_SA(b, h) (((b) * 2 + (h)) * HTB)
#define PG8_SB(b, h) ((4 + (b) * 2 + (h)) * HTB)
#define PG8_STAGE(bufoff, gbase, voff) do { _Pragma("unroll") for (int _i = 0; _i < 2; ++_i) \
        __builtin_amdgcn_global_load_lds((const unsigned*)((const char*)(gbase) + (voff)[_i]), (PG8_LAS unsigned*)(lds + (bufoff) + ldsw + _i * 8192), 16, 0, 0); } while (0)
#define PG8_LDA(dst, b, h) do { _Pragma("unroll") for (int m = 0; m < 4; ++m) _Pragma("unroll") for (int k = 0; k < 2; ++k) dst[m][k] = *(const PG8_LAS bf16x8*)(lds + PG8_SA(b, h) + aoff + m * 2048 + k * 1024); } while (0)
#define PG8_LDB(dst, b, h) do { _Pragma("unroll") for (int n = 0; n < 2; ++n) _Pragma("unroll") for (int k = 0; k < 2; ++k) dst[n][k] = *(const PG8_LAS bf16x8*)(lds + PG8_SB(b, h) + boff + n * 2048 + k * 1024); } while (0)
#define PG8_MMA(ai, bj, At, Bt) do { __builtin_amdgcn_s_setprio(1); _Pragma("unroll") for (int m = 0; m < 4; ++m) _Pragma("unroll") for (int n = 0; n < 2; ++n) _Pragma("unroll") for (int k = 0; k < 2; ++k) \
        acc[ai][bj][m][n] = __builtin_amdgcn_mfma_f32_16x16x32_bf16(Bt[n][k], At[m][k], acc[ai][bj][m][n], 0, 0, 0); __builtin_amdgcn_s_setprio(0); } while (0)
#define PG8_WAIT_V(n) asm volatile("s_waitcnt vmcnt(" #n ")" ::: "memory")
#define PG8_WAIT_L(n) asm volatile("s_waitcnt lgkmcnt(" #n ")" ::: "memory")
#define PG8_BAR __builtin_amdgcn_s_barrier()
#define PG8_SCHED __builtin_amdgcn_sched_barrier(0)
    Unit cur, nxt; int ui = 0;
    if (!S.next(0, cur)) return;
    f32x4 acc[2][2][4][2];
#pragma unroll
    for (int a = 0; a < 2; ++a)
#pragma unroll
        for (int b = 0; b < 2; ++b)
#pragma unroll
            for (int m = 0; m < 4; ++m)
#pragma unroll
                for (int n = 0; n < 2; ++n) acc[a][b][m][n] = (f32x4){0.f, 0.f, 0.f, 0.f};
    bf16x8 At[4][2], B0[2][2], B1[2][2];
    const char* cA = (const char*)g.A + (size_t)cur.pm * tstep + (size_t)cur.kp * kpstep; const char* cB = (const char*)g.Bt + (size_t)cur.pn * tstep + (size_t)cur.kp * kpstep;
    S.a_ready(cur);
    PG8_STAGE(PG8_SB(0, 0), cB, voffB); PG8_STAGE(PG8_SA(0, 0), cA, voffA); PG8_STAGE(PG8_SB(0, 1), cB + hstep, voffB); PG8_STAGE(PG8_SA(0, 1), cA + hstep, voffA);
    if (wr == 1) PG8_BAR;
    PG8_WAIT_V(4); PG8_BAR;
    PG8_STAGE(PG8_SB(1, 0), cB + kstep, voffB); PG8_STAGE(PG8_SA(1, 0), cA + kstep, voffA); PG8_STAGE(PG8_SB(1, 1), cB + hstep + kstep, voffB);
    PG8_WAIT_V(6); PG8_BAR;
    PG8_STAMP();
    for (;;) {
        const bool has_next = S.next(ui + 1, nxt);
        const char* nA = has_next ? (const char*)g.A + (size_t)nxt.pm * tstep + (size_t)nxt.kp * kpstep : cA; const char* nB = has_next ? (const char*)g.Bt + (size_t)nxt.pn * tstep + (size_t)nxt.kp * kpstep : cB;
        for (int t = 0; t < nt; t += 2) {
            const bool last = (t == nt - 2);
            const char* a1 = cA + (size_t)(t + 1) * kstep;
            const char* a2 = last ? nA : cA + (size_t)(t + 2) * kstep; const char* b2 = last ? nB : cB + (size_t)(t + 2) * kstep;
            const char* a3 = a2 + kstep; const char* b3 = b2 + kstep;
            if (last && has_next) S.a_ready(nxt);
            PG8_LDB(B0, 0, 0); PG8_SCHED; PG8_LDA(At, 0, 0); PG8_STAGE(PG8_SA(1, 1), a1 + hstep, voffA);
            PG8_WAIT_L(8); PG8_BAR; PG8_WAIT_L(0); PG8_MMA(0, 0, At, B0); PG8_BAR; PG8_SCHED;
            PG8_LDB(B1, 0, 1); PG8_STAGE(PG8_SB(0, 0), b2, voffB);
            PG8_BAR; PG8_WAIT_L(0); PG8_MMA(0, 1, At, B1); PG8_BAR;
            PG8_LDA(At, 0, 1); PG8_STAGE(PG8_SA(0, 0), a2, voffA);
            PG8_BAR; PG8_WAIT_L(0); PG8_MMA(1, 0, At, B0); PG8_BAR; PG8_SCHED;
            PG8_STAGE(PG8_SB(0, 1), b2 + hstep, voffB);
            PG8_WAIT_V(6); PG8_BAR; PG8_MMA(1, 1, At, B1); PG8_BAR;
            PG8_LDB(B0, 1, 0); PG8_SCHED; PG8_LDA(At, 1, 0); PG8_STAGE(PG8_SA(0, 1), a2 + hstep, voffA);
            PG8_WAIT_L(8); PG8_BAR; PG8_WAIT_L(0); PG8_MMA(0, 0, At, B0); PG8_BAR; PG8_SCHED;
            PG8_LDB(B1, 1, 1); PG8_STAGE(PG8_SB(1, 0), b3, voffB);
            PG8_BAR; PG8_WAIT_L(0); PG8_MMA(0, 1, At, B1); PG8_BAR;
            PG8_LDA(At, 1, 1); PG8_STAGE(PG8_SA(1, 0), a3, voffA);
            PG8_BAR; PG8_WAIT_L(0); PG8_MMA(1, 0, At, B0); PG8_BAR; PG8_SCHED;
            PG8_STAGE(PG8_SB(1, 1), b3 + hstep, voffB);
            PG8_WAIT_V(6); PG8_BAR; PG8_MMA(1, 1, At, B1); PG8_BAR;
        }
        PG8_STAMP();
#ifdef PROBE_EPI
        const unsigned long long pe0 = __builtin_amdgcn_s_memrealtime();
#endif
        if constexpr (!Epi::AFTER_DRAIN) { E(acc, cur, nxt, has_next, wr, wc, fr, fq); S.done(cur); }
#ifdef PROBE_EPI
        asm volatile("s_waitcnt vmcnt(0)" ::: "memory");
        if (tid == 0) { *(volatile PG8_LAS unsigned*)(lds - 1024 + 32) += (unsigned)(__builtin_amdgcn_s_memrealtime() - pe0); }
#endif
        PG8_STAMP();
        if (!has_next) break;
#pragma unroll
        for (int a = 0; a < 2; ++a)
#pragma unroll
            for (int b = 0; b < 2; ++b)
#pragma unroll
                for (int m = 0; m < 4; ++m)
#pragma unroll
                    for (int n = 0; n < 2; ++n) acc[a][b][m][n] = (f32x4){0.f, 0.f, 0.f, 0.f};
        cur = nxt; cA = nA; cB = nB; ++ui;
    }
    PG8_WAIT_V(0);
    if (wr == 0) PG8_BAR;
    PG8_BAR;
    if constexpr (Epi::AFTER_DRAIN) { E.fused(acc, cur, wr, wc, fr, fq, lds, wid, lane); S.done(cur); }
    PG8_STAMP();
    if (STAMP && wid == 0) { stamps[lane] = lane < nts ? (((unsigned long long)(unsigned)ts_hi << 32) | (unsigned)ts_lo) : 0ull;
        if (lane == 62) stamps[62] = rt_entry; if (lane == 63) stamps[63] = (unsigned long long)wall_clock64(); }
#undef PG8_STAMP
#undef PG8_SA
#undef PG8_SB
#undef PG8_STAGE
#undef PG8_LDA
#undef PG8_LDB
#undef PG8_MMA
#undef PG8_WAIT_V
#undef PG8_WAIT_L
#undef PG8_BAR
#undef PG8_SCHED
}
}

using pg8::bf16_t; using pg8::bf16x8; using pg8::f32x4;
#define DEVI __device__ __forceinline__
#define LAS3 __attribute__((address_space(3)))
#define G1 __attribute__((address_space(1)))

constexpr int D = 1024, NB = 8, SEQ = 2048, CTX = 256, DEPTH = 4, FF = 2816, NIN = 3088, NP = 3072, NPG = 3328;
constexpr int MLAT = NB * SEQ, MCTX = NB * CTX, MT = MLAT + MCTX, KEYS = CTX + SEQ;
constexpr float LOG2E = 1.4426950408889634f;
constexpr int LDS_BYTES = 160 * 1024;
#ifndef SKIPMASK
#define SKIPMASK 0
#endif
#ifndef GM
#define GM 0
#endif
#ifndef P0M
#define P0M 0
#endif

constexpr size_t al256(size_t x) { return (x + 255) & ~(size_t)255; }
constexpr size_t WS_CTL = 0;
constexpr size_t WS_BAR = 4096;
constexpr size_t WS_MOD = 4096 + 16384;
constexpr size_t WS_W13 = WS_MOD + al256((size_t)DEPTH * 9 * 9216 * 4);
constexpr size_t WS_W2 = WS_W13 + al256((size_t)DEPTH * 2 * 5632 * 1024 * 2);
constexpr size_t WS_WIN = WS_W2 + al256((size_t)DEPTH * 2 * 1024 * 2816 * 2);
constexpr size_t WS_WOUT = WS_WIN + al256((size_t)DEPTH * NPG * 1024 * 2);
constexpr size_t WS_HF = WS_WOUT + al256((size_t)DEPTH * 1024 * 1024 * 2);
constexpr size_t HF_LAYER = (size_t)512 * (SEQ + CTX);
constexpr size_t WS_HFS = WS_HF + al256((size_t)DEPTH * HF_LAYER * 4);
constexpr size_t WS_ROPEG = WS_HFS + al256((size_t)DEPTH * 36 * 512 * 4);
constexpr size_t WS_ROPED = WS_ROPEG + al256((size_t)SEQ * 64 * 4);
constexpr size_t WS_HCTX = WS_ROPED + al256((size_t)SEQ * 32 * 4);
constexpr size_t WS_A = WS_HCTX + al256((size_t)MCTX * D * 4);
constexpr size_t WS_P = WS_A + al256((size_t)MT * D * 2);
constexpr size_t WS_HID = WS_P + al256((size_t)MT * NP * 2);
constexpr size_t WS_GATES = WS_HID + al256((size_t)MT * FF * 2);
constexpr size_t WS_CAT = WS_GATES + al256((size_t)MT * 16 * 4);
constexpr size_t WS_Q = WS_CAT + al256((size_t)MT * D * 2);
constexpr size_t WS_K = WS_Q + al256((size_t)NB * 8 * KEYS * 64 * 2);
constexpr size_t WS_VT = WS_K + al256((size_t)NB * 6 * KEYS * 64 * 2);
constexpr size_t WS_MLQK = WS_VT + al256((size_t)NB * 6 * KEYS * 64 * 2);
constexpr size_t WS_HYU = WS_MLQK + al256((size_t)MT * 512 * 4);
constexpr size_t WS_HYO = WS_HYU + al256((size_t)768 * MT * 2);
constexpr size_t WS_MLH = WS_HYO + al256((size_t)256 * MT * 2);
constexpr size_t WS_SB = WS_MLH + al256((size_t)2 * MT * 256 * 4);
constexpr size_t WS_SBIN = WS_SB + al256((size_t)DEPTH * 2 * 9 * 5632 * 4);
constexpr size_t WS_SSQ = WS_SBIN + al256((size_t)DEPTH * 9 * NPG * 4);
constexpr size_t WS_END = WS_SSQ + al256((size_t)DEPTH * 3 * MT * 4);
static_assert((size_t)MT * FF * 2 <= (size_t)MT * NP * 2, "HID must fit in P region");

struct Params { const float* in[28]; float* out; unsigned char* ws; };
__device__ __forceinline__ unsigned char* opaque_ws(const Params& P) { unsigned char* w = P.ws; asm volatile("" : "+s"(w)); return w; }

DEVI bf16_t f2bf(float f) { unsigned u = __float_as_uint(f); u += 0x7FFFu + ((u >> 16) & 1u); return (bf16_t)(u >> 16); }
typedef __bf16 bf16x2_t __attribute__((ext_vector_type(2)));
DEVI unsigned pack2(float lo, float hi) { bf16x2_t v; v[0] = (__bf16)lo; v[1] = (__bf16)hi; return __builtin_bit_cast(unsigned, v); }
DEVI float bflo(unsigned u) { return __uint_as_float(u << 16); }
DEVI float bfhi(unsigned u) { return __uint_as_float(u & 0xffff0000u); }
DEVI float bf2f(bf16_t b) { return __uint_as_float(((unsigned)b) << 16); }
DEVI float wave_sum(float v) { for (int o = 32; o; o >>= 1) v += __shfl_xor(v, o); return v; }
DEVI float wave_max(float v) { for (int o = 32; o; o >>= 1) v = fmaxf(v, __shfl_xor(v, o)); return v; }
DEVI float silu_fast(float a) { return a * __builtin_amdgcn_rcpf(1.f + __builtin_amdgcn_exp2f(a * -1.4426950408889634f)); }
DEVI float silu_prec(float a) { return a / (1.f + expf(-a)); }
DEVI float sigmoid_fast(float a) { return __builtin_amdgcn_rcpf(1.f + __builtin_amdgcn_exp2f(a * -1.4426950408889634f)); }
DEVI float logsigmoid(float x) { return x >= 0.f ? -log1pf(expf(-x)) : x - log1pf(expf(x)); }
DEVI uint2 pack4(f32x4 v) { uint2 r; r.x = pack2(v[0], v[1]); r.y = pack2(v[2], v[3]); return r; }
typedef unsigned u32x2 __attribute__((ext_vector_type(2)));
typedef unsigned u32x4v __attribute__((ext_vector_type(4)));
DEVI u32x4v pack8v(f32x4 a, f32x4 b) { u32x4v r; r[0] = pack2(a[0], a[1]); r[1] = pack2(a[2], a[3]); r[2] = pack2(b[0], b[1]); r[3] = pack2(b[2], b[3]); return r; }
DEVI u32x2 pack4v(f32x4 v) { u32x2 r; r[0] = pack2(v[0], v[1]); r[1] = pack2(v[2], v[3]); return r; }
DEVI f32x4 mfma16(bf16x8 a, bf16x8 b, f32x4 c) { return __builtin_amdgcn_mfma_f32_16x16x32_bf16(a, b, c, 0, 0, 0); }


#define XB_TMO      128
#define XB_XCNT(j)  (256  + 64 * (j))
#define XB_XSUB(j)  (1280 + 64 * (j))
#define XB_XGEN(j)  (2304 + 64 * (j))
#define XB_TOP      3328
#define XB_TOPGEN   3392
#define XCD_BAR_WORDS 3456
#define XB_SPIN_CAP (1u << 20)
DEVI unsigned xb_ld(unsigned* p)              { return __hip_atomic_load(p, __ATOMIC_RELAXED, __HIP_MEMORY_SCOPE_AGENT); }
DEVI unsigned xb_add(unsigned* p, unsigned v) { return __hip_atomic_fetch_add(p, v, __ATOMIC_RELAXED, __HIP_MEMORY_SCOPE_AGENT); }
DEVI unsigned xb_xcc_id() { return (unsigned)__builtin_amdgcn_s_getreg((3 << 11) | 20) & 0xFu; }
#define XB_SPIN(cond, bar) do { unsigned _sp = 0; while (cond) { __builtin_amdgcn_s_sleep(1); \
    if ((++_sp & 255u) == 0u) { if (xb_ld(&(bar)[XB_TMO])) break; if (_sp > XB_SPIN_CAP) { atomicAdd(&(bar)[XB_TMO], 1u); break; } } } } while (0)
struct XcdBarrier { unsigned* bar; unsigned x; volatile LAS3 unsigned* st; };
DEVI XcdBarrier xcd_barrier_post(unsigned* bar, volatile LAS3 unsigned* st) {
    XcdBarrier b; b.bar = bar; b.x = xb_xcc_id(); b.st = st;
    if (opaque_tid() == 0) (void)xb_add(&bar[XB_XCNT(b.x)], 1u);
    return b;
}
DEVI void xcd_barrier_complete(unsigned* bar, unsigned x, unsigned& nloc, unsigned& nx) {
    const unsigned G = gridDim.x * gridDim.y * gridDim.z;
    unsigned sum, cnt, mine, sp = 0u;
    for (;;) {
        sum = 0u; cnt = 0u; mine = 0u;
#pragma unroll
        for (unsigned j = 0; j < 16; ++j) { const unsigned c = xb_ld(&bar[XB_XCNT(j)]); sum += c; cnt += (c > 0u) ? 1u : 0u; mine = (j == x) ? c : mine; }
        if (sum == G) break;
        __builtin_amdgcn_s_sleep(1);
        if ((++sp & 255u) == 0u) { if (xb_ld(&bar[XB_TMO])) break; if (sp > XB_SPIN_CAP) { atomicAdd(&bar[XB_TMO], 1u); break; } }
    }
    nloc = mine > 0u ? mine : 1u; nx = cnt > 0u ? cnt : 1u;
}
#ifndef USE_XCD
#define USE_XCD 1
#endif
DEVI void xcd_barrier(const XcdBarrier& b) {
#if !USE_XCD
    cg::this_grid().sync(); return;
#endif
    asm volatile("s_waitcnt vmcnt(0)" ::: "memory");
    __syncthreads();
    if (opaque_tid() == 0) {
        unsigned* bar = b.bar;
        __builtin_amdgcn_s_waitcnt(0);
        unsigned nloc = b.st[0], nx = b.st[1];
        if (nloc == 0u) { xcd_barrier_complete(bar, b.x, nloc, nx); b.st[0] = nloc; b.st[1] = nx; }
        const unsigned old = xb_add(&bar[XB_XSUB(b.x)], 1u);
        const unsigned gen = old / nloc;
        if (old + 1u == (gen + 1u) * nloc) {
            __builtin_amdgcn_fence(__ATOMIC_RELEASE, "agent");
            asm volatile("s_waitcnt vmcnt(0)" ::: "memory");
            const unsigned og = xb_add(&bar[XB_TOP], 1u);
            const unsigned tg = og / nx;
            if (og + 1u == (tg + 1u) * nx) xb_add(&bar[XB_TOPGEN], 1u);
            else XB_SPIN(xb_ld(&bar[XB_TOPGEN]) == tg, bar);
            __builtin_amdgcn_fence(__ATOMIC_ACQUIRE, "agent");
            xb_add(&bar[XB_XGEN(b.x)], 1u);
            asm volatile("s_waitcnt vmcnt(0)" ::: "memory");
        } else {
            XB_SPIN(xb_ld(&bar[XB_XGEN(b.x)]) == gen, bar);
            __builtin_amdgcn_fence(__ATOMIC_ACQUIRE, "agent");
            asm volatile("s_waitcnt vmcnt(0)" ::: "memory");
        }
    }
    __syncthreads();
}

constexpr int EPW_OFF = 1024 + 131072, EPW_STRIDE = 192 * 4;
DEVI void epw_fill(unsigned char* smem, int mode, const pg8::Unit& u, int wid, int lane, const float* ssq_, const float* Sb_, int sbstride, float (&v)[3]) {
    const G1 float* ssq = (const G1 float*)ssq_; const G1 float* Sb = (const G1 float*)Sb_;
    const int wr = wid >> 2, wc = wid & 3; const int r9 = u.pm < 64 ? (u.pm >> 3) : 8;
#pragma unroll
    for (int k = 0; k < 2; ++k) { const int idx = lane + 64 * k; const int ai = idx >> 6, m = (idx >> 4) & 3, f = idx & 15; v[k] = ssq[u.pm * 256 + ai * 128 + wr * 64 + m * 16 + f]; }
    { const int bj = lane >> 5, c = lane & 31; v[2] = Sb[(size_t)r9 * sbstride + u.pn * 256 + bj * 128 + wc * 32 + c]; }
    (void)mode; (void)smem;
}
DEVI void epw_store(unsigned char* smem, int wid, int lane, const float (&v)[3]) {
    float* w = (float*)(smem + EPW_OFF + wid * EPW_STRIDE);
    w[lane] = rsqrtf(v[0] * (1.f / 1024.f) + 1e-6f); w[64 + lane] = rsqrtf(v[1] * (1.f / 1024.f) + 1e-6f); w[128 + lane] = v[2];
}
struct EpiSwiglu {
    static constexpr bool PERM = true, AFTER_DRAIN = false;
    static DEVI void apply(const f32x4 (&acc)[2][2][4][2], const pg8::Unit& u, int wr, int wc, int fr, int fq, bf16_t* H_, const float* epw) {
        G1 bf16_t* H = (G1 bf16_t*)H_;
        const int row0 = u.pm * 256 + wr * 64 + fr, col0 = u.pn * 128 + wc * 32 + 8 * fq;
        f32x4 sa[2], sb[2];
#pragma unroll
        for (int n = 0; n < 2; ++n) { sa[n] = *(const f32x4*)(epw + 128 + 8 * fq + 4 * n); sb[n] = *(const f32x4*)(epw + 160 + 8 * fq + 4 * n); }
#pragma unroll
        for (int ai = 0; ai < 2; ++ai)
#pragma unroll
            for (int m = 0; m < 4; ++m) { const int row = row0 + ai * 128 + m * 16; G1 bf16_t* rowp = H + (size_t)row * FF + col0;
                const float rstd = epw[(ai * 4 + m) * 16 + fr];
                f32x4 v[2];
#pragma unroll
                for (int n = 0; n < 2; ++n) { const f32x4 a = acc[ai][0][m][n] * rstd + sa[n], b = acc[ai][1][m][n] * rstd + sb[n];
#pragma unroll
                    for (int i = 0; i < 4; ++i) v[n][i] = silu_fast(a[i]) * b[i]; }
                *(G1 u32x4v*)rowp = pack8v(v[0], v[1]); }
    }
};
struct EpiResid {
    static constexpr bool PERM = true, AFTER_DRAIN = false;
    static DEVI void apply(const f32x4 (&acc)[2][2][4][2], const pg8::Unit& u, int wr, int wc, int fr, int fq, float* hl_, float* hc_, const float* gate_, float fac, bf16_t* aout_, const float* ng_, const float* nscale_, float* ssq_) {
        G1 float* hl = (G1 float*)hl_; G1 float* hc = (G1 float*)hc_; const G1 float* gate = (const G1 float*)gate_; G1 bf16_t* aout = (G1 bf16_t*)aout_; const G1 float* ng = (const G1 float*)ng_; const G1 float* nscale = (const G1 float*)nscale_;
        const int row0 = u.pm * 256 + wr * 64 + fr, col0 = u.pn * 256 + wc * 32 + 8 * fq;
        const int r9 = u.pm < 64 ? (u.pm >> 3) : 8;
        const G1 float* gp = gate + (size_t)r9 * 9216 + col0;
        f32x4 gv[2][2];
#pragma unroll
        for (int bj = 0; bj < 2; ++bj)
#pragma unroll
            for (int n = 0; n < 2; ++n) gv[bj][n] = *(const G1 f32x4*)(gp + bj * 128 + n * 4) * fac;
        if (aout_ == nullptr) {
#pragma unroll
            for (int ai = 0; ai < 2; ++ai)
#pragma unroll
                for (int m = 0; m < 4; ++m) { const int row = row0 + ai * 128 + m * 16;
                    G1 float* rowp = (row < MLAT ? hl + (size_t)row * D : hc + (size_t)(row - MLAT) * D) + col0;
#pragma unroll
                    for (int bj = 0; bj < 2; ++bj)
#pragma unroll
                        for (int n = 0; n < 2; ++n) { G1 f32x4* p = (G1 f32x4*)(rowp + bj * 128 + n * 4); *p = *p + gv[bj][n] * acc[ai][bj][m][n]; } }
        } else {
            f32x4 gs[2][2];
#pragma unroll
            for (int bj = 0; bj < 2; ++bj)
#pragma unroll
                for (int n = 0; n < 2; ++n) { const int c = col0 + bj * 128 + n * 4; gs[bj][n] = *(const G1 f32x4*)(ng + c) * (*(const G1 f32x4*)(nscale + (size_t)r9 * 9216 + c) + 1.f); }
#pragma unroll
            for (int ai = 0; ai < 2; ++ai)
#pragma unroll
                for (int m = 0; m < 4; ++m) { const int row = row0 + ai * 128 + m * 16;
                    G1 float* rowp = (row < MLAT ? hl + (size_t)row * D : hc + (size_t)(row - MLAT) * D) + col0;
                    G1 bf16_t* ap = aout + (size_t)row * D + col0;
                    float ss = 0.f;
#pragma unroll
                    for (int bj = 0; bj < 2; ++bj) { f32x4 an[2];
#pragma unroll
                        for (int n = 0; n < 2; ++n) { G1 f32x4* p = (G1 f32x4*)(rowp + bj * 128 + n * 4); const f32x4 hn = *p + gv[bj][n] * acc[ai][bj][m][n]; *p = hn;
                            ss += hn[0] * hn[0] + hn[1] * hn[1] + hn[2] * hn[2] + hn[3] * hn[3];
                            an[n] = hn * gs[bj][n]; }
                        *(G1 u32x4v*)(ap + bj * 128) = pack8v(an[0], an[1]); }
                    ss += __shfl_xor(ss, 16); ss += __shfl_xor(ss, 32);
                    if (fq == 0) atomicAdd((float*)((G1 float*)ssq_ + row), ss); }
        }
    }
};
struct EpiP {
    static constexpr bool PERM = true, AFTER_DRAIN = false;
    static DEVI void apply(const f32x4 (&acc)[2][2][4][2], const pg8::Unit& u, int wr, int wc, int fr, int fq, bf16_t* Pp_, const float* epw, float* gates_, const float* gb_) {
        G1 bf16_t* Pp = (G1 bf16_t*)Pp_; G1 float* gates = (G1 float*)gates_; const G1 float* gb = (const G1 float*)gb_;
        const int row0 = u.pm * 256 + wr * 64 + fr, col0 = u.pn * 256 + wc * 32 + 8 * fq;
        if (u.pn < 12) {
            f32x4 sv[2][2];
#pragma unroll
            for (int bj = 0; bj < 2; ++bj)
#pragma unroll
                for (int n = 0; n < 2; ++n) sv[bj][n] = *(const f32x4*)(epw + 128 + bj * 32 + 8 * fq + 4 * n);
#pragma unroll
            for (int ai = 0; ai < 2; ++ai)
#pragma unroll
                for (int m = 0; m < 4; ++m) { const int row = row0 + ai * 128 + m * 16; G1 bf16_t* rowp = Pp + (size_t)row * NP + col0;
                    const float rstd = epw[(ai * 4 + m) * 16 + fr];
#pragma unroll
                    for (int bj = 0; bj < 2; ++bj) *(G1 u32x4v*)(rowp + bj * 128) = pack8v(acc[ai][bj][m][0] * rstd + sv[bj][0], acc[ai][bj][m][1] * rstd + sv[bj][1]); }
        } else if (wc == 0 && fq < 2) {
            f32x4 sv[2];
#pragma unroll
            for (int n = 0; n < 2; ++n) sv[n] = *(const f32x4*)(epw + 128 + 8 * fq + 4 * n) + *(const G1 f32x4*)(gb + 8 * fq + 4 * n);
#pragma unroll
            for (int ai = 0; ai < 2; ++ai)
#pragma unroll
                for (int m = 0; m < 4; ++m) { const int row = row0 + ai * 128 + m * 16;
                    const float rstd = epw[(ai * 4 + m) * 16 + fr];
#pragma unroll
                    for (int n = 0; n < 2; ++n) *(G1 f32x4*)(gates + (size_t)row * 16 + 8 * fq + 4 * n) = acc[ai][0][m][n] * rstd + sv[n]; }
        }
    }
};
template <class Epi> DEVI void run_gemm(unsigned char* smem, const bf16_t* A, const bf16_t* Bt, int Mrows, int N, int K, const Epi& E) {
    pg8::StaticOrder S; S.init(Mrows, N, (int)gridDim.x, opaque_bid());
    pg8::Gemm g; g.A = A; g.Bt = Bt; g.M = Mrows; g.N = N; g.K = K; g.ld = K;
    pg8::gemm_phase<Epi, pg8::StaticOrder, false>((LAS3 unsigned char*)(smem + 1024), g, S, E, nullptr);
}
template <class Epi> DEVI void run_gemm_split(unsigned char* smem, const bf16_t* A, const bf16_t* Bt, int nM, int nN, int K, int KP, const Epi& E) {
    pg8::SplitOrder S; S.init(nM, nN, K / KP, (int)gridDim.x, opaque_bid());
    pg8::Gemm g; g.A = A; g.Bt = Bt; g.M = nM * 256; g.N = nN * 256; g.K = KP; g.ld = K;
    pg8::gemm_phase<Epi, pg8::SplitOrder, false>((LAS3 unsigned char*)(smem + 1024), g, S, E, nullptr);
}
struct EpiResidCtxAtomic {
    static constexpr bool PERM = false, AFTER_DRAIN = false;
    static DEVI void apply(const f32x4 (&acc)[2][2][4][2], const pg8::Unit& u, int wr, int wc, int fr, int fq, float* hc, const float* gate, float fac) {
        const int row0 = u.pm * 256 + wr * 64 + fr, col0 = u.pn * 256 + wc * 32 + 4 * fq;
        const float* gp = gate + (size_t)8 * 9216 + col0;
#pragma unroll
        for (int bj = 0; bj < 2; ++bj)
#pragma unroll
            for (int n = 0; n < 2; ++n) { const f32x4 gv = *(const f32x4*)(gp + bj * 128 + n * 16) * fac;
                float* cp = hc + (size_t)row0 * D + col0 + bj * 128 + n * 16;
#pragma unroll
                for (int ai = 0; ai < 2; ++ai)
#pragma unroll
                    for (int m = 0; m < 4; ++m) { const f32x4 v = gv * acc[ai][bj][m][n]; float* q = cp + (size_t)(ai * 128 + m * 16) * D;
#pragma unroll
                        for (int i = 0; i < 4; ++i) unsafeAtomicAdd(q + i, v[i]); } }
    }
};


struct UniOrder {
    int mode; pg8::StaticOrder so; pg8::SplitOrder sp; int pm0, B0, R;
    DEVI bool next(int i, pg8::Unit& u) const {
        if (mode) return sp.next(i, u);
        const int G = so.G, c = so.c; long L;
        if (c < B0) L = (long)R * (G - B0) + (long)i * G + c;
        else L = i < R ? (long)i * (G - B0) + (c - B0) : (long)R * (G - B0) + (long)(i - R) * G + c;
        if (!so.at(L, u)) return false;
        u.pm += pm0; return true; }
    DEVI void a_ready(const pg8::Unit&) const {}
    DEVI void done(const pg8::Unit&) const {}
};
struct GemmJob { const bf16_t* A; const bf16_t* Bt; int nM, nN, nK, K, ld, order, epi, pm0, B0, R; bf16_t* obf; float* hl; float* hc; const float* gate; float fac; bf16_t* aout; const float* ng; const float* nscale; float* ssq; const float* Sb; float* gates; const float* gb; };
struct EpiParams { int mode; float fac; bf16_t* obf; float* hl; float* hc; const float* gate; bf16_t* aout; const float* ng; const float* nscale; float* ssq; const float* Sb; float* gates; const float* gb; };
struct UniEpi {
    static constexpr bool PERM = true, AFTER_DRAIN = false;
    const EpiParams* ep; unsigned char* smem;
    DEVI void operator()(const f32x4 (&acc)[2][2][4][2], const pg8::Unit& u, const pg8::Unit& nx, bool has_next, int wr, int wc, int fr, int fq) const {
        const int mode = __builtin_amdgcn_readfirstlane(ep->mode);
        if (mode == 1) { EpiResid::apply(acc, u, wr, wc, fr, fq, ep->hl, ep->hc, ep->gate, ep->fac, ep->aout, ep->ng, ep->nscale, ep->ssq); return; }
        const int wid = wr * 4 + wc, lane = fq * 16 + fr;
        const float* epw = (const float*)(smem + EPW_OFF + wid * EPW_STRIDE);
        float pf[3] = {1.f, 1.f, 0.f};
        if (has_next) epw_fill(smem, mode, nx, wid, lane, ep->ssq, ep->Sb, mode == 0 ? 5632 : NPG, pf);
        if (mode == 0) EpiSwiglu::apply(acc, u, wr, wc, fr, fq, ep->obf, epw);
        else EpiP::apply(acc, u, wr, wc, fr, fq, ep->obf, epw, ep->gates, ep->gb);
        if (has_next) epw_store(smem, wid, lane, pf);
    }
};
DEVI void run_job(unsigned char* smem, const GemmJob& J) {
    UniOrder S; S.mode = J.order; S.so.init(J.nM * 256, J.nN * 256, (int)gridDim.x, opaque_bid()); S.sp.init(J.nM, J.nN, J.nK, (int)gridDim.x, opaque_bid()); S.pm0 = J.pm0; S.B0 = J.B0; S.R = J.R;
    pg8::Gemm g; g.A = J.A; g.Bt = J.Bt; g.M = J.nM * 256; g.N = J.nN * 256; g.K = J.K; g.ld = J.ld;
    EpiParams* ep = (EpiParams*)(smem + 64);
    __syncthreads();
    if (opaque_tid() == 0) { ep->mode = J.epi; ep->fac = J.fac; ep->obf = J.obf; ep->hl = J.hl; ep->hc = J.hc; ep->gate = J.gate; ep->aout = J.aout; ep->ng = J.ng; ep->nscale = J.nscale; ep->ssq = J.ssq; ep->Sb = J.Sb; ep->gates = J.gates; ep->gb = J.gb; }
    __syncthreads();
    UniEpi E; E.ep = ep; E.smem = smem;
    if (J.epi != 1) { pg8::Unit u0; if (S.next(0, u0)) { const int tid_ = opaque_tid(); float pf[3]; epw_fill(smem, J.epi, u0, tid_ >> 6, tid_ & 63, J.ssq, J.Sb, J.epi == 0 ? 5632 : NPG, pf); epw_store(smem, tid_ >> 6, tid_ & 63, pf); } }
    pg8::gemm_phase<UniEpi, UniOrder, false>((LAS3 unsigned char*)(smem + 1024), g, S, E, nullptr);
}

DEVI int colmap(int type, int n) {
    if (type == 0) { const int pn = n >> 8, bj = (n >> 7) & 1, jj = n & 127; return bj * FF + pn * 128 + jj; }
    if (type == 2) return n < 1024 ? n : (n < 3072 ? n + 16 : (n < 3088 ? n - 3072 + 1024 : -1));
    return n;
}
DEVI void convert_tile(const float* __restrict__ src, int Nsrc, int K, int type, bf16_t* __restrict__ dst, int kt, int nt, float* lt) {
    const int tid = opaque_tid(), k0 = kt * 64, n0 = nt * 256;
    { const int nn = tid & 255, kk0 = tid >> 8; const int col = colmap(type, n0 + nn);
      const float* s = src + (size_t)k0 * Nsrc + (col < 0 ? 0 : col);
#pragma unroll 8
      for (int i = 0; i < 32; ++i) { const int kk = kk0 + 2 * i; const float v = s[(size_t)kk * Nsrc]; lt[nn * 65 + kk] = col < 0 ? 0.f : v; } }
    __syncthreads();
    { const int kp = (tid & 31) * 2, nn0 = tid >> 5;
#pragma unroll 4
      for (int i = 0; i < 16; ++i) { const int nn = nn0 + 16 * i;
          *(unsigned*)(dst + (size_t)(n0 + nn) * K + k0 + kp) = pack2(lt[nn * 65 + kp], lt[nn * 65 + kp + 1]); } }
    __syncthreads();
}

DEVI void filt_item(const Params& P, int l, int tile, float* lds) {
    const int tid = opaque_tid();
    const int Lsel = tile >= 32; const int L = Lsel ? CTX : SEQ; const int t0 = (Lsel ? tile - 32 : tile) * 64;
    float* feats = lds; float* h1 = lds + 64 * 33; float* h2 = h1 + 64 * 65;
#pragma unroll 1
    for (int idx = tid; idx < 64 * 33; idx += 512) { const int r = idx / 33, f = idx - r * 33; const int t = t0 + r; float v;
        if (f == 0) v = (float)t / (float)L;
        else { const int band = f <= 16 ? f : f - 16; const int x = (t * band) & (L - 1); const float ang = 6.283185307179586f * ((float)x / (float)L); v = f <= 16 ? cosf(ang) : sinf(ang); }
        feats[idx] = v; }
    __syncthreads();
    const float* w1 = P.in[18] + (size_t)l * 33 * 64; const float* b1 = P.in[19] + l * 64;
    const float* w2 = P.in[20] + (size_t)l * 64 * 64; const float* b2 = P.in[21] + l * 64;
    const float* w3 = P.in[22] + (size_t)l * 64 * 512; const float* b3 = P.in[23] + l * 512;
    { const int j = tid & 63, r0 = tid >> 6; float acc[8];
#pragma unroll
      for (int i = 0; i < 8; ++i) acc[i] = b1[j];
      for (int f = 0; f < 33; ++f) { const float w = w1[f * 64 + j];
#pragma unroll
          for (int i = 0; i < 8; ++i) acc[i] += feats[(r0 + 8 * i) * 33 + f] * w; }
#pragma unroll
      for (int i = 0; i < 8; ++i) h1[(r0 + 8 * i) * 65 + j] = acc[i]; }
    __syncthreads();
#pragma unroll 1
    for (int idx = tid; idx < 64 * 64; idx += 512) { const int a = (idx >> 6) * 65 + (idx & 63); h1[a] = sinf(h1[a]); }
    __syncthreads();
    { const int j = tid & 63, r0 = tid >> 6; float acc[8];
#pragma unroll
      for (int i = 0; i < 8; ++i) acc[i] = b2[j];
      for (int f = 0; f < 64; ++f) { const float w = w2[f * 64 + j];
#pragma unroll
          for (int i = 0; i < 8; ++i) acc[i] += h1[(r0 + 8 * i) * 65 + f] * w; }
#pragma unroll
      for (int i = 0; i < 8; ++i) h2[(r0 + 8 * i) * 65 + j] = acc[i]; }
    __syncthreads();
#pragma unroll 1
    for (int idx = tid; idx < 64 * 64; idx += 512) { const int a = (idx >> 6) * 65 + (idx & 63); h2[a] = sinf(h2[a]); }
    __syncthreads();
    { const int c = tid; const float bb = b3[c]; const int cc = c & 255;
      const float da = -3.0701134573253946f, db = -15.350567286626973f;
      const float delta = fabsf(da + (db - da) * ((float)cc / 255.f));
      float cs = 0.f;
      float* hf = (float*)(opaque_ws(P) + WS_HF) + (size_t)l * HF_LAYER + (Lsel ? (size_t)512 * SEQ : 0) + (size_t)c * L + t0;
#pragma unroll 1
      for (int rh = 0; rh < 4; ++rh) { float acc[16];
#pragma unroll
          for (int r = 0; r < 16; ++r) acc[r] = 0.f;
#pragma unroll 1
          for (int k = 0; k < 64; ++k) { const float w = w3[k * 512 + c];
#pragma unroll
              for (int r = 0; r < 16; ++r) acc[r] += h2[(rh * 16 + r) * 65 + k] * w; }
#pragma unroll
          for (int r = 0; r < 16; ++r) { const int t = t0 + rh * 16 + r; const float dist = fabsf((float)(t - L / 2)) / (float)(L / 2);
              const float v = (acc[r] + bb) * expf(-dist * delta); cs += fabsf(v); hf[rh * 16 + r] = v; } }
      ((float*)(opaque_ws(P) + WS_HFS))[((size_t)l * 36 + tile) * 512 + c] = cs; }
    __syncthreads();
}

DEVI void mod_item(const Params& P, int l, int chunk, float* lds) {
    const int tid = opaque_tid();
    float* sc = lds; float* red = lds + 9 * 1024;
    for (int idx = tid; idx < 9 * 1024; idx += 512) { const int r = idx >> 10, k = idx & 1023; const float v = r < 8 ? P.in[1][r * 1024 + k] : P.in[3][k]; sc[idx] = silu_prec(v); }
    __syncthreads();
    const int col = tid & 127, ks = tid >> 7; const int n = chunk * 128 + col;
    const float* w = P.in[4] + (size_t)l * 1024 * 9216 + (size_t)(ks * 256) * 9216 + n;
    float acc[9];
#pragma unroll
    for (int r = 0; r < 9; ++r) acc[r] = 0.f;
#pragma unroll 2
    for (int k = 0; k < 256; k += 4) { const float w0 = w[(size_t)k * 9216], w1 = w[(size_t)(k + 1) * 9216], w2 = w[(size_t)(k + 2) * 9216], w3 = w[(size_t)(k + 3) * 9216];
#pragma unroll
        for (int r = 0; r < 9; ++r) { const float4 s4 = *(const float4*)(sc + r * 1024 + ks * 256 + k); acc[r] += s4.x * w0 + s4.y * w1 + s4.z * w2 + s4.w * w3; } }
#pragma unroll
    for (int r = 0; r < 9; ++r) red[(ks * 9 + r) * 128 + col] = acc[r];
    __syncthreads();
    float* modout = (float*)(opaque_ws(P) + WS_MOD);
    for (int idx = tid; idx < 9 * 128; idx += 512) { const int r = idx >> 7, c = idx & 127;
        const float s = red[(0 * 9 + r) * 128 + c] + red[(1 * 9 + r) * 128 + c] + red[(2 * 9 + r) * 128 + c] + red[(3 * 9 + r) * 128 + c];
        modout[((size_t)l * 9 + r) * 9216 + chunk * 128 + c] = s + P.in[5][(size_t)l * 9216 + chunk * 128 + c]; }
    __syncthreads();
}

constexpr int N_FILT = DEPTH * 36, N_MODI = DEPTH * 72;
constexpr int CV_W13 = 16 * 22, CV_W2 = 44 * 4, CV_WIN = 16 * 13, CV_WOUT = 16 * 4;
constexpr int N_CV13 = DEPTH * 2 * CV_W13, N_CV2 = DEPTH * 2 * CV_W2, N_CVIN = DEPTH * CV_WIN, N_CVOUT = DEPTH * CV_WOUT;
constexpr int N_COPY = MT / 64, N_ROPE = 4, N_ZERO = 8, N_SB = DEPTH * 2 * 44, N_SBIN = DEPTH * 26;
constexpr int N_P0A = N_FILT + N_MODI + N_ROPE + N_ZERO + N_CV13 + N_CV2 + N_CVIN + N_CVOUT;
constexpr int N_P0B = N_SB + N_SBIN + N_COPY;

DEVI void sb_item(const Params& P, const float* W, int Nsrc, int type, const float* shiftp, float* out, int Nout, int chunk, float* lds) {
    const int tid = opaque_tid();
    float* sc = lds; float* red = lds + 9 * 1024;
    for (int idx = tid; idx < 9 * 1024; idx += 512) { const int r = idx >> 10, k = idx & 1023; sc[idx] = shiftp[(size_t)r * 9216 + k]; }
    __syncthreads();
    const int col = tid & 127, ks = tid >> 7; const int n = chunk * 128 + col; const int cm = colmap(type, n);
    const float* w = W + (size_t)(ks * 256) * Nsrc + (cm < 0 ? 0 : cm);
    float acc[9];
#pragma unroll
    for (int r = 0; r < 9; ++r) acc[r] = 0.f;
#pragma unroll 2
    for (int k = 0; k < 256; k += 4) { const float w0 = w[(size_t)k * Nsrc], w1 = w[(size_t)(k + 1) * Nsrc], w2 = w[(size_t)(k + 2) * Nsrc], w3 = w[(size_t)(k + 3) * Nsrc];
#pragma unroll
        for (int r = 0; r < 9; ++r) { const float4 s4 = *(const float4*)(sc + r * 1024 + ks * 256 + k); acc[r] += s4.x * w0 + s4.y * w1 + s4.z * w2 + s4.w * w3; } }
#pragma unroll
    for (int r = 0; r < 9; ++r) red[(ks * 9 + r) * 128 + col] = cm < 0 ? 0.f : acc[r];
    __syncthreads();
    for (int idx = tid; idx < 9 * 128; idx += 512) { const int r = idx >> 7, c = idx & 127;
        out[(size_t)r * Nout + chunk * 128 + c] = red[(0 * 9 + r) * 128 + c] + red[(1 * 9 + r) * 128 + c] + red[(2 * 9 + r) * 128 + c] + red[(3 * 9 + r) * 128 + c]; }
    __syncthreads();
}

DEVI void phase0a(const Params& P, unsigned char* smem) {
    const int tid = opaque_tid();
    float* lds = (float*)(smem + 1024);
    for (int it0 = opaque_bid(); it0 < N_P0A; it0 += gridDim.x) {
        int it = it0;
        if (it < N_FILT) { filt_item(P, it / 36, it % 36, lds); continue; } it -= N_FILT;
        if (it < N_MODI) { mod_item(P, it / 72, it % 72, lds); continue; } it -= N_MODI;
        if (it < N_ROPE) { const int t = it * 512 + tid; const int row = t >> 6, col = t & 63;
          float* rg = (float*)(opaque_ws(P) + WS_ROPEG) + (size_t)t * 64; float* rd = (float*)(opaque_ws(P) + WS_ROPED) + (size_t)t * 32;
          for (int j = 0; j < 16; ++j) { const float inv = expf(-(float)j / 16.f * 9.210340371976184f); const float ar = (float)row * inv, ac = (float)col * inv;
              rg[j] = cosf(ar); rg[16 + j] = cosf(ac); rg[32 + j] = sinf(ar); rg[48 + j] = sinf(ac); }
          for (int j = 0; j < 8; ++j) { const float inv = expf(-(float)j / 8.f * 9.210340371976184f); const float ar = (float)row * inv, ac = (float)col * inv;
              rd[j] = cosf(ar); rd[8 + j] = cosf(ac); rd[16 + j] = sinf(ar); rd[24 + j] = sinf(ac); }
          continue; } it -= N_ROPE;
        if (it < N_ZERO) { float* z = (float*)(opaque_ws(P) + WS_SSQ); const int n = DEPTH * 3 * MT; for (int i = it * 512 + tid; i < n; i += N_ZERO * 512) z[i] = 0.f; continue; } it -= N_ZERO;
        if (it < N_CV13) { const int lf = it / CV_W13, r = it % CV_W13; convert_tile(P.in[7] + (size_t)lf * 1024 * 5632, 5632, 1024, 0, (bf16_t*)(opaque_ws(P) + WS_W13) + (size_t)lf * 5632 * 1024, r / 22, r % 22, lds); continue; } it -= N_CV13;
        if (it < N_CV2) { const int lf = it / CV_W2, r = it % CV_W2; convert_tile(P.in[8] + (size_t)lf * 2816 * 1024, 1024, 2816, 1, (bf16_t*)(opaque_ws(P) + WS_W2) + (size_t)lf * 1024 * 2816, r / 4, r % 4, lds); continue; } it -= N_CV2;
        if (it < N_CVIN) { const int l = it / CV_WIN, r = it % CV_WIN; convert_tile(P.in[9] + (size_t)l * 1024 * NIN, NIN, 1024, 2, (bf16_t*)(opaque_ws(P) + WS_WIN) + (size_t)l * NPG * 1024, r / 13, r % 13, lds); continue; } it -= N_CVIN;
        if (it < N_CVOUT) { const int l = it / CV_WOUT, r = it % CV_WOUT; convert_tile(P.in[10] + (size_t)l * 1024 * 1024, 1024, 1024, 1, (bf16_t*)(opaque_ws(P) + WS_WOUT) + (size_t)l * 1024 * 1024, r / 4, r % 4, lds); continue; }
    }
}
DEVI void phase0b(const Params& P, unsigned char* smem) {
    const int tid = opaque_tid();
    float* lds = (float*)(smem + 1024);
    for (int it0 = opaque_bid(); it0 < N_P0B; it0 += gridDim.x) {
        int it = it0;
        if (it < N_SB) { const int lf = it / 44; const int l = lf >> 1, f = lf & 1;
            sb_item(P, P.in[7] + (size_t)lf * 1024 * 5632, 5632, 0, (const float*)(opaque_ws(P) + WS_MOD) + (size_t)l * 9 * 9216 + (f ? 6 : 0) * 1024, (float*)(opaque_ws(P) + WS_SB) + (size_t)lf * 9 * 5632, 5632, it % 44, lds); continue; } it -= N_SB;
        if (it < N_SBIN) { const int l = it / 26;
            sb_item(P, P.in[9] + (size_t)l * 1024 * NIN, NIN, 2, (const float*)(opaque_ws(P) + WS_MOD) + (size_t)l * 9 * 9216 + 3 * 1024, (float*)(opaque_ws(P) + WS_SBIN) + (size_t)l * 9 * NPG, NPG, it % 26, lds); continue; } it -= N_SBIN;
        {
            const int lane = tid & 63, wid = tid >> 6;
            float* hctx = (float*)(opaque_ws(P) + WS_HCTX); bf16_t* A = (bf16_t*)(opaque_ws(P) + WS_A); float* ssq = (float*)(opaque_ws(P) + WS_SSQ);
            const float* g = P.in[6]; const float* modl = (const float*)(opaque_ws(P) + WS_MOD);
#pragma unroll 2
            for (int rr = 0; rr < 8; ++rr) { const int row = it * 64 + wid * 8 + rr;
                const float* sp = row < MLAT ? P.in[0] + (size_t)row * D : P.in[2] + (size_t)(row - MLAT) * D;
                float* dp = row < MLAT ? P.out + (size_t)row * D : hctx + (size_t)(row - MLAT) * D;
                const int r9 = row < MLAT ? (row >> 11) : 8; const float* scl = modl + (size_t)r9 * 9216 + 1024;
                float ss = 0.f;
#pragma unroll
                for (int j = 0; j < 4; ++j) { const int col = 4 * lane + 256 * j; const float4 x = *(const float4*)(sp + col); *(float4*)(dp + col) = x;
                    ss += x.x * x.x + x.y * x.y + x.z * x.z + x.w * x.w;
                    const float4 g4 = *(const float4*)(g + col), s4 = *(const float4*)(scl + col);
                    uint2 o; o.x = pack2(x.x * g4.x * (1.f + s4.x), x.y * g4.y * (1.f + s4.y)); o.y = pack2(x.z * g4.z * (1.f + s4.z), x.w * g4.w * (1.f + s4.w));
                    *(uint2*)(A + (size_t)row * D + col) = o; }
                ss = wave_sum(ss);
                if (lane == 0) ssq[row] = ss; }
        }
    }
}

template <bool GATES> DEVI void norm_phase(const Params& P, int l, int which, unsigned char* smem) {
    const int tid = opaque_tid(), lane = tid & 63, wid = tid >> 6;
    const float* g = P.in[6] + (size_t)(l * 3 + which) * 1024;
    const float* modl = (const float*)(opaque_ws(P) + WS_MOD) + (size_t)l * 9 * 9216;
    const float* hctx = (const float*)(opaque_ws(P) + WS_HCTX);
    bf16_t* A = (bf16_t*)(opaque_ws(P) + WS_A);
    float* WgT = (float*)(smem + 1024);
    if (GATES) { const float* win = P.in[9] + (size_t)l * 1024 * NIN;
        for (int idx = tid; idx < 16384; idx += 512) { const int k = idx >> 4, jj = idx & 15; WgT[jj * 1024 + k] = win[(size_t)k * NIN + 1024 + jj]; }
        __syncthreads(); }
    float4 gv[4];
#pragma unroll
    for (int j = 0; j < 4; ++j) gv[j] = *(const float4*)(g + 4 * lane + 256 * j);
    for (int row = opaque_bid() * 8 + wid; row < MT; row += gridDim.x * 8) {
        const float* hp = row < MLAT ? P.out + (size_t)row * D : hctx + (size_t)(row - MLAT) * D;
        const int r9 = row < MLAT ? (row >> 11) : 8;
        const float* sh = modl + (size_t)r9 * 9216 + (3 * which) * 1024; const float* scl = sh + 1024;
        float4 x[4]; float ss = 0.f;
#pragma unroll
        for (int j = 0; j < 4; ++j) { x[j] = *(const float4*)(hp + 4 * lane + 256 * j); ss += x[j].x * x[j].x + x[j].y * x[j].y + x[j].z * x[j].z + x[j].w * x[j].w; }
        ss = wave_sum(ss);
        const float rstd = rsqrtf(ss * (1.f / 1024.f) + 1e-6f);
        float ga[16];
        if (GATES) {
#pragma unroll
            for (int jj = 0; jj < 16; ++jj) ga[jj] = 0.f; }
#pragma unroll
        for (int j = 0; j < 4; ++j) { const int col = 4 * lane + 256 * j;
            const float4 s4 = *(const float4*)(scl + col), h4 = *(const float4*)(sh + col);
            float4 y;
            y.x = x[j].x * rstd * gv[j].x * (1.f + s4.x) + h4.x; y.y = x[j].y * rstd * gv[j].y * (1.f + s4.y) + h4.y;
            y.z = x[j].z * rstd * gv[j].z * (1.f + s4.z) + h4.z; y.w = x[j].w * rstd * gv[j].w * (1.f + s4.w) + h4.w;
            uint2 o; o.x = pack2(y.x, y.y); o.y = pack2(y.z, y.w);
            *(uint2*)(A + (size_t)row * D + col) = o;
            if (GATES) {
#pragma unroll
                for (int jj = 0; jj < 16; ++jj) { const float4 w = *(const float4*)(WgT + jj * 1024 + col); ga[jj] += y.x * w.x + y.y * w.y + y.z * w.z + y.w * w.w; } } }
        if (GATES) { float outv = 0.f;
#pragma unroll
            for (int jj = 0; jj < 16; ++jj) { const float t = wave_sum(ga[jj]); if (lane == jj) outv = t; }
            if (lane < 16) ((float*)(opaque_ws(P) + WS_GATES))[(size_t)row * 16 + lane] = outv + P.in[11][l * 16 + lane]; }
    }
}

template <int LEN> DEVI void prep_seg(const bf16_t* __restrict__ src, const float* __restrict__ g, const float* __restrict__ rope, float scale, bf16_t* __restrict__ dst) {
    float x[LEN];
#pragma unroll
    for (int i = 0; i < LEN / 8; ++i) { const uint4 v = *(const uint4*)(src + 8 * i);
        x[8 * i + 0] = bflo(v.x); x[8 * i + 1] = bfhi(v.x); x[8 * i + 2] = bflo(v.y); x[8 * i + 3] = bfhi(v.y);
        x[8 * i + 4] = bflo(v.z); x[8 * i + 5] = bfhi(v.z); x[8 * i + 6] = bflo(v.w); x[8 * i + 7] = bfhi(v.w); }
    float ss = 0.f;
#pragma unroll
    for (int i = 0; i < LEN; ++i) ss += x[i] * x[i];
    const float rstd = rsqrtf(ss * (1.f / LEN) + 1e-6f);
#pragma unroll
    for (int i = 0; i < LEN; ++i) x[i] = x[i] * rstd * g[i];
    if (rope) {
#pragma unroll
        for (int j = 0; j < LEN / 2; ++j) { const float c = rope[j], s = rope[LEN / 2 + j]; const float a = x[j], b = x[j + LEN / 2]; x[j] = a * c - b * s; x[j + LEN / 2] = a * s + b * c; } }
#pragma unroll
    for (int i = 0; i < LEN / 8; ++i) { uint4 o;
        o.x = pack2(x[8 * i + 0] * scale, x[8 * i + 1] * scale); o.y = pack2(x[8 * i + 2] * scale, x[8 * i + 3] * scale);
        o.z = pack2(x[8 * i + 4] * scale, x[8 * i + 5] * scale); o.w = pack2(x[8 * i + 6] * scale, x[8 * i + 7] * scale);
        *(uint4*)(dst + 8 * i) = o; }
}
DEVI void unpack8(const uint4 v, float (&x)[8]) { x[0] = bflo(v.x); x[1] = bfhi(v.x); x[2] = bflo(v.y); x[3] = bfhi(v.y); x[4] = bflo(v.z); x[5] = bfhi(v.z); x[6] = bflo(v.w); x[7] = bfhi(v.w); }

DEVI void prep_phase(const Params& P, int l, unsigned char* smem) {
    const int tid = opaque_tid();
    const bf16_t* p = (const bf16_t*)(opaque_ws(P) + WS_P);
    bf16_t* Qb = (bf16_t*)(opaque_ws(P) + WS_Q); bf16_t* Kb = (bf16_t*)(opaque_ws(P) + WS_K); bf16_t* VT = (bf16_t*)(opaque_ws(P) + WS_VT);
    bf16_t* mlqk = (bf16_t*)(opaque_ws(P) + WS_MLQK); bf16_t* hyu = (bf16_t*)(opaque_ws(P) + WS_HYU);
    const float* ropeG = (const float*)(opaque_ws(P) + WS_ROPEG); const float* ropeD = (const float*)(opaque_ws(P) + WS_ROPED);
    const float* gqa_g = P.in[15] + l * 128; const float* diff_g = P.in[25] + l * 64;
    bf16_t* lt = (bf16_t*)(smem + 1024);
    constexpr int TR = 16, LS = TR + 8;
    for (int rt = opaque_bid(); rt < MT / TR; rt += gridDim.x) {
        const int row0 = rt * TR; const bool isctx = row0 >= MLAT;
        int b, t0, Ls;
        if (!isctx) { b = row0 >> 11; t0 = row0 & 2047; Ls = SEQ; } else { const int rc = row0 - MLAT; b = rc >> 8; t0 = rc & 255; Ls = CTX; }
        const int pp0 = isctx ? t0 : CTX + t0;
        for (int task = tid; task < TR * 22; task += 512) {
            if (task < TR * 6) { const int seg = task % 6, r = task / 6;
                const int srccol = seg < 4 ? 1024 + 64 * seg : 1280 + 64 * (seg - 4);
                const float* g = gqa_g + (seg < 4 ? 0 : 64); const float scale = seg < 4 ? 0.125f * LOG2E : 1.f;
                bf16_t* dst = seg < 4 ? Qb + (((size_t)b * 8 + seg) * KEYS + pp0 + r) * 64 : Kb + (((size_t)b * 6 + (seg - 4)) * KEYS + pp0 + r) * 64;
                const float* rope = isctx ? nullptr : ropeG + (size_t)(t0 + r) * 64;
                prep_seg<64>(p + (size_t)(row0 + r) * NP + srccol, g, rope, scale, dst);
            } else { const int tt = task - TR * 6; const int seg = tt & 15, r = tt >> 4; const int isk = seg >> 3, hh = (seg >> 1) & 3, s = seg & 1;
                const int srccol = (isk ? 2560 : 2304) + 64 * hh + 32 * s;
                const float* g = diff_g + isk * 32; const float scale = isk ? 1.f : 0.17677669529663687f * LOG2E;
                bf16_t* dst = isk ? Kb + (((size_t)b * 6 + 2 + hh) * KEYS + pp0 + r) * 64 + 32 * s : Qb + (((size_t)b * 8 + 4 + hh) * KEYS + pp0 + r) * 64 + 32 * s;
                const float* rope = isctx ? nullptr : ropeD + (size_t)(t0 + r) * 32;
                prep_seg<32>(p + (size_t)(row0 + r) * NP + srccol, g, rope, scale, dst);
            }
        }
        { const float* cw = P.in[12] + (size_t)l * 3 * 512; const float* cb = P.in[13] + (size_t)l * 512;
          for (int task = tid; task < TR * 64; task += 512) { const int cg8 = task & 63, r = task >> 6; const int c0 = cg8 * 8; const int t = t0 + r;
              const bf16_t* pr = p + (size_t)(row0 + r) * NP + c0;
              float xm[8], x0[8], xp[8];
              unpack8(*(const uint4*)pr, x0);
              if (t > 0) unpack8(*(const uint4*)(pr - NP), xm); else {
#pragma unroll
                  for (int i = 0; i < 8; ++i) xm[i] = 0.f; }
              if (t < Ls - 1) unpack8(*(const uint4*)(pr + NP), xp); else {
#pragma unroll
                  for (int i = 0; i < 8; ++i) xp[i] = 0.f; }
              const float sc = c0 < 256 ? 0.125f : 1.f;
              float y[8];
#pragma unroll
              for (int i = 0; i < 8; ++i) { const float v = cw[c0 + i] * xm[i] + cw[512 + c0 + i] * x0[i] + cw[1024 + c0 + i] * xp[i] + cb[c0 + i]; y[i] = silu_fast(v) * sc; }
              uint4 o4; o4.x = pack2(y[0], y[1]); o4.y = pack2(y[2], y[3]); o4.z = pack2(y[4], y[5]); o4.w = pack2(y[6], y[7]);
              *(uint4*)(mlqk + (size_t)(row0 + r) * 512 + c0) = o4; } }
        for (int task = tid; task < TR * 48; task += 512) { const int r = task & (TR - 1), ch = task / TR;
            const int srccol = ch < 16 ? 1408 + ch * 8 : 2816 + (ch - 16) * 8;
            const uint4 v = *(const uint4*)(p + (size_t)(row0 + r) * NP + srccol);
            bf16_t* d = lt + (size_t)(ch * 8) * LS + r;
            d[0] = (bf16_t)(v.x & 0xffff); d[LS] = (bf16_t)(v.x >> 16); d[2 * LS] = (bf16_t)(v.y & 0xffff); d[3 * LS] = (bf16_t)(v.y >> 16);
            d[4 * LS] = (bf16_t)(v.z & 0xffff); d[5 * LS] = (bf16_t)(v.z >> 16); d[6 * LS] = (bf16_t)(v.w & 0xffff); d[7 * LS] = (bf16_t)(v.w >> 16); }
        __syncthreads();
        static_assert(TR == 16, "V^T key permutation below assumes 16-row tiles");
        for (int task = tid; task < 384 * 2; task += 512) { const int dd = task >> 1, ch = task & 1; const int slot = dd >> 6, d = dd & 63;
            const uint4 v = *(const uint4*)(lt + (size_t)dd * LS + ch * 8);
            bf16_t* dst = VT + (((size_t)b * 6 + slot) * 64 + d) * KEYS + (pp0 & ~31) + ((pp0 >> 4) & 1) * 4;
            *(uint2*)(dst + (2 * ch) * 8) = make_uint2(v.x, v.y); *(uint2*)(dst + (2 * ch + 1) * 8) = make_uint2(v.z, v.w); }
        __syncthreads();
        { const float* cw = P.in[16] + (size_t)l * 3 * 768; const float* cb = P.in[17] + (size_t)l * 768;
          for (int task = tid; task < TR * 96; task += 512) { const int r = task & (TR - 1), ch = task / TR; const int c0 = ch * 8; const int t = t0 + r;
              const bf16_t* pr = p + (size_t)(row0 + r) * NP + 1536 + c0;
              float xm[8], x0[8], xp[8];
              unpack8(*(const uint4*)pr, x0);
              if (t > 0) unpack8(*(const uint4*)(pr - NP), xm); else {
#pragma unroll
                  for (int i = 0; i < 8; ++i) xm[i] = 0.f; }
              if (t < Ls - 1) unpack8(*(const uint4*)(pr + NP), xp); else {
#pragma unroll
                  for (int i = 0; i < 8; ++i) xp[i] = 0.f; }
              bf16_t* d = lt + (size_t)c0 * LS + r;
#pragma unroll
              for (int i = 0; i < 8; ++i) { const float v = cw[c0 + i] * xm[i] + cw[768 + c0 + i] * x0[i] + cw[1536 + c0 + i] * xp[i] + cb[c0 + i]; d[i * LS] = f2bf(v); } } }
        __syncthreads();
        for (int task = tid; task < 768 * (TR / 8); task += 512) { const int cc = task / (TR / 8), ch = task % (TR / 8);
            *(uint4*)(hyu + (size_t)cc * MT + row0 + ch * 8) = *(const uint4*)(lt + (size_t)cc * LS + ch * 8); }
        __syncthreads();
    }
}

template <bool DIFF> DEVI void attn_item(const Params& P, int l, int b, int hsel, int qb, bool isctx, unsigned char* smem) {
    const int tid = opaque_tid(), lane = tid & 63, wid = tid >> 6, fr = lane & 15, quad = lane >> 4;
    bf16_t* Ks0 = (bf16_t*)(smem + 1024); bf16_t* Vs0 = Ks0 + 2 * 64 * 72;
    const int nkt = (isctx ? CTX : KEYS) / 64;
    const int pq0 = (isctx ? 0 : CTX) + qb * 128 + wid * 16;
    const int slotk = DIFF ? 2 + hsel : hsel;
    const bf16_t* Kg = (const bf16_t*)(opaque_ws(P) + WS_K) + ((size_t)b * 6 + slotk) * KEYS * 64;
    const bf16_t* Vg = (const bf16_t*)(opaque_ws(P) + WS_VT) + ((size_t)b * 6 + slotk) * 64 * KEYS;
    const bf16_t* Qg = (const bf16_t*)(opaque_ws(P) + WS_Q);
    bf16x8 q[2][2];
#pragma unroll
    for (int s = 0; s < 2; ++s) { const int slotq = DIFF ? 4 + hsel : 2 * hsel + s;
        const bf16_t* qp = Qg + (((size_t)b * 8 + slotq) * KEYS + pq0 + fr) * 64 + quad * 8;
        q[s][0] = *(const bf16x8*)qp; q[s][1] = *(const bf16x8*)(qp + 32); }
    float M2;
    { const float* g = DIFF ? P.in[25] + l * 64 : P.in[15] + l * 128; const int n = DIFF ? 32 : 64;
      float a = lane < n ? fabsf(g[lane]) : 0.f, bb = lane < n ? fabsf(g[n + lane]) : 0.f; a = wave_max(a); bb = wave_max(bb);
      M2 = sqrtf((float)n) * a * bb * LOG2E; }
    f32x4 O[2][5];
#pragma unroll
    for (int s = 0; s < 2; ++s)
#pragma unroll
        for (int d = 0; d < 5; ++d) O[s][d] = (f32x4){0.f, 0.f, 0.f, 0.f};
    const f32x4 minit = (f32x4){-M2, -M2, -M2, -M2};
    const int lrow = tid >> 3, lch = (tid & 7) * 8;
    const bf16_t* kgp = Kg + (size_t)lrow * 64 + lch; const bf16_t* vgp = Vg + (size_t)lrow * KEYS + lch;
#define LDK(t) (*(const uint4*)(kgp + (size_t)(t) * 64 * 64))
#define LDV(t) (*(const uint4*)(vgp + (size_t)(t) * 64))
    uint4 k0r = LDK(0), v0r = LDV(0), k1r = k0r, v1r = v0r;
    constexpr int KSZ = 64 * 72, VSZ = 80 * 72;
    __syncthreads();
    *(uint4*)(Ks0 + lrow * 72 + lch) = k0r; *(uint4*)(Vs0 + lrow * 72 + lch) = v0r;
    if (nkt > 1) { k0r = LDK(1); v0r = LDV(1); }
    if (nkt > 2) { k1r = LDK(2); v1r = LDV(2); }
    __syncthreads();
    f32x4 S[2][4]; bf16x8 pbp[2][2];
    bf16x8 vones;
#pragma unroll
    for (int i = 0; i < 8; ++i) vones[i] = (short)0x3F80;
#define ATT_QK(KS) do { _Pragma("unroll") for (int ks = 0; ks < 4; ++ks) { const bf16_t* kp = (KS) + (ks * 16 + fr) * 72 + quad * 8; \
            const bf16x8 k0 = *(const bf16x8*)kp, k1 = *(const bf16x8*)(kp + 32); \
            if (!DIFF) { S[0][ks] = mfma16(k0, q[0][0], minit); S[1][ks] = mfma16(k0, q[1][0], minit); S[0][ks] = mfma16(k1, q[0][1], S[0][ks]); S[1][ks] = mfma16(k1, q[1][1], S[1][ks]); } \
            else { S[0][ks] = mfma16(k0, q[0][0], minit); S[1][ks] = mfma16(k1, q[0][1], minit); } } } while (0)
#define ATT_EXP(PB) do { _Pragma("unroll") for (int s = 0; s < 2; ++s) _Pragma("unroll") for (int kk = 0; kk < 2; ++kk) { float pv[8]; \
            _Pragma("unroll") for (int i = 0; i < 4; ++i) { pv[i] = __builtin_amdgcn_exp2f(S[s][2 * kk][i]); pv[4 + i] = __builtin_amdgcn_exp2f(S[s][2 * kk + 1][i]); } \
            union { uint4 u; bf16x8 v; } cv; cv.u.x = pack2(pv[0], pv[1]); cv.u.y = pack2(pv[2], pv[3]); cv.u.z = pack2(pv[4], pv[5]); cv.u.w = pack2(pv[6], pv[7]); \
            PB[s][kk] = cv.v; } } while (0)
#define ATT_PV(VS, PB) do { _Pragma("unroll") for (int ds = 0; ds < 5; ++ds) _Pragma("unroll") for (int kk = 0; kk < 2; ++kk) { const bf16x8 vf = ds < 4 ? *(const bf16x8*)((VS) + (ds * 16 + fr) * 72 + kk * 32 + quad * 8) : vones; \
            O[0][ds] = mfma16(vf, PB[0][kk], O[0][ds]); O[1][ds] = mfma16(vf, PB[1][kk], O[1][ds]); } } while (0)
#define ATT_NEXT(kt, VN) do { if ((kt) + 1 < nkt) { bf16_t* Kn = Ks0 + (((kt) + 1) & 1) * KSZ; bf16_t* Vn = Vs0 + (VN) * VSZ; \
            if (((kt) & 1) == 0) { *(uint4*)(Kn + lrow * 72 + lch) = k0r; *(uint4*)(Vn + lrow * 72 + lch) = v0r; if ((kt) + 3 < nkt) { k0r = LDK((kt) + 3); v0r = LDV((kt) + 3); } } \
            else { *(uint4*)(Kn + lrow * 72 + lch) = k1r; *(uint4*)(Vn + lrow * 72 + lch) = v1r; if ((kt) + 3 < nkt) { k1r = LDK((kt) + 3); v1r = LDV((kt) + 3); } } } } while (0)
    ATT_QK(Ks0); ATT_EXP(pbp); ATT_NEXT(0, 1);
    __syncthreads();
    int vprev = 0, vcur = 1, vnext = 2;
    for (int kt = 1; kt < nkt; ++kt) {
        ATT_QK(Ks0 + (kt & 1) * KSZ);
        bf16x8 pb[2][2];
        ATT_PV(Vs0 + vprev * VSZ, pbp);
        ATT_EXP(pb);
#pragma unroll
        for (int s = 0; s < 2; ++s)
#pragma unroll
            for (int kk = 0; kk < 2; ++kk) pbp[s][kk] = pb[s][kk];
        ATT_NEXT(kt, vnext);
        __syncthreads();
        const int t_ = vprev; vprev = vcur; vcur = vnext; vnext = t_;
    }
    ATT_PV(Vs0 + vprev * VSZ, pbp);
#undef ATT_QK
#undef ATT_EXP
#undef ATT_PV
#undef ATT_NEXT
    float lsum[2];
#pragma unroll
    for (int s = 0; s < 2; ++s) lsum[s] = __shfl(O[s][4][0], fr);
    const int pp = pq0 + fr;
    const size_t row = pp < CTX ? (size_t)MLAT + b * CTX + pp : (size_t)b * SEQ + (pp - CTX);
    bf16_t* cat = (bf16_t*)(opaque_ws(P) + WS_CAT);
    if (!DIFF) {
#pragma unroll
        for (int s = 0; s < 2; ++s) { const float inv = 1.f / lsum[s]; bf16_t* op = cat + row * D + 256 + (2 * hsel + s) * 64 + quad * 4;
#pragma unroll
            for (int ds = 0; ds < 4; ++ds) *(uint2*)(op + ds * 16) = pack4(O[s][ds] * inv); }
    } else {
        const float* lp = P.in[26] + l * 128;
        float a = lane < 32 ? lp[lane] * lp[32 + lane] : 0.f, c = lane < 32 ? lp[64 + lane] * lp[96 + lane] : 0.f; a = wave_sum(a); c = wave_sum(c);
        const float lam_init = 0.8f - 0.6f * expf(-0.3f * (float)l);
        const float lam = expf(a) - expf(c) + lam_init;
        const float i0 = 1.f / lsum[0], i1 = lam / lsum[1];
        f32x4 o[4]; float ss = 0.f;
#pragma unroll
        for (int ds = 0; ds < 4; ++ds) { o[ds] = O[0][ds] * i0 - O[1][ds] * i1; ss += o[ds][0] * o[ds][0] + o[ds][1] * o[ds][1] + o[ds][2] * o[ds][2] + o[ds][3] * o[ds][3]; }
        ss += __shfl_xor(ss, 16); ss += __shfl_xor(ss, 32);
        const float fac = rsqrtf(ss * (1.f / 64.f) + 1e-6f) * (1.f - lam_init);
        const float* sg = P.in[27] + l * 64;
        bf16_t* op = cat + row * D + 768 + hsel * 64 + quad * 4;
#pragma unroll
        for (int ds = 0; ds < 4; ++ds) { const f32x4 gg = *(const f32x4*)(sg + ds * 16 + quad * 4); *(uint2*)(op + ds * 16) = pack4(o[ds] * gg * fac); }
    }
}

#undef LDK
#undef LDV
DEVI void hy_build_E(const float* hs, float norm, int L, bf16_t* E, int NG) {
    const int lo = L / 2, hi = 3 * L / 2 - 1;
    for (int idx = opaque_tid(); idx < 8 * NG; idx += 512) { const int r = idx / NG, m = idx - r * NG; const int i0 = 8 * m + r;
        float v[8];
#pragma unroll
        for (int e = 0; e < 8; ++e) { const int i = i0 + e; v[e] = (i >= lo && i <= hi) ? hs[hi - i] * norm : 0.f; }
        uint4 o; o.x = pack2(v[0], v[1]); o.y = pack2(v[2], v[3]); o.z = pack2(v[4], v[5]); o.w = pack2(v[6], v[7]);
        *(uint4*)(E + ((size_t)r * NG + m) * 8) = o; }
}
template <int NT> DEVI void hy_conv_chain(const bf16_t* E, int NG, const bf16_t* Us, int ustride, int L, int tbase, int fr, int quad, f32x4 (&acc)[NT]) {
    int jlo = tbase - L / 2 + 1; jlo = jlo < 0 ? 0 : (jlo & ~31);
    int jhi = (tbase + 32 * (NT - 1) + 16 + L / 2 + 31) & ~31; jhi = jhi > L ? L : jhi;
    const bf16_t* Er = E + (size_t)(7 - (fr & 7)) * NG * 8;
    const bf16_t* ub = Us + (fr & 7) * ustride + quad * 8;
    const int ob = quad * 8 - tbase - fr + L - 1;
    bf16x8 F[NT];
#pragma unroll
    for (int i = 0; i < NT; ++i) { acc[i] = (f32x4){0.f, 0.f, 0.f, 0.f}; F[i] = *(const bf16x8*)(Er + (size_t)((jlo + ob - 32 * i) >> 3) * 8); }
    for (int jb = jlo; jb < jhi; jb += 32) {
        const bf16x8 bv = *(const bf16x8*)(ub + jb);
        bf16x8 Fn = F[0];
        if (jb + 32 < jhi) Fn = *(const bf16x8*)(Er + (size_t)((jb + 32 + ob) >> 3) * 8);
#pragma unroll
        for (int i = 0; i < NT; ++i) acc[i] = mfma16(F[i], bv, acc[i]);
#pragma unroll
        for (int i = NT - 1; i > 0; --i) F[i] = F[i - 1];
        F[0] = Fn;
    }
}
template <int NT> DEVI void hy_item(const Params& P, int l, int c, unsigned char* smem) {
    constexpr int Lsel = (NT == 2) ? 1 : 0;
    constexpr int L = Lsel ? CTX : SEQ; constexpr int NG = L / 4 + 2; constexpr int ustride = L + 8;
    const int tid = opaque_tid(), lane = tid & 63, wid = tid >> 6, fr = lane & 15, quad = lane >> 4;
    bf16_t* E = (bf16_t*)(smem + 1024); bf16_t* Us = E + (size_t)8 * NG * 8; bf16_t* Zs = Us + 8 * ustride;
    const float* hfs = (const float*)(opaque_ws(P) + WS_HFS) + (size_t)l * 36 * 512;
    float s0 = 0.f, s1 = 0.f;
    { const int tlo = Lsel ? 32 : 0, thi = Lsel ? 36 : 32; for (int t = tlo; t < thi; ++t) { s0 += hfs[t * 512 + c]; s1 += hfs[t * 512 + 256 + c]; } }
    const float* hf = (const float*)(opaque_ws(P) + WS_HF) + (size_t)l * HF_LAYER + (Lsel ? (size_t)512 * SEQ : 0);
    const bf16_t* hyu = (const bf16_t*)(opaque_ws(P) + WS_HYU); bf16_t* hyo = (bf16_t*)(opaque_ws(P) + WS_HYO);
    { float* hs = (float*)Zs; const float* src = hf + (size_t)c * L; for (int i = tid; i < L / 4; i += 512) *(float4*)(hs + 4 * i) = *(const float4*)(src + 4 * i); }
    { constexpr int nch = L / 8; for (int idx = tid; idx < 8 * nch; idx += 512) { const int bb = idx / nch, ch = idx - bb * nch;
          const size_t base = Lsel ? (size_t)MLAT + bb * CTX : (size_t)bb * SEQ;
          *(uint4*)(Us + bb * ustride + ch * 8) = *(const uint4*)(hyu + (size_t)c * MT + base + ch * 8); } }
    __syncthreads();
    hy_build_E((const float*)Zs, 1.f / s0, L, E, NG);
    __syncthreads();
    const float sk0 = P.in[24][(size_t)l * 512 + c], sk1 = P.in[24][(size_t)l * 512 + 256 + c];
    const size_t baseb = Lsel ? (size_t)MLAT + (fr & 7) * CTX : (size_t)(fr & 7) * SEQ;
    const int tbase = 16 * (wid & 1) + 32 * NT * (wid >> 1);
    f32x4 acc[NT];
    hy_conv_chain<NT>(E, NG, Us, ustride, L, tbase, fr, quad, acc);
    if (fr < 8) {
#pragma unroll
        for (int i = 0; i < NT; ++i) { const int t = tbase + 32 * i + quad * 4;
            const uint2 v4 = *(const uint2*)(Us + fr * ustride + t); const uint2 x4 = *(const uint2*)(hyu + (size_t)(256 + c) * MT + baseb + t);
            f32x4 z; z[0] = bflo(x4.x) * (acc[i][0] + sk0 * bflo(v4.x)); z[1] = bfhi(x4.x) * (acc[i][1] + sk0 * bfhi(v4.x));
            z[2] = bflo(x4.y) * (acc[i][2] + sk0 * bflo(v4.y)); z[3] = bfhi(x4.y) * (acc[i][3] + sk0 * bfhi(v4.y));
            *(uint2*)(Zs + fr * ustride + t) = pack4(z); } }
    __syncthreads();
    { float* hs = (float*)Us; const float* src = hf + (size_t)(256 + c) * L; for (int i = tid; i < L / 4; i += 512) *(float4*)(hs + 4 * i) = *(const float4*)(src + 4 * i); }
    __syncthreads();
    hy_build_E((const float*)Us, 1.f / s1, L, E, NG);
    __syncthreads();
    hy_conv_chain<NT>(E, NG, Zs, ustride, L, tbase, fr, quad, acc);
    if (fr < 8) {
#pragma unroll
        for (int i = 0; i < NT; ++i) { const int t = tbase + 32 * i + quad * 4;
            const uint2 v4 = *(const uint2*)(Zs + fr * ustride + t); const uint2 x4 = *(const uint2*)(hyu + (size_t)(512 + c) * MT + baseb + t);
            f32x4 z; z[0] = bflo(x4.x) * (acc[i][0] + sk1 * bflo(v4.x)); z[1] = bfhi(x4.x) * (acc[i][1] + sk1 * bfhi(v4.x));
            z[2] = bflo(x4.y) * (acc[i][2] + sk1 * bflo(v4.y)); z[3] = bfhi(x4.y) * (acc[i][3] + sk1 * bfhi(v4.y));
            *(uint2*)(hyo + (size_t)c * MT + baseb + t) = pack4(z); } }
}

DEVI void ml_item(const Params& P, int l, int b, int hh, int dir, unsigned char* smem) {
    const int tid = opaque_tid(), lane = tid & 63, wid = tid >> 6, fr = lane & 15, quad = lane >> 4;
    bf16_t* Qs = (bf16_t*)(smem + 1024); bf16_t* Qp = Qs + 64 * 72; bf16_t* Ks = Qp + 64 * 72; bf16_t* KTw = Ks + 64 * 72; bf16_t* Ss = KTw + 64 * 72;
    bf16_t* VT = Ss + 64 * 72; bf16_t* Cs = VT + 80 * 72;
    float* btm = (float*)(Cs + 80 * 72); float* aval = btm + 64; float* mrow = aval + 64; float* winter = mrow + 64; float* wg = winter + 64; float* sc = wg + 64;
    const bf16_t* mlqk = (const bf16_t*)(opaque_ws(P) + WS_MLQK); const bf16_t* p = (const bf16_t*)(opaque_ws(P) + WS_P); const float* gates = (const float*)(opaque_ws(P) + WS_GATES);
    float* mlh = (float*)(opaque_ws(P) + WS_MLH) + (size_t)dir * MT * 256;
    for (int i = tid; i < 80 * 72; i += 512) Cs[i] = 0;
    for (int i = tid; i < 16 * 72; i += 512) VT[64 * 72 + i] = (i < 72) ? (bf16_t)0x3F80 : (bf16_t)0;
    if (tid == 0) sc[0] = 0.f;
    const int tt = wid & 3, grp = wid >> 2;
    f32x4 Cacc[3];
#pragma unroll
    for (int j = 0; j < 3; ++j) Cacc[j] = (f32x4){0.f, 0.f, 0.f, 0.f};
    const int lr = tid & 63, lc0 = (tid >> 6) * 8;
    uint4 qreg, kreg, vreg; float gi = 0.f, gf = 0.f;
    { const int Ls = CTX; const size_t rowbase = (size_t)MLAT + b * CTX; const int pos = dir ? Ls - 1 - lr : lr; const size_t row = rowbase + pos;
      qreg = *(const uint4*)(mlqk + row * 512 + hh * 64 + lc0); kreg = *(const uint4*)(mlqk + row * 512 + 256 + hh * 64 + lc0); vreg = *(const uint4*)(p + row * NP + 512 + hh * 64 + lc0);
      if (tid < 64) { const float* gp = gates + row * 16 + dir * 8 + hh; gi = gp[0]; gf = gp[4]; } }
    __syncthreads();
#pragma unroll 1
    for (int ck = 0; ck < 36; ++ck) {
        const int seq = ck >= 4; const int Ls = seq ? SEQ : CTX; const size_t rowbase = seq ? (size_t)b * SEQ : (size_t)MLAT + b * CTX; const int kk = seq ? ck - 4 : ck;
        if (tid < 64) {
            float bsum = logsigmoid(gf);
#pragma unroll
            for (int o = 1; o < 64; o <<= 1) { const float t = __shfl_up(bsum, o); if (lane >= o) bsum += t; }
            const float a = gi - bsum; float pm = a;
#pragma unroll
            for (int o = 1; o < 64; o <<= 1) { const float t = __shfl_up(pm, o); if (lane >= o) pm = fmaxf(pm, t); }
            const float m = sc[0]; const float mt = bsum + fmaxf(m, pm);
            btm[lane] = bsum - mt; aval[lane] = a; mrow[lane] = mt; winter[lane] = expf(bsum + m - mt);
            const float bend = __shfl(bsum, 63), pmend = __shfl(pm, 63); const float mnew = bend + fmaxf(m, pmend);
            wg[lane] = expf(bend + a - mnew);
            if (lane == 0) { sc[1] = expf(bend + m - mnew); sc[2] = mnew; } }
        __syncthreads();
        { float qf[8], kf[8]; unpack8(qreg, qf); unpack8(kreg, kf);
          const float wi = winter[lr], wgs = wg[lr];
          *(uint4*)(Qs + lr * 72 + lc0) = qreg; *(uint4*)(Ks + lr * 72 + lc0) = kreg;
          uint4 o; o.x = pack2(qf[0] * wi, qf[1] * wi); o.y = pack2(qf[2] * wi, qf[3] * wi); o.z = pack2(qf[4] * wi, qf[5] * wi); o.w = pack2(qf[6] * wi, qf[7] * wi);
          *(uint4*)(Qp + lr * 72 + lc0) = o;
          const unsigned k01 = pack2(kf[0] * wgs, kf[1] * wgs), k23 = pack2(kf[2] * wgs, kf[3] * wgs), k45 = pack2(kf[4] * wgs, kf[5] * wgs), k67 = pack2(kf[6] * wgs, kf[7] * wgs);
          bf16_t* kt = KTw + lc0 * 72 + lr;
          kt[0] = (bf16_t)(k01 & 0xffff); kt[72] = (bf16_t)(k01 >> 16); kt[144] = (bf16_t)(k23 & 0xffff); kt[216] = (bf16_t)(k23 >> 16);
          kt[288] = (bf16_t)(k45 & 0xffff); kt[360] = (bf16_t)(k45 >> 16); kt[432] = (bf16_t)(k67 & 0xffff); kt[504] = (bf16_t)(k67 >> 16);
          bf16_t* vt = VT + lc0 * 72 + lr;
          vt[0] = (bf16_t)(vreg.x & 0xffff); vt[72] = (bf16_t)(vreg.x >> 16); vt[144] = (bf16_t)(vreg.y & 0xffff); vt[216] = (bf16_t)(vreg.y >> 16);
          vt[288] = (bf16_t)(vreg.z & 0xffff); vt[360] = (bf16_t)(vreg.z >> 16); vt[432] = (bf16_t)(vreg.w & 0xffff); vt[504] = (bf16_t)(vreg.w >> 16); }
        __syncthreads();
        if (ck + 1 < 36) { const int ck1 = ck + 1; const int seq1 = ck1 >= 4; const int Ls1 = seq1 ? SEQ : CTX; const size_t rb1 = seq1 ? (size_t)b * SEQ : (size_t)MLAT + b * CTX; const int kk1 = seq1 ? ck1 - 4 : ck1;
            const int pos = dir ? Ls1 - 1 - (kk1 * 64 + lr) : kk1 * 64 + lr; const size_t row = rb1 + pos;
            qreg = *(const uint4*)(mlqk + row * 512 + hh * 64 + lc0); kreg = *(const uint4*)(mlqk + row * 512 + 256 + hh * 64 + lc0); vreg = *(const uint4*)(p + row * NP + 512 + hh * 64 + lc0);
            if (tid < 64) { const float* gp = gates + row * 16 + dir * 8 + hh; gi = gp[0]; gf = gp[4]; } }
#pragma unroll
        for (int j = 0; j < 2; ++j) { const int ti = 2 * wid + j; const int st = ti >> 2, t2 = ti & 3;
            f32x4 sv = (f32x4){0.f, 0.f, 0.f, 0.f};
            if (st <= t2) {
#pragma unroll
                for (int k2 = 0; k2 < 2; ++k2) { const bf16x8 af = *(const bf16x8*)(Ks + (st * 16 + fr) * 72 + k2 * 32 + quad * 8); const bf16x8 bq = *(const bf16x8*)(Qs + (t2 * 16 + fr) * 72 + k2 * 32 + quad * 8);
                    sv = mfma16(af, bq, sv); }
                const int t = t2 * 16 + fr; const float bt = btm[t];
#pragma unroll
                for (int i = 0; i < 4; ++i) { const int s_ = st * 16 + quad * 4 + i; sv[i] = s_ <= t ? sv[i] * expf(bt + aval[s_]) : 0.f; } }
            *(uint2*)(Ss + (t2 * 16 + fr) * 72 + st * 16 + quad * 4) = pack4(sv); }
        __syncthreads();
        { f32x4 oacc[3];
#pragma unroll
          for (int j = 0; j < 3; ++j) oacc[j] = (f32x4){0.f, 0.f, 0.f, 0.f};
#pragma unroll
          for (int k2 = 0; k2 < 2; ++k2) { const bf16x8 bS = *(const bf16x8*)(Ss + (tt * 16 + fr) * 72 + k2 * 32 + quad * 8); const bf16x8 bQ = *(const bf16x8*)(Qp + (tt * 16 + fr) * 72 + k2 * 32 + quad * 8);
              const bf16x8 bK = *(const bf16x8*)(KTw + (tt * 16 + fr) * 72 + k2 * 32 + quad * 8);
#pragma unroll
              for (int j = 0; j < 3; ++j) { const int dt = j < 2 ? 2 * grp + j : 4;
                  const bf16x8 aV = *(const bf16x8*)(VT + (dt * 16 + fr) * 72 + k2 * 32 + quad * 8); const bf16x8 aC = *(const bf16x8*)(Cs + (dt * 16 + fr) * 72 + k2 * 32 + quad * 8);
                  oacc[j] = mfma16(aV, bS, oacc[j]); oacc[j] = mfma16(aC, bQ, oacc[j]);
                  if (k2 == 0) Cacc[j] = Cacc[j] * sc[1];
                  Cacc[j] = mfma16(aV, bK, Cacc[j]); } }
          const int t = tt * 16 + fr;
          const float den = __shfl(oacc[2][0], fr);
          const float inv = 1.f / fmaxf(fabsf(den), expf(-mrow[t]));
          const int pos = dir ? Ls - 1 - (kk * 64 + t) : kk * 64 + t; const size_t row = rowbase + pos;
#pragma unroll
          for (int j = 0; j < 2; ++j) { const f32x4 o = oacc[j] * inv; *(f32x4*)(mlh + row * 256 + hh * 64 + (2 * grp + j) * 16 + quad * 4) = o; } }
        __syncthreads();
#pragma unroll
        for (int j = 0; j < 3; ++j) { const int dt = j < 2 ? 2 * grp + j : 4;
#pragma unroll
            for (int i = 0; i < 4; ++i) Cs[(dt * 16 + quad * 4 + i) * 72 + tt * 16 + fr] = f2bf(Cacc[j][i]); }
        if (tid == 0) sc[0] = sc[2];
    }
}

constexpr int MX_ML = 64, MX_HYL = 256, MX_GQAL = 256, MX_DIFL = 512, MX_GQAC = 32, MX_DIFC = 64, MX_HYC = 256;
constexpr int MX_TOTAL = MX_ML + MX_HYL + MX_GQAL + MX_DIFL + MX_GQAC + MX_DIFC + MX_HYC;

DEVI void mixer_phase(const Params& P, int cidx, int l, unsigned char* smem) {
    unsigned* ctr = (unsigned*)(opaque_ws(P) + WS_CTL) + cidx;
    int* s_item = (int*)smem;
    for (;;) {
        __syncthreads();
        if (opaque_tid() == 0) *s_item = (int)atomicAdd(ctr, 1u);
        __syncthreads();
        int it = *s_item;
        if (it >= (l == DEPTH - 1 ? MX_ML + MX_HYL + MX_GQAL + MX_DIFL : MX_TOTAL)) break;
        if (it < MX_ML) { ml_item(P, l, it >> 3, (it >> 1) & 3, it & 1, smem);
#ifdef PROBE_ML2
            __syncthreads(); ml_item(P, l, it >> 3, (it >> 1) & 3, it & 1, smem);
#endif
            continue; } it -= MX_ML;
#ifndef PROBE_MX
#define PROBE_MX 0
#endif
        if (it < MX_DIFL) { for (int pr = 0; pr < (PROBE_MX == 3 ? 2 : 1); ++pr) { if (pr) __syncthreads(); attn_item<true>(P, l, it >> 6, (it >> 4) & 3, it & 15, false, smem); } continue; } it -= MX_DIFL;
        if (it < MX_GQAL) { for (int pr = 0; pr < (PROBE_MX == 2 ? 2 : 1); ++pr) { if (pr) __syncthreads(); attn_item<false>(P, l, it >> 5, (it >> 4) & 1, it & 15, false, smem); } continue; } it -= MX_GQAL;
        if (it < MX_HYL) { for (int pr = 0; pr < (PROBE_MX == 1 ? 2 : 1); ++pr) { if (pr) __syncthreads(); hy_item<16>(P, l, it, smem); } continue; } it -= MX_HYL;
        if (it < MX_GQAC) { attn_item<false>(P, l, it >> 2, (it >> 1) & 1, it & 1, true, smem); continue; } it -= MX_GQAC;
        if (it < MX_DIFC) { attn_item<true>(P, l, it >> 3, (it >> 1) & 3, it & 1, true, smem); continue; } it -= MX_DIFC;
        hy_item<2>(P, l, it, smem);
    }
}

DEVI void final_phase(const Params& P, int l, unsigned char* smem) {
    const int tid = opaque_tid();
    const float* mlh0 = (const float*)(opaque_ws(P) + WS_MLH); const float* mlh1 = mlh0 + (size_t)MT * 256;
    const bf16_t* p = (const bf16_t*)(opaque_ws(P) + WS_P); const bf16_t* hyo = (const bf16_t*)(opaque_ws(P) + WS_HYO);
    bf16_t* cat = (bf16_t*)(opaque_ws(P) + WS_CAT);
    const float* ng = P.in[14] + (size_t)l * 256;
    bf16_t* lt = (bf16_t*)(smem + 1024);
    constexpr int TR = 32;
    const int ntile = ((l == DEPTH - 1 ? MLAT : MT) + TR - 1) / TR;
    for (int rt = opaque_bid(); rt < ntile; rt += gridDim.x) { const int row0 = rt * TR;
        for (int task = tid; task < TR * 64; task += 512) { const int r = task >> 6, c4 = (task & 63) * 4; const size_t row = row0 + r;
            const float4 a = *(const float4*)(mlh0 + row * 256 + c4), bq = *(const float4*)(mlh1 + row * 256 + c4);
            float4 h; h.x = a.x + bq.x; h.y = a.y + bq.y; h.z = a.z + bq.z; h.w = a.w + bq.w;
            float ss = h.x * h.x + h.y * h.y + h.z * h.z + h.w * h.w;
            ss += __shfl_xor(ss, 1); ss += __shfl_xor(ss, 2); ss += __shfl_xor(ss, 4); ss += __shfl_xor(ss, 8);
            const float rstd = rsqrtf(ss * (1.f / 64.f) + 1e-6f);
            const float4 g4 = *(const float4*)(ng + c4);
            const uint2 ov = *(const uint2*)(p + row * NP + 768 + c4);
            f32x4 y; y[0] = h.x * rstd * g4.x * sigmoid_fast(bflo(ov.x)); y[1] = h.y * rstd * g4.y * sigmoid_fast(bfhi(ov.x));
            y[2] = h.z * rstd * g4.z * sigmoid_fast(bflo(ov.y)); y[3] = h.w * rstd * g4.w * sigmoid_fast(bfhi(ov.y));
            *(uint2*)(cat + row * D + c4) = pack4(y); }
        for (int task = tid; task < 256 * (TR / 8); task += 512) { const int c = task / (TR / 8), ch = task % (TR / 8);
            const uint4 v = *(const uint4*)(hyo + (size_t)c * MT + row0 + ch * 8);
            bf16_t* d = lt + (size_t)(ch * 8) * 264 + c;
            d[0] = (bf16_t)(v.x & 0xffff); d[264] = (bf16_t)(v.x >> 16); d[528] = (bf16_t)(v.y & 0xffff); d[792] = (bf16_t)(v.y >> 16);
            d[1056] = (bf16_t)(v.z & 0xffff); d[1320] = (bf16_t)(v.z >> 16); d[1584] = (bf16_t)(v.w & 0xffff); d[1848] = (bf16_t)(v.w >> 16); }
        __syncthreads();
        for (int task = tid; task < TR * 32; task += 512) { const int r = task >> 5, c8 = (task & 31) * 8;
            *(uint4*)(cat + (size_t)(row0 + r) * D + 512 + c8) = *(const uint4*)(lt + (size_t)r * 264 + c8); }
        __syncthreads();
    }
}

#ifndef REPSTEP
#define REPSTEP -1
#endif
#define XBAR() do { XcdBarrier xb_; xb_.bar = (unsigned*)(opaque_ws(P) + WS_BAR); xb_.x = xb_xcc_id(); xb_.st = (volatile LAS3 unsigned*)(smem + 16); xcd_barrier(xb_); } while (0)
__global__ void __launch_bounds__(512) mega_fwd(Params P) {
    extern __shared__ __attribute__((aligned(16))) unsigned char smem[];
    cg::grid_group grid = cg::this_grid();
    if (threadIdx.x < 8) ((volatile LAS3 unsigned*)(smem + 16))[threadIdx.x] = 0u;
    __syncthreads();
    if (blockIdx.x == 0) { for (int i = threadIdx.x; i < (4096 + 16384) / 4; i += 512) ((unsigned*)(P.ws + WS_CTL))[i] = 0u; }
    phase0a(P, smem);
    grid.sync();
#ifdef PROBE_P0A
    phase0a(P, smem);
    grid.sync();
#endif
    (void)xcd_barrier_post((unsigned*)(opaque_ws(P) + WS_BAR), (volatile LAS3 unsigned*)(smem + 16));
    phase0b(P, smem);
    XBAR();
#ifdef PROBE_P0B
    phase0b(P, smem);
    XBAR();
#endif
    constexpr int NS = 10;
#ifdef PROBE_S
    unsigned long long pacc = 0;
#endif
#pragma unroll 1
    for (int step = 0; step < DEPTH * NS; ++step) {
        const int l = step / NS, s = step - l * NS;
#ifdef PROBE_S
        unsigned long long pt0 = 0; if (s == PROBE_S) pt0 = __builtin_amdgcn_s_memrealtime();
#endif
        if (s == 4) prep_phase(P, l, smem);
        else if (s == 5) mixer_phase(P, l, l, smem);
        else if (s == 6) final_phase(P, l, smem);
        else {
            int opA = 0, partA = 0, lA = l, opB = 0, partB = 0, B0 = 0, R = 0;
            const bool last = (l == DEPTH - 1);
            switch (s) {
            case 0: if (l > 0) { opA = 6; partA = 1; lA = l - 1; B0 = 32; R = 3; } opB = 1; break;
            case 1: opA = 2; opB = 1; partB = 1; break;
            case 2: opA = 2; partA = 1; opB = 3; B0 = 32; R = 3; break;
            case 3: opA = 3; partA = 1; break;
            case 7: opA = 4; break;
            case 8: if (!last) { opA = 4; partA = 1; B0 = 32; R = 1; } opB = 5; break;
            default: opA = 6; if (!last) { opB = 5; partB = 1; } break;
            }
#pragma unroll 1
            for (int jj = 0; jj < 2; ++jj) {
                const int op = jj ? opB : opA, part = jj ? partB : partA, lj = jj ? l : lA;
                if (op == 0) continue;
                unsigned char* ws = opaque_ws(P);
                const float* modl = (const float*)(ws + WS_MOD) + (size_t)lj * 9 * 9216;
                float* ssqb = (float*)(ws + WS_SSQ);
                GemmJob J;
                J.nM = part ? 8 : 64; J.pm0 = part ? 64 : 0; J.B0 = jj ? B0 : 0; J.R = jj ? R : 0; J.nK = 1; J.order = 0; J.K = 1024; J.ld = 1024;
                J.hl = P.out; J.hc = (float*)(ws + WS_HCTX); J.gates = (float*)(ws + WS_GATES); J.gb = P.in[11] + lj * 16;
                J.obf = nullptr; J.gate = modl; J.fac = 0.f; J.aout = nullptr; J.ng = P.in[6]; J.nscale = modl; J.ssq = ssqb; J.Sb = nullptr;
                if (op == 1 || op == 5) { const int f = op == 1 ? 0 : 1; J.A = (const bf16_t*)(ws + WS_A); J.Bt = (const bf16_t*)(ws + WS_W13) + (size_t)(lj * 2 + f) * 5632 * 1024; J.nN = 22; J.epi = 0; J.obf = (bf16_t*)(ws + WS_HID);
                    J.ssq = ssqb + (size_t)(lj * 3 + (f ? 2 : 0)) * MT; J.Sb = (const float*)(ws + WS_SB) + (size_t)(lj * 2 + f) * 9 * 5632; }
                else if (op == 2 || op == 6) { const int f = op == 2 ? 0 : 1; J.A = (const bf16_t*)(ws + WS_HID); J.Bt = (const bf16_t*)(ws + WS_W2) + (size_t)(lj * 2 + f) * 1024 * 2816; J.nN = 4; J.K = 2816; J.ld = 2816; J.epi = 1;
                    J.gate = modl + (f == 0 ? 2 : 8) * 1024; J.fac = 0.5f;
                    const bool fuse = (f == 0) || (lj + 1 < DEPTH); const int ln = (f == 1 && lj + 1 < DEPTH) ? lj + 1 : lj;
                    J.aout = fuse ? (bf16_t*)(ws + WS_A) : (bf16_t*)nullptr; J.ng = P.in[6] + (size_t)(ln * 3 + (f == 0 ? 1 : 0)) * 1024;
                    J.nscale = (const float*)(ws + WS_MOD) + (size_t)ln * 9 * 9216 + (f == 0 ? 4 : 1) * 1024; J.ssq = ssqb + (size_t)(ln * 3 + (f == 0 ? 1 : 0)) * MT; }
                else if (op == 3) { J.A = (const bf16_t*)(ws + WS_A); J.Bt = (const bf16_t*)(ws + WS_WIN) + (size_t)lj * NPG * 1024; J.nN = 13; J.epi = 2; J.obf = (bf16_t*)(ws + WS_P);
                    J.ssq = ssqb + (size_t)(lj * 3 + 1) * MT; J.Sb = (const float*)(ws + WS_SBIN) + (size_t)lj * 9 * NPG; }
                else { J.A = (const bf16_t*)(ws + WS_CAT); J.Bt = (const bf16_t*)(ws + WS_WOUT) + (size_t)lj * 1024 * 1024; J.nN = 4; J.epi = 1; J.gate = modl + 5 * 1024; J.fac = 1.f;
                    J.aout = (bf16_t*)(ws + WS_A); J.ng = P.in[6] + (size_t)(lj * 3 + 2) * 1024; J.nscale = modl + 7 * 1024; J.ssq = ssqb + (size_t)(lj * 3 + 2) * MT; }
                run_job(smem, J);
            }
        }
        XBAR();
#ifdef PROBE_S
        if (s == PROBE_S) pacc += __builtin_amdgcn_s_memrealtime() - pt0;
#endif
    }
#ifdef PROBE_EPI
    if (blockIdx.x == 0) { const unsigned pe = *(volatile LAS3 unsigned*)(smem + 32); const unsigned long long t1 = __builtin_amdgcn_s_memrealtime(); while (__builtin_amdgcn_s_memrealtime() - t1 < 4ull * pe) __builtin_amdgcn_s_sleep(8); }
#endif
#ifdef PROBE_S
    if (blockIdx.x == 0) { const unsigned long long t1 = __builtin_amdgcn_s_memrealtime(); while (__builtin_amdgcn_s_memrealtime() - t1 < 4ull * pacc) __builtin_amdgcn_s_sleep(8); }
#endif
}

extern "C" void kernel_launch(void* const* d_in, const int* in_sizes, int n_in, void* d_out, int out_size, void* d_ws, size_t ws_size, hipStream_t stream) {
    static int grid_blocks = 0;
    if (grid_blocks == 0) {
        if (n_in != 28 || ws_size < WS_END) { fprintf(stderr, "kernel_launch: unexpected n_in %d or ws_size %zu (need %zu)\n", n_in, ws_size, (size_t)WS_END); grid_blocks = -1; return; }
        int dev = 0, cus = 0, per_cu = 0;
        hipGetDevice(&dev);
        hipDeviceGetAttribute(&cus, hipDeviceAttributeMultiprocessorCount, dev);
        if (hipFuncSetAttribute((const void*)mega_fwd, hipFuncAttributeMaxDynamicSharedMemorySize, LDS_BYTES) != hipSuccess) { fprintf(stderr, "kernel_launch: hipFuncSetAttribute failed\n"); }
        if (hipOccupancyMaxActiveBlocksPerMultiprocessor(&per_cu, (const void*)mega_fwd, 512, LDS_BYTES) != hipSuccess || per_cu < 1) { fprintf(stderr, "kernel_launch: occupancy query gave %d\n", per_cu); per_cu = 1; }
        (void)hipGetLastError();
        grid_blocks = cus;
    }
    if (grid_blocks < 0) return;
    Params p{};
    for (int i = 0; i < 28; ++i) p.in[i] = (const float*)d_in[i];
    p.out = (float*)d_out; p.ws = (unsigned char*)d_ws;
    void* args[] = {&p};
    hipError_t e = hipLaunchCooperativeKernel((const void*)mega_fwd, dim3(grid_blocks), dim3(512), args, LDS_BYTES, stream);
    if (e != hipSuccess) fprintf(stderr, "cooperative launch failed: %s (grid %d)\n", hipGetErrorString(e), grid_blocks);
}
```

```cpp
#define REPSTEP -1
#include <hip/hip_runtime.h>
#include <hip/hip_cooperative_groups.h>
#include <cstdio>
namespace cg = cooperative_groups;
__device__ __forceinline__ int opaque_tid() { int t = threadIdx.x; asm volatile("" : "+v"(t)); return t; }
__device__ __forceinline__ int opaque_bid() { int b = blockIdx.x; asm volatile("" : "+s"(b)); return b; }
namespace pg8 {
#define PG8_LAS __attribute__((address_space(3)))
typedef unsigned short bf16_t;
typedef short bf16x8 __attribute__((ext_vector_type(8)));
typedef float f32x4 __attribute__((ext_vector_type(4)));
typedef unsigned u32x4 __attribute__((ext_vector_type(4)));
constexpr int BM = 256, BK = 64, HALF = 128, HTB = HALF * BK * 2  , STAGE_BYTES = 8 * HTB, NXCD = 8, WGM = 8;

__host__ __device__ __forceinline__ int lds_byte(int r, int c) { const int st = (r >> 4) * 2 + (c >> 5), rr = r & 15, cc = c & 31, ob = rr * 64 + cc * 2; return st * 1024 + (ob ^ (((ob >> 9) & 1) << 5)); }
__host__ __device__ __forceinline__ void stage_rc(int b, int& R, int& C) { const int st = b / 1024, sb = b % 1024, swz = sb ^ (((sb >> 9) & 1) << 5); R = (st >> 1) * 16 + swz / 64; C = (st & 1) * 32 + (swz % 64) / 2; }
__host__ __device__ __forceinline__ int perm32(int rho) { const int n = rho >> 4, i = rho & 15; return 8 * (i >> 2) + 4 * n + (i & 3); }

struct Unit { int pm, pn, kp; };
struct Gemm { const bf16_t* A; const bf16_t* Bt; int M, N, K, ld; };

struct StaticOrder {
    int nM, nN, nwg, G, c;
    __host__ __device__ void init(int M, int N, int G_, int c_) { nM = M / BM; nN = N / BM; nwg = nM * nN; G = G_; c = c_; }
    __host__ __device__ bool next(int i, Unit& u) const { return at((long)i * G + c, u); }
    __host__ __device__ bool at(const long L, Unit& u) const {
        if (L >= nwg) return false;
        int wgid = (int)L; { const int q = nwg / NXCD, r = nwg % NXCD, xcd = wgid % NXCD, off = wgid / NXCD; wgid = (xcd < r ? xcd * (q + 1) : r * (q + 1) + (xcd - r) * q) + off; }
        const int nig = WGM * nN, gid = wgid / nig, fm = gid * WGM, gsz = (nM - fm) < WGM ? (nM - fm) : WGM;
        u.pm = fm + ((wgid % nig) % gsz); u.pn = (wgid % nig) / gsz; u.kp = 0; return true;
    }
    __device__ __forceinline__ void a_ready(const Unit&) const {}
    __device__ __forceinline__ void done(const Unit&) const {}
};
struct SplitOrder {
    int nN, nK, total, G, c;
    __host__ __device__ void init(int nM_, int nN_, int nK_, int G_, int c_) { nN = nN_; nK = nK_; total = nM_ * nN_ * nK_; G = G_; c = c_; }
    __host__ __device__ bool next(int i, Unit& u) const { const int L = i * G + c; if (L >= total) return false; u.kp = L % nK; const int r = L / nK; u.pn = r % nN; u.pm = r / nN; return true; }
    __device__ __forceinline__ void a_ready(const Unit&) const {}
    __device__ __forceinline__ void done(const Unit&) const {}
};
__device__ __forceinline__ unsigned cvt_pk_bf16(float lo, float hi) { unsigned r; asm volatile("v_cvt_pk_bf16_f32 %0, %1, %2" : "=v"(r) : "v"(lo), "v"(hi)); return r; }
template <class Epi, class Sched, bool STAMP = false>
__device__ __forceinline__ void gemm_phase(PG8_LAS unsigned char* lds, const Gemm g, const Sched& S, const Epi& E, unsigned long long* stamps) {
    const int tid = opaque_tid(), wid = __builtin_amdgcn_readfirstlane(tid >> 6), lane = tid & 63, wr = wid >> 2, wc = wid & 3, fr = lane & 15, fq = lane >> 4;
    const int K = g.K, LD = g.ld, nt = K / BK;
    int ts_lo = 0, ts_hi = 0, nts = 0; const unsigned long long rt_entry = STAMP ? (unsigned long long)wall_clock64() : 0ull;
#define PG8_STAMP() do { if (STAMP && wid == 0 && nts < 64) { const unsigned long long _c = (unsigned long long)clock64(); \
        ts_lo = (lane == nts) ? (int)(unsigned)_c : ts_lo; ts_hi = (lane == nts) ? (int)(unsigned)(_c >> 32) : ts_hi; ++nts; } } while (0)
    PG8_STAMP();
    unsigned voffA[2], voffB[2];
#pragma unroll
    for (int i = 0; i < 2; ++i) { int R, C; stage_rc(tid * 16 + i * 8192, R, C); const int Rb = Epi::PERM ? ((R & ~31) + perm32(R & 31)) : R;
        voffA[i] = (unsigned)(R * LD + C) * 2u; voffB[i] = (unsigned)(Rb * LD + C) * 2u; }
    const size_t kstep = (size_t)(BK * 2);
    const size_t hstep = (size_t)HALF * LD * 2; const size_t kpstep = (size_t)K * 2;
    const size_t tstep = 2 * hstep;
    const unsigned ldsw = (unsigned)wid * 1024u;
    const int aoff = lds_byte(wr * 64 + fr, fq * 8), boff = lds_byte(wc * 32 + fr, fq * 8);
#define PG8_SA(b, h) (((b) * 2 + (h)) * HTB)
#define PG8_SB(b, h) ((4 + (b) * 2 + (h)) * HTB)
#define PG8_STAGE(bufoff, gbase, voff) do { _Pragma("unroll") for (int _i = 0; _i < 2; ++_i) \
        __builtin_amdgcn_global_load_lds((const unsigned*)((const char*)(gbase) + (voff)[_i]), (PG8_LAS unsigned*)(lds + (bufoff) + ldsw + _i * 8192), 16, 0, 0); } while (0)
#define PG8_LDA(dst, b, h) do { _Pragma("unroll") for (int m = 0; m < 4; ++m) _Pragma("unroll") for (int k = 0; k < 2; ++k) dst[m][k] = *(const PG8_LAS bf16x8*)(lds + PG8_SA(b, h) + aoff + m * 2048 + k * 1024); } while (0)
#define PG8_LDB(dst, b, h) do { _Pragma("unroll") for (int n = 0; n < 2; ++n) _Pragma("unroll") for (int k = 0; k < 2; ++k) dst[n][k] = *(const PG8_LAS bf16x8*)(lds + PG8_SB(b, h) + boff + n * 2048 + k * 1024); } while (0)
#define PG8_MMA(ai, bj, At, Bt) do { __builtin_amdgcn_s_setprio(1); _Pragma("unroll") for (int m = 0; m < 4; ++m) _Pragma("unroll") for (int n = 0; n < 2; ++n) _Pragma("unroll") for (int k = 0; k < 2; ++k) \
        acc[ai][bj][m][n] = __builtin_amdgcn_mfma_f32_16x16x32_bf16(Bt[n][k], At[m][k], acc[ai][bj][m][n], 0, 0, 0); __builtin_amdgcn_s_setprio(0); } while (0)
#define PG8_WAIT_V(n) asm volatile("s_waitcnt vmcnt(" #n ")" ::: "memory")
#define PG8_WAIT_L(n) asm volatile("s_waitcnt lgkmcnt(" #n ")" ::: "memory")
#define PG8_BAR __builtin_amdgcn_s_barrier()
#define PG8_SCHED __builtin_amdgcn_sched_barrier(0)
    Unit cur, nxt; int ui = 0;
    if (!S.next(0, cur)) return;
    f32x4 acc[2][2][4][2];
#pragma unroll
    for (int a = 0; a < 2; ++a)
#pragma unroll
        for (int b = 0; b < 2; ++b)
#pragma unroll
            for (int m = 0; m < 4; ++m)
#pragma unroll
                for (int n = 0; n < 2; ++n) acc[a][b][m][n] = (f32x4){0.f, 0.f, 0.f, 0.f};
    bf16x8 At[4][2], B0[2][2], B1[2][2];
    const char* cA = (const char*)g.A + (size_t)cur.pm * tstep + (size_t)cur.kp * kpstep; const char* cB = (const char*)g.Bt + (size_t)cur.pn * tstep + (size_t)cur.kp * kpstep;
    S.a_ready(cur);
    PG8_STAGE(PG8_SB(0, 0), cB, voffB); PG8_STAGE(PG8_SA(0, 0), cA, voffA); PG8_STAGE(PG8_SB(0, 1), cB + hstep, voffB); PG8_STAGE(PG8_SA(0, 1), cA + hstep, voffA);
    if (wr == 1) PG8_BAR;
    PG8_WAIT_V(4); PG8_BAR;
    PG8_STAGE(PG8_SB(1, 0), cB + kstep, voffB); PG8_STAGE(PG8_SA(1, 0), cA + kstep, voffA); PG8_STAGE(PG8_SB(1, 1), cB + hstep + kstep, voffB);
    PG8_WAIT_V(6); PG8_BAR;
    PG8_STAMP();
    for (;;) {
        const bool has_next = S.next(ui + 1, nxt);
        const char* nA = has_next ? (const char*)g.A + (size_t)nxt.pm * tstep + (size_t)nxt.kp * kpstep : cA; const char* nB = has_next ? (const char*)g.Bt + (size_t)nxt.pn * tstep + (size_t)nxt.kp * kpstep : cB;
        for (int t = 0; t < nt; t += 2) {
            const bool last = (t == nt - 2);
            const char* a1 = cA + (size_t)(t + 1) * kstep;
            const char* a2 = last ? nA : cA + (size_t)(t + 2) * kstep; const char* b2 = last ? nB : cB + (size_t)(t + 2) * kstep;
            const char* a3 = a2 + kstep; const char* b3 = b2 + kstep;
            if (last && has_next) S.a_ready(nxt);
            PG8_LDB(B0, 0, 0); PG8_SCHED; PG8_LDA(At, 0, 0); PG8_STAGE(PG8_SA(1, 1), a1 + hstep, voffA);
            PG8_WAIT_L(8); PG8_BAR; PG8_WAIT_L(0); PG8_MMA(0, 0, At, B0); PG8_BAR; PG8_SCHED;
            PG8_LDB(B1, 0, 1); PG8_STAGE(PG8_SB(0, 0), b2, voffB);
            PG8_BAR; PG8_WAIT_L(0); PG8_MMA(0, 1, At, B1); PG8_BAR;
            PG8_LDA(At, 0, 1); PG8_STAGE(PG8_SA(0, 0), a2, voffA);
            PG8_BAR; PG8_WAIT_L(0); PG8_MMA(1, 0, At, B0); PG8_BAR; PG8_SCHED;
            PG8_STAGE(PG8_SB(0, 1), b2 + hstep, voffB);
            PG8_WAIT_V(6); PG8_BAR; PG8_MMA(1, 1, At, B1); PG8_BAR;
            PG8_LDB(B0, 1, 0); PG8_SCHED; PG8_LDA(At, 1, 0); PG8_STAGE(PG8_SA(0, 1), a2 + hstep, voffA);
            PG8_WAIT_L(8); PG8_BAR; PG8_WAIT_L(0); PG8_MMA(0, 0, At, B0); PG8_BAR; PG8_SCHED;
            PG8_LDB(B1, 1, 1); PG8_STAGE(PG8_SB(1, 0), b3, voffB);
            PG8_BAR; PG8_WAIT_L(0); PG8_MMA(0, 1, At, B1); PG8_BAR;
            PG8_LDA(At, 1, 1); PG8_STAGE(PG8_SA(1, 0), a3, voffA);
            PG8_BAR; PG8_WAIT_L(0); PG8_MMA(1, 0, At, B0); PG8_BAR; PG8_SCHED;
            PG8_STAGE(PG8_SB(1, 1), b3 + hstep, voffB);
            PG8_WAIT_V(6); PG8_BAR; PG8_MMA(1, 1, At, B1); PG8_BAR;
        }
        PG8_STAMP();
#ifdef PROBE_EPI
        const unsigned long long pe0 = __builtin_amdgcn_s_memrealtime();
#endif
        if constexpr (!Epi::AFTER_DRAIN) { E(acc, cur, nxt, has_next, wr, wc, fr, fq); S.done(cur); }
#ifdef PROBE_EPI
        asm volatile("s_waitcnt vmcnt(0)" ::: "memory");
        if (tid == 0) { *(volatile PG8_LAS unsigned*)(lds - 1024 + 32) += (unsigned)(__builtin_amdgcn_s_memrealtime() - pe0); }
#endif
        PG8_STAMP();
        if (!has_next) break;
#pragma unroll
        for (int a = 0; a < 2; ++a)
#pragma unroll
            for (int b = 0; b < 2; ++b)
#pragma unroll
                for (int m = 0; m < 4; ++m)
#pragma unroll
                    for (int n = 0; n < 2; ++n) acc[a][b][m][n] = (f32x4){0.f, 0.f, 0.f, 0.f};
        cur = nxt; cA = nA; cB = nB; ++ui;
    }
    PG8_WAIT_V(0);
    if (wr == 0) PG8_BAR;
    PG8_BAR;
    if constexpr (Epi::AFTER_DRAIN) { E.fused(acc, cur, wr, wc, fr, fq, lds, wid, lane); S.done(cur); }
    PG8_STAMP();
    if (STAMP && wid == 0) { stamps[lane] = lane < nts ? (((unsigned long long)(unsigned)ts_hi << 32) | (unsigned)ts_lo) : 0ull;
        if (lane == 62) stamps[62] = rt_entry; if (lane == 63) stamps[63] = (unsigned long long)wall_clock64(); }
#undef PG8_STAMP
#undef PG8_SA
#undef PG8_SB
#undef PG8_STAGE
#undef PG8_LDA
#undef PG8_LDB
#undef PG8_MMA
#undef PG8_WAIT_V
#undef PG8_WAIT_L
#undef PG8_BAR
#undef PG8_SCHED
}
}

using pg8::bf16_t; using pg8::bf16x8; using pg8::f32x4;
#define DEVI __device__ __forceinline__
#define LAS3 __attribute__((address_space(3)))
#define G1 __attribute__((address_space(1)))

constexpr int D = 1024, NB = 8, SEQ = 2048, CTX = 256, DEPTH = 4, FF = 2816, NIN = 3088, NP = 3072, NPG = 3328;
constexpr int MLAT = NB * SEQ, MCTX = NB * CTX, MT = MLAT + MCTX, KEYS = CTX + SEQ;
constexpr float LOG2E = 1.4426950408889634f;
constexpr int LDS_BYTES = 160 * 1024;
#ifndef SKIPMASK
#define SKIPMASK 0
#endif
#ifndef GM
#define GM 0
#endif
#ifndef P0M
#define P0M 0
#endif

constexpr size_t al256(size_t x) { return (x + 255) & ~(size_t)255; }
constexpr size_t WS_CTL = 0;
constexpr size_t WS_BAR = 4096;
constexpr size_t WS_MOD = 4096 + 16384;
constexpr size_t WS_W13 = WS_MOD + al256((size_t)DEPTH * 9 * 9216 * 4);
constexpr size_t WS_W2 = WS_W13 + al256((size_t)DEPTH * 2 * 5632 * 1024 * 2);
constexpr size_t WS_WIN = WS_W2 + al256((size_t)DEPTH * 2 * 1024 * 2816 * 2);
constexpr size_t WS_WOUT = WS_WIN + al256((size_t)DEPTH * NPG * 1024 * 2);
constexpr size_t WS_HF = WS_WOUT + al256((size_t)DEPTH * 1024 * 1024 * 2);
constexpr size_t HF_LAYER = (size_t)512 * (SEQ + CTX);
constexpr size_t WS_HFS = WS_HF + al256((size_t)DEPTH * HF_LAYER * 4);
constexpr size_t WS_ROPEG = WS_HFS + al256((size_t)DEPTH * 36 * 512 * 4);
constexpr size_t WS_ROPED = WS_ROPEG + al256((size_t)SEQ * 64 * 4);
constexpr size_t WS_HCTX = WS_ROPED + al256((size_t)SEQ * 32 * 4);
constexpr size_t WS_A = WS_HCTX + al256((size_t)MCTX * D * 4);
constexpr size_t WS_P = WS_A + al256((size_t)MT * D * 2);
constexpr size_t WS_HID = WS_P + al256((size_t)MT * NP * 2);
constexpr size_t WS_GATES = WS_HID + al256((size_t)MT * FF * 2);
constexpr size_t WS_CAT = WS_GATES + al256((size_t)MT * 16 * 4);
constexpr size_t WS_Q = WS_CAT + al256((size_t)MT * D * 2);
constexpr size_t WS_K = WS_Q + al256((size_t)NB * 8 * KEYS * 64 * 2);
constexpr size_t WS_VT = WS_K + al256((size_t)NB * 6 * KEYS * 64 * 2);
constexpr size_t WS_MLQK = WS_VT + al256((size_t)NB * 6 * KEYS * 64 * 2);
constexpr size_t WS_HYU = WS_MLQK + al256((size_t)MT * 512 * 4);
constexpr size_t WS_HYO = WS_HYU + al256((size_t)768 * MT * 2);
constexpr size_t WS_MLH = WS_HYO + al256((size_t)256 * MT * 2);
constexpr size_t WS_SB = WS_MLH + al256((size_t)2 * MT * 256 * 4);
constexpr size_t WS_SBIN = WS_SB + al256((size_t)DEPTH * 2 * 9 * 5632 * 4);
constexpr size_t WS_SSQ = WS_SBIN + al256((size_t)DEPTH * 9 * NPG * 4);
constexpr size_t WS_END = WS_SSQ + al256((size_t)DEPTH * 3 * MT * 4);
static_assert((size_t)MT * FF * 2 <= (size_t)MT * NP * 2, "HID must fit in P region");

struct Params { const float* in[28]; float* out; unsigned char* ws; };
__device__ __forceinline__ unsigned char* opaque_ws(const Params& P) { unsigned char* w = P.ws; asm volatile("" : "+s"(w)); return w; }

DEVI bf16_t f2bf(float f) { unsigned u = __float_as_uint(f); u += 0x7FFFu + ((u >> 16) & 1u); return (bf16_t)(u >> 16); }
typedef __bf16 bf16x2_t __attribute__((ext_vector_type(2)));
DEVI unsigned pack2(float lo, float hi) { bf16x2_t v; v[0] = (__bf16)lo; v[1] = (__bf16)hi; return __builtin_bit_cast(unsigned, v); }
DEVI float bflo(unsigned u) { return __uint_as_float(u << 16); }
DEVI float bfhi(unsigned u) { return __uint_as_float(u & 0xffff0000u); }
DEVI float bf2f(bf16_t b) { return __uint_as_float(((unsigned)b) << 16); }
DEVI float wave_sum(float v) { for (int o = 32; o; o >>= 1) v += __shfl_xor(v, o); return v; }
DEVI float wave_max(float v) { for (int o = 32; o; o >>= 1) v = fmaxf(v, __shfl_xor(v, o)); return v; }
DEVI float silu_fast(float a) { return a * __builtin_amdgcn_rcpf(1.f + __builtin_amdgcn_exp2f(a * -1.4426950408889634f)); }
DEVI float silu_prec(float a) { return a / (1.f + expf(-a)); }
DEVI float sigmoid_fast(float a) { return __builtin_amdgcn_rcpf(1.f + __builtin_amdgcn_exp2f(a * -1.4426950408889634f)); }
DEVI float logsigmoid(float x) { return x >= 0.f ? -log1pf(expf(-x)) : x - log1pf(expf(x)); }
DEVI uint2 pack4(f32x4 v) { uint2 r; r.x = pack2(v[0], v[1]); r.y = pack2(v[2], v[3]); return r; }
typedef unsigned u32x2 __attribute__((ext_vector_type(2)));
typedef unsigned u32x4v __attribute__((ext_vector_type(4)));
DEVI u32x4v pack8v(f32x4 a, f32x4 b) { u32x4v r; r[0] = pack2(a[0], a[1]); r[1] = pack2(a[2], a[3]); r[2] = pack2(b[0], b[1]); r[3] = pack2(b[2], b[3]); return r; }
DEVI u32x2 pack4v(f32x4 v) { u32x2 r; r[0] = pack2(v[0], v[1]); r[1] = pack2(v[2], v[3]); return r; }
DEVI f32x4 mfma16(bf16x8 a, bf16x8 b, f32x4 c) { return __builtin_amdgcn_mfma_f32_16x16x32_bf16(a, b, c, 0, 0, 0); }


#define XB_TMO      128
#define XB_XCNT(j)  (256  + 64 * (j))
#define XB_XSUB(j)  (1280 + 64 * (j))
#define XB_XGEN(j)  (2304 + 64 * (j))
#define XB_TOP      3328
#define XB_TOPGEN   3392
#define XCD_BAR_WORDS 3456
#define XB_SPIN_CAP (1u << 20)
DEVI unsigned xb_ld(unsigned* p)              { return __hip_atomic_load(p, __ATOMIC_RELAXED, __HIP_MEMORY_SCOPE_AGENT); }
DEVI unsigned xb_add(unsigned* p, unsigned v) { return __hip_atomic_fetch_add(p, v, __ATOMIC_RELAXED, __HIP_MEMORY_SCOPE_AGENT); }
DEVI unsigned xb_xcc_id() { return (unsigned)__builtin_amdgcn_s_getreg((3 << 11) | 20) & 0xFu; }
#define XB_SPIN(cond, bar) do { unsigned _sp = 0; while (cond) { __builtin_amdgcn_s_sleep(1); \
    if ((++_sp & 255u) == 0u) { if (xb_ld(&(bar)[XB_TMO])) break; if (_sp > XB_SPIN_CAP) { atomicAdd(&(bar)[XB_TMO], 1u); break; } } } } while (0)
struct XcdBarrier { unsigned* bar; unsigned x; volatile LAS3 unsigned* st; };
DEVI XcdBarrier xcd_barrier_post(unsigned* bar, volatile LAS3 unsigned* st) {
    XcdBarrier b; b.bar = bar; b.x = xb_xcc_id(); b.st = st;
    if (opaque_tid() == 0) (void)xb_add(&bar[XB_XCNT(b.x)], 1u);
    return b;
}
DEVI void xcd_barrier_complete(unsigned* bar, unsigned x, unsigned& nloc, unsigned& nx) {
    const unsigned G = gridDim.x * gridDim.y * gridDim.z;
    unsigned sum, cnt, mine, sp = 0u;
    for (;;) {
        sum = 0u; cnt = 0u; mine = 0u;
#pragma unroll
        for (unsigned j = 0; j < 16; ++j) { const unsigned c = xb_ld(&bar[XB_XCNT(j)]); sum += c; cnt += (c > 0u) ? 1u : 0u; mine = (j == x) ? c : mine; }
        if (sum == G) break;
        __builtin_amdgcn_s_sleep(1);
        if ((++sp & 255u) == 0u) { if (xb_ld(&bar[XB_TMO])) break; if (sp > XB_SPIN_CAP) { atomicAdd(&bar[XB_TMO], 1u); break; } }
    }
    nloc = mine > 0u ? mine : 1u; nx = cnt > 0u ? cnt : 1u;
}
#ifndef USE_XCD
#define USE_XCD 1
#endif
DEVI void xcd_barrier(const XcdBarrier& b) {
#if !USE_XCD
    cg::this_grid().sync(); return;
#endif
    asm volatile("s_waitcnt vmcnt(0)" ::: "memory");
    __syncthreads();
    if (opaque_tid() == 0) {
        unsigned* bar = b.bar;
        __builtin_amdgcn_s_waitcnt(0);
        unsigned nloc = b.st[0], nx = b.st[1];
        if (nloc == 0u) { xcd_barrier_complete(bar, b.x, nloc, nx); b.st[0] = nloc; b.st[1] = nx; }
        const unsigned old = xb_add(&bar[XB_XSUB(b.x)], 1u);
        const unsigned gen = old / nloc;
        if (old + 1u == (gen + 1u) * nloc) {
            __builtin_amdgcn_fence(__ATOMIC_RELEASE, "agent");
            asm volatile("s_waitcnt vmcnt(0)" ::: "memory");
            const unsigned og = xb_add(&bar[XB_TOP], 1u);
            const unsigned tg = og / nx;
            if (og + 1u == (tg + 1u) * nx) xb_add(&bar[XB_TOPGEN], 1u);
            else XB_SPIN(xb_ld(&bar[XB_TOPGEN]) == tg, bar);
            __builtin_amdgcn_fence(__ATOMIC_ACQUIRE, "agent");
            xb_add(&bar[XB_XGEN(b.x)], 1u);
            asm volatile("s_waitcnt vmcnt(0)" ::: "memory");
        } else {
            XB_SPIN(xb_ld(&bar[XB_XGEN(b.x)]) == gen, bar);
            __builtin_amdgcn_fence(__ATOMIC_ACQUIRE, "agent");
            asm volatile("s_waitcnt vmcnt(0)" ::: "memory");
        }
    }
    __syncthreads();
}

constexpr int EPW_OFF = 1024 + 131072, EPW_STRIDE = 192 * 4;
DEVI void epw_fill(unsigned char* smem, int mode, const pg8::Unit& u, int wid, int lane, const float* ssq_, const float* Sb_, int sbstride, float (&v)[3]) {
    const G1 float* ssq = (const G1 float*)ssq_; const G1 float* Sb = (const G1 float*)Sb_;
    const int wr = wid >> 2, wc = wid & 3; const int r9 = u.pm < 64 ? (u.pm >> 3) : 8;
#pragma unroll
    for (int k = 0; k < 2; ++k) { const int idx = lane + 64 * k; const int ai = idx >> 6, m = (idx >> 4) & 3, f = idx & 15; v[k] = ssq[u.pm * 256 + ai * 128 + wr * 64 + m * 16 + f]; }
    { const int bj = lane >> 5, c = lane & 31; v[2] = Sb[(size_t)r9 * sbstride + u.pn * 256 + bj * 128 + wc * 32 + c]; }
    (void)mode; (void)smem;
}
DEVI void epw_store(unsigned char* smem, int wid, int lane, const float (&v)[3]) {
    float* w = (float*)(smem + EPW_OFF + wid * EPW_STRIDE);
    w[lane] = rsqrtf(v[0] * (1.f / 1024.f) + 1e-6f); w[64 + lane] = rsqrtf(v[1] * (1.f / 1024.f) + 1e-6f); w[128 + lane] = v[2];
}
struct EpiSwiglu {
    static constexpr bool PERM = true, AFTER_DRAIN = false;
    static DEVI void apply(const f32x4 (&acc)[2][2][4][2], const pg8::Unit& u, int wr, int wc, int fr, int fq, bf16_t* H_, const float* epw) {
        G1 bf16_t* H = (G1 bf16_t*)H_;
        const int row0 = u.pm * 256 + wr * 64 + fr, col0 = u.pn * 128 + wc * 32 + 8 * fq;
        f32x4 sa[2], sb[2];
#pragma unroll
        for (int n = 0; n < 2; ++n) { sa[n] = *(const f32x4*)(epw + 128 + 8 * fq + 4 * n); sb[n] = *(const f32x4*)(epw + 160 + 8 * fq + 4 * n); }
#pragma unroll
        for (int ai = 0; ai < 2; ++ai)
#pragma unroll
            for (int m = 0; m < 4; ++m) { const int row = row0 + ai * 128 + m * 16; G1 bf16_t* rowp = H + (size_t)row * FF + col0;
                const float rstd = epw[(ai * 4 + m) * 16 + fr];
                f32x4 v[2];
#pragma unroll
                for (int n = 0; n < 2; ++n) { const f32x4 a = acc[ai][0][m][n] * rstd + sa[n], b = acc[ai][1][m][n] * rstd + sb[n];
#pragma unroll
                    for (int i = 0; i < 4; ++i) v[n][i] = silu_fast(a[i]) * b[i]; }
                *(G1 u32x4v*)rowp = pack8v(v[0], v[1]); }
    }
};
struct EpiResid {
    static constexpr bool PERM = true, AFTER_DRAIN = false;
    static DEVI void apply(const f32x4 (&acc)[2][2][4][2], const pg8::Unit& u, int wr, int wc, int fr, int fq, float* hl_, float* hc_, const float* gate_, float fac, bf16_t* aout_, const float* ng_, const float* nscale_, float* ssq_) {
        G1 float* hl = (G1 float*)hl_; G1 float* hc = (G1 float*)hc_; const G1 float* gate = (const G1 float*)gate_; G1 bf16_t* aout = (G1 bf16_t*)aout_; const G1 float* ng = (const G1 float*)ng_; const G1 float* nscale = (const G1 float*)nscale_;
        const int row0 = u.pm * 256 + wr * 64 + fr, col0 = u.pn * 256 + wc * 32 + 8 * fq;
        const int r9 = u.pm < 64 ? (u.pm >> 3) : 8;
        const G1 float* gp = gate + (size_t)r9 * 9216 + col0;
        f32x4 gv[2][2];
#pragma unroll
        for (int bj = 0; bj < 2; ++bj)
#pragma unroll
            for (int n = 0; n < 2; ++n) gv[bj][n] = *(const G1 f32x4*)(gp + bj * 128 + n * 4) * fac;
        if (aout_ == nullptr) {
#pragma unroll
            for (int ai = 0; ai < 2; ++ai)
#pragma unroll
                for (int m = 0; m < 4; ++m) { const int row = row0 + ai * 128 + m * 16;
                    G1 float* rowp = (row < MLAT ? hl + (size_t)row * D : hc + (size_t)(row - MLAT) * D) + col0;
#pragma unroll
                    for (int bj = 0; bj < 2; ++bj)
#pragma unroll
                        for (int n = 0; n < 2; ++n) { G1 f32x4* p = (G1 f32x4*)(rowp + bj * 128 + n * 4); *p = *p + gv[bj][n] * acc[ai][bj][m][n]; } }
        } else {
            f32x4 gs[2][2];
#pragma unroll
            for (int bj = 0; bj < 2; ++bj)
#pragma unroll
                for (int n = 0; n < 2; ++n) { const int c = col0 + bj * 128 + n * 4; gs[bj][n] = *(const G1 f32x4*)(ng + c) * (*(const G1 f32x4*)(nscale + (size_t)r9 * 9216 + c) + 1.f); }
#pragma unroll
            for (int ai = 0; ai < 2; ++ai)
#pragma unroll
                for (int m = 0; m < 4; ++m) { const int row = row0 + ai * 128 + m * 16;
                    G1 float* rowp = (row < MLAT ? hl + (size_t)row * D : hc + (size_t)(row - MLAT) * D) + col0;
                    G1 bf16_t* ap = aout + (size_t)row * D + col0;
                    float ss = 0.f;
#pragma unroll
                    for (int bj = 0; bj < 2; ++bj) { f32x4 an[2];
#pragma unroll
                        for (int n = 0; n < 2; ++n) { G1 f32x4* p = (G1 f32x4*)(rowp + bj * 128 + n * 4); const f32x4 hn = *p + gv[bj][n] * acc[ai][bj][m][n]; *p = hn;
                            ss += hn[0] * hn[0] + hn[1] * hn[1] + hn[2] * hn[2] + hn[3] * hn[3];
                            an[n] = hn * gs[bj][n]; }
                        *(G1 u32x4v*)(ap + bj * 128) = pack8v(an[0], an[1]); }
                    ss += __shfl_xor(ss, 16); ss += __shfl_xor(ss, 32);
                    if (fq == 0) atomicAdd((float*)((G1 float*)ssq_ + row), ss); }
        }
    }
};
struct EpiP {
    static constexpr bool PERM = true, AFTER_DRAIN = false;
    static DEVI void apply(const f32x4 (&acc)[2][2][4][2], const pg8::Unit& u, int wr, int wc, int fr, int fq, bf16_t* Pp_, const float* epw, float* gates_, const float* gb_) {
        G1 bf16_t* Pp = (G1 bf16_t*)Pp_; G1 float* gates = (G1 float*)gates_; const G1 float* gb = (const G1 float*)gb_;
        const int row0 = u.pm * 256 + wr * 64 + fr, col0 = u.pn * 256 + wc * 32 + 8 * fq;
        if (u.pn < 12) {
            f32x4 sv[2][2];
#pragma unroll
            for (int bj = 0; bj < 2; ++bj)
#pragma unroll
                for (int n = 0; n < 2; ++n) sv[bj][n] = *(const f32x4*)(epw + 128 + bj * 32 + 8 * fq + 4 * n);
#pragma unroll
            for (int ai = 0; ai < 2; ++ai)
#pragma unroll
                for (int m = 0; m < 4; ++m) { const int row = row0 + ai * 128 + m * 16; G1 bf16_t* rowp = Pp + (size_t)row * NP + col0;
                    const float rstd = epw[(ai * 4 + m) * 16 + fr];
#pragma unroll
                    for (int bj = 0; bj < 2; ++bj) *(G1 u32x4v*)(rowp + bj * 128) = pack8v(acc[ai][bj][m][0] * rstd + sv[bj][0], acc[ai][bj][m][1] * rstd + sv[bj][1]); }
        } else if (wc == 0 && fq < 2) {
            f32x4 sv[2];
#pragma unroll
            for (int n = 0; n < 2; ++n) sv[n] = *(const f32x4*)(epw + 128 + 8 * fq + 4 * n) + *(const G1 f32x4*)(gb + 8 * fq + 4 * n);
#pragma unroll
            for (int ai = 0; ai < 2; ++ai)
#pragma unroll
                for (int m = 0; m < 4; ++m) { const int row = row0 + ai * 128 + m * 16;
                    const float rstd = epw[(ai * 4 + m) * 16 + fr];
#pragma unroll
                    for (int n = 0; n < 2; ++n) *(G1 f32x4*)(gates + (size_t)row * 16 + 8 * fq + 4 * n) = acc[ai][0][m][n] * rstd + sv[n]; }
        }
    }
};
template <class Epi> DEVI void run_gemm(unsigned char* smem, const bf16_t* A, const bf16_t* Bt, int Mrows, int N, int K, const Epi& E) {
    pg8::StaticOrder S; S.init(Mrows, N, (int)gridDim.x, opaque_bid());
    pg8::Gemm g; g.A = A; g.Bt = Bt; g.M = Mrows; g.N = N; g.K = K; g.ld = K;
    pg8::gemm_phase<Epi, pg8::StaticOrder, false>((LAS3 unsigned char*)(smem + 1024), g, S, E, nullptr);
}
template <class Epi> DEVI void run_gemm_split(unsigned char* smem, const bf16_t* A, const bf16_t* Bt, int nM, int nN, int K, int KP, const Epi& E) {
    pg8::SplitOrder S; S.init(nM, nN, K / KP, (int)gridDim.x, opaque_bid());
    pg8::Gemm g; g.A = A; g.Bt = Bt; g.M = nM * 256; g.N = nN * 256; g.K = KP; g.ld = K;
    pg8::gemm_phase<Epi, pg8::SplitOrder, false>((LAS3 unsigned char*)(smem + 1024), g, S, E, nullptr);
}
struct EpiResidCtxAtomic {
    static constexpr bool PERM = false, AFTER_DRAIN = false;
    static DEVI void apply(const f32x4 (&acc)[2][2][4][2], const pg8::Unit& u, int wr, int wc, int fr, int fq, float* hc, const float* gate, float fac) {
        const int row0 = u.pm * 256 + wr * 64 + fr, col0 = u.pn * 256 + wc * 32 + 4 * fq;
        const float* gp = gate + (size_t)8 * 9216 + col0;
#pragma unroll
        for (int bj = 0; bj < 2; ++bj)
#pragma unroll
            for (int n = 0; n < 2; ++n) { const f32x4 gv = *(const f32x4*)(gp + bj * 128 + n * 16) * fac;
                float* cp = hc + (size_t)row0 * D + col0 + bj * 128 + n * 16;
#pragma unroll
                for (int ai = 0; ai < 2; ++ai)
#pragma unroll
                    for (int m = 0; m < 4; ++m) { const f32x4 v = gv * acc[ai][bj][m][n]; float* q = cp + (size_t)(ai * 128 + m * 16) * D;
#pragma unroll
                        for (int i = 0; i < 4; ++i) unsafeAtomicAdd(q + i, v[i]); } }
    }
};


struct UniOrder {
    int mode; pg8::StaticOrder so; pg8::SplitOrder sp; int pm0, B0, R;
    DEVI bool next(int i, pg8::Unit& u) const {
        if (mode) return sp.next(i, u);
        const int G = so.G, c = so.c; long L;
        if (c < B0) L = (long)R * (G - B0) + (long)i * G + c;
        else L = i < R ? (long)i * (G - B0) + (c - B0) : (long)R * (G - B0) + (long)(i - R) * G + c;
        if (!so.at(L, u)) return false;
        u.pm += pm0; return true; }
    DEVI void a_ready(const pg8::Unit&) const {}
    DEVI void done(const pg8::Unit&) const {}
};
struct GemmJob { const bf16_t* A; const bf16_t* Bt; int nM, nN, nK, K, ld, order, epi, pm0, B0, R; bf16_t* obf; float* hl; float* hc; const float* gate; float fac; bf16_t* aout; const float* ng; const float* nscale; float* ssq; const float* Sb; float* gates; const float* gb; };
struct EpiParams { int mode; float fac; bf16_t* obf; float* hl; float* hc; const float* gate; bf16_t* aout; const float* ng; const float* nscale; float* ssq; const float* Sb; float* gates; const float* gb; };
struct UniEpi {
    static constexpr bool PERM = true, AFTER_DRAIN = false;
    const EpiParams* ep; unsigned char* smem;
    DEVI void operator()(const f32x4 (&acc)[2][2][4][2], const pg8::Unit& u, const pg8::Unit& nx, bool has_next, int wr, int wc, int fr, int fq) const {
        const int mode = __builtin_amdgcn_readfirstlane(ep->mode);
        if (mode == 1) { EpiResid::apply(acc, u, wr, wc, fr, fq, ep->hl, ep->hc, ep->gate, ep->fac, ep->aout, ep->ng, ep->nscale, ep->ssq); return; }
        const int wid = wr * 4 + wc, lane = fq * 16 + fr;
        const float* epw = (const float*)(smem + EPW_OFF + wid * EPW_STRIDE);
        float pf[3] = {1.f, 1.f, 0.f};
        if (has_next) epw_fill(smem, mode, nx, wid, lane, ep->ssq, ep->Sb, mode == 0 ? 5632 : NPG, pf);
        if (mode == 0) EpiSwiglu::apply(acc, u, wr, wc, fr, fq, ep->obf, epw);
        else EpiP::apply(acc, u, wr, wc, fr, fq, ep->obf, epw, ep->gates, ep->gb);
        if (has_next) epw_store(smem, wid, lane, pf);
    }
};
DEVI void run_job(unsigned char* smem, const GemmJob& J) {
    UniOrder S; S.mode = J.order; S.so.init(J.nM * 256, J.nN * 256, (int)gridDim.x, opaque_bid()); S.sp.init(J.nM, J.nN, J.nK, (int)gridDim.x, opaque_bid()); S.pm0 = J.pm0; S.B0 = J.B0; S.R = J.R;
    pg8::Gemm g; g.A = J.A; g.Bt = J.Bt; g.M = J.nM * 256; g.N = J.nN * 256; g.K = J.K; g.ld = J.ld;
    EpiParams* ep = (EpiParams*)(smem + 64);
    __syncthreads();
    if (opaque_tid() == 0) { ep->mode = J.epi; ep->fac = J.fac; ep->obf = J.obf; ep->hl = J.hl; ep->hc = J.hc; ep->gate = J.gate; ep->aout = J.aout; ep->ng = J.ng; ep->nscale = J.nscale; ep->ssq = J.ssq; ep->Sb = J.Sb; ep->gates = J.gates; ep->gb = J.gb; }
    __syncthreads();
    UniEpi E; E.ep = ep; E.smem = smem;
    if (J.epi != 1) { pg8::Unit u0; if (S.next(0, u0)) { const int tid_ = opaque_tid(); float pf[3]; epw_fill(smem, J.epi, u0, tid_ >> 6, tid_ & 63, J.ssq, J.Sb, J.epi == 0 ? 5632 : NPG, pf); epw_store(smem, tid_ >> 6, tid_ & 63, pf); } }
    pg8::gemm_phase<UniEpi, UniOrder, false>((LAS3 unsigned char*)(smem + 1024), g, S, E, nullptr);
}

DEVI int colmap(int type, int n) {
    if (type == 0) { const int pn = n >> 8, bj = (n >> 7) & 1, jj = n & 127; return bj * FF + pn * 128 + jj; }
    if (type == 2) return n < 1024 ? n : (n < 3072 ? n + 16 : (n < 3088 ? n - 3072 + 1024 : -1));
    return n;
}
DEVI void convert_tile(const float* __restrict__ src, int Nsrc, int K, int type, bf16_t* __restrict__ dst, int kt, int nt, float* lt) {
    const int tid = opaque_tid(), k0 = kt * 64, n0 = nt * 256;
    { const int nn = tid & 255, kk0 = tid >> 8; const int col = colmap(type, n0 + nn);
      const float* s = src + (size_t)k0 * Nsrc + (col < 0 ? 0 : col);
#pragma unroll 8
      for (int i = 0; i < 32; ++i) { const int kk = kk0 + 2 * i; const float v = s[(size_t)kk * Nsrc]; lt[nn * 65 + kk] = col < 0 ? 0.f : v; } }
    __syncthreads();
    { const int kp = (tid & 7) * 8, nn0 = tid >> 3;
#pragma unroll
      for (int i = 0; i < 4; ++i) { const int nn = nn0 + 64 * i; const float* lp = lt + nn * 65 + kp;
          uint4 o; o.x = pack2(lp[0], lp[1]); o.y = pack2(lp[2], lp[3]); o.z = pack2(lp[4], lp[5]); o.w = pack2(lp[6], lp[7]);
          *(uint4*)(dst + (size_t)(n0 + nn) * K + k0 + kp) = o; } }
    __syncthreads();
}

DEVI void filt_item(const Params& P, int l, int tile, float* lds) {
    const int tid = opaque_tid();
    const int Lsel = tile >= 32; const int L = Lsel ? CTX : SEQ; const int t0 = (Lsel ? tile - 32 : tile) * 64;
    float* feats = lds; float* h1 = lds + 64 * 33; float* h2 = h1 + 64 * 65;
#pragma unroll 1
    for (int idx = tid; idx < 64 * 33; idx += 512) { const int r = idx / 33, f = idx - r * 33; const int t = t0 + r; float v;
        if (f == 0) v = (float)t / (float)L;
        else { const int band = f <= 16 ? f : f - 16; const int x = (t * band) & (L - 1); const float ang = 6.283185307179586f * ((float)x / (float)L); v = f <= 16 ? cosf(ang) : sinf(ang); }
        feats[idx] = v; }
    __syncthreads();
    const float* w1 = P.in[18] + (size_t)l * 33 * 64; const float* b1 = P.in[19] + l * 64;
    const float* w2 = P.in[20] + (size_t)l * 64 * 64; const float* b2 = P.in[21] + l * 64;
    const float* w3 = P.in[22] + (size_t)l * 64 * 512; const float* b3 = P.in[23] + l * 512;
    { const int j = tid & 63, r0 = tid >> 6; float acc[8];
#pragma unroll
      for (int i = 0; i < 8; ++i) acc[i] = b1[j];
      for (int f = 0; f < 33; ++f) { const float w = w1[f * 64 + j];
#pragma unroll
          for (int i = 0; i < 8; ++i) acc[i] += feats[(r0 + 8 * i) * 33 + f] * w; }
#pragma unroll
      for (int i = 0; i < 8; ++i) h1[(r0 + 8 * i) * 65 + j] = acc[i]; }
    __syncthreads();
#pragma unroll 1
    for (int idx = tid; idx < 64 * 64; idx += 512) { const int a = (idx >> 6) * 65 + (idx & 63); h1[a] = sinf(h1[a]); }
    __syncthreads();
    { const int j = tid & 63, r0 = tid >> 6; float acc[8];
#pragma unroll
      for (int i = 0; i < 8; ++i) acc[i] = b2[j];
      for (int f = 0; f < 64; ++f) { const float w = w2[f * 64 + j];
#pragma unroll
          for (int i = 0; i < 8; ++i) acc[i] += h1[(r0 + 8 * i) * 65 + f] * w; }
#pragma unroll
      for (int i = 0; i < 8; ++i) h2[(r0 + 8 * i) * 65 + j] = acc[i]; }
    __syncthreads();
#pragma unroll 1
    for (int idx = tid; idx < 64 * 64; idx += 512) { const int a = (idx >> 6) * 65 + (idx & 63); h2[a] = sinf(h2[a]); }
    __syncthreads();
    { const int c = tid; const float bb = b3[c]; const int cc = c & 255;
      const float da = -3.0701134573253946f, db = -15.350567286626973f;
      const float delta = fabsf(da + (db - da) * ((float)cc / 255.f));
      float cs = 0.f;
      float* hf = (float*)(opaque_ws(P) + WS_HF) + (size_t)l * HF_LAYER + (Lsel ? (size_t)512 * SEQ : 0) + (size_t)c * L + t0;
#pragma unroll 1
      for (int rh = 0; rh < 4; ++rh) { float acc[16];
#pragma unroll
          for (int r = 0; r < 16; ++r) acc[r] = 0.f;
#pragma unroll 1
          for (int k = 0; k < 64; ++k) { const float w = w3[k * 512 + c];
#pragma unroll
              for (int r = 0; r < 16; ++r) acc[r] += h2[(rh * 16 + r) * 65 + k] * w; }
#pragma unroll
          for (int r = 0; r < 16; ++r) { const int t = t0 + rh * 16 + r; const float dist = fabsf((float)(t - L / 2)) / (float)(L / 2);
              const float v = (acc[r] + bb) * expf(-dist * delta); cs += fabsf(v); hf[rh * 16 + r] = v; } }
      ((float*)(opaque_ws(P) + WS_HFS))[((size_t)l * 36 + tile) * 512 + c] = cs; }
    __syncthreads();
}

DEVI void mod_item(const Params& P, int l, int chunk, float* lds) {
    const int tid = opaque_tid();
    float* sc = lds; float* red = lds + 9 * 1024;
    for (int idx = tid; idx < 9 * 1024; idx += 512) { const int r = idx >> 10, k = idx & 1023; const float v = r < 8 ? P.in[1][r * 1024 + k] : P.in[3][k]; sc[idx] = silu_prec(v); }
    __syncthreads();
    const int col = tid & 127, ks = tid >> 7; const int n = chunk * 128 + col;
    const float* w = P.in[4] + (size_t)l * 1024 * 9216 + (size_t)(ks * 256) * 9216 + n;
    float acc[9];
#pragma unroll
    for (int r = 0; r < 9; ++r) acc[r] = 0.f;
#pragma unroll 2
    for (int k = 0; k < 256; k += 4) { const float w0 = w[(size_t)k * 9216], w1 = w[(size_t)(k + 1) * 9216], w2 = w[(size_t)(k + 2) * 9216], w3 = w[(size_t)(k + 3) * 9216];
#pragma unroll
        for (int r = 0; r < 9; ++r) { const float4 s4 = *(const float4*)(sc + r * 1024 + ks * 256 + k); acc[r] += s4.x * w0 + s4.y * w1 + s4.z * w2 + s4.w * w3; } }
#pragma unroll
    for (int r = 0; r < 9; ++r) red[(ks * 9 + r) * 128 + col] = acc[r];
    __syncthreads();
    float* modout = (float*)(opaque_ws(P) + WS_MOD);
    for (int idx = tid; idx < 9 * 128; idx += 512) { const int r = idx >> 7, c = idx & 127;
        const float s = red[(0 * 9 + r) * 128 + c] + red[(1 * 9 + r) * 128 + c] + red[(2 * 9 + r) * 128 + c] + red[(3 * 9 + r) * 128 + c];
        modout[((size_t)l * 9 + r) * 9216 + chunk * 128 + c] = s + P.in[5][(size_t)l * 9216 + chunk * 128 + c]; }
    __syncthreads();
}

constexpr int N_FILT = DEPTH * 36, N_MODI = DEPTH * 72;
constexpr int CV_W13 = 16 * 22, CV_W2 = 44 * 4, CV_WIN = 16 * 13, CV_WOUT = 16 * 4;
constexpr int N_CV13 = DEPTH * 2 * CV_W13, N_CV2 = DEPTH * 2 * CV_W2, N_CVIN = DEPTH * CV_WIN, N_CVOUT = DEPTH * CV_WOUT;
constexpr int N_COPY = MT / 64, N_ROPE = 4, N_ZERO = 8, N_SB = DEPTH * 2 * 44, N_SBIN = DEPTH * 26;
constexpr int N_P0A = N_FILT + N_MODI + N_ROPE + N_ZERO + N_CV13 + N_CV2 + N_CVIN + N_CVOUT;
constexpr int N_P0B = N_SB + N_SBIN + N_COPY;

DEVI void sb_item(const Params& P, const float* W, int Nsrc, int type, const float* shiftp, float* out, int Nout, int chunk, float* lds) {
    const int tid = opaque_tid();
    float* sc = lds; float* red = lds + 9 * 1024;
    for (int idx = tid; idx < 9 * 1024; idx += 512) { const int r = idx >> 10, k = idx & 1023; sc[idx] = shiftp[(size_t)r * 9216 + k]; }
    __syncthreads();
    const int col = tid & 127, ks = tid >> 7; const int n = chunk * 128 + col; const int cm = colmap(type, n);
    const float* w = W + (size_t)(ks * 256) * Nsrc + (cm < 0 ? 0 : cm);
    float acc[9];
#pragma unroll
    for (int r = 0; r < 9; ++r) acc[r] = 0.f;
#pragma unroll 2
    for (int k = 0; k < 256; k += 4) { const float w0 = w[(size_t)k * Nsrc], w1 = w[(size_t)(k + 1) * Nsrc], w2 = w[(size_t)(k + 2) * Nsrc], w3 = w[(size_t)(k + 3) * Nsrc];
#pragma unroll
        for (int r = 0; r < 9; ++r) { const float4 s4 = *(const float4*)(sc + r * 1024 + ks * 256 + k); acc[r] += s4.x * w0 + s4.y * w1 + s4.z * w2 + s4.w * w3; } }
#pragma unroll
    for (int r = 0; r < 9; ++r) red[(ks * 9 + r) * 128 + col] = cm < 0 ? 0.f : acc[r];
    __syncthreads();
    for (int idx = tid; idx < 9 * 128; idx += 512) { const int r = idx >> 7, c = idx & 127;
        out[(size_t)r * Nout + chunk * 128 + c] = red[(0 * 9 + r) * 128 + c] + red[(1 * 9 + r) * 128 + c] + red[(2 * 9 + r) * 128 + c] + red[(3 * 9 + r) * 128 + c]; }
    __syncthreads();
}

DEVI void phase0a(const Params& P, unsigned char* smem) {
    const int tid = opaque_tid();
    float* lds = (float*)(smem + 1024);
    for (int it0 = opaque_bid(); it0 < N_P0A; it0 += gridDim.x) {
        int it = it0;
        if (it < N_FILT) { filt_item(P, it / 36, it % 36, lds); continue; } it -= N_FILT;
        if (it < N_MODI) { mod_item(P, it / 72, it % 72, lds); continue; } it -= N_MODI;
        if (it < N_ROPE) { const int t = it * 512 + tid; const int row = t >> 6, col = t & 63;
          float* rg = (float*)(opaque_ws(P) + WS_ROPEG) + (size_t)t * 64; float* rd = (float*)(opaque_ws(P) + WS_ROPED) + (size_t)t * 32;
          for (int j = 0; j < 16; ++j) { const float inv = expf(-(float)j / 16.f * 9.210340371976184f); const float ar = (float)row * inv, ac = (float)col * inv;
              rg[j] = cosf(ar); rg[16 + j] = cosf(ac); rg[32 + j] = sinf(ar); rg[48 + j] = sinf(ac); }
          for (int j = 0; j < 8; ++j) { const float inv = expf(-(float)j / 8.f * 9.210340371976184f); const float ar = (float)row * inv, ac = (float)col * inv;
              rd[j] = cosf(ar); rd[8 + j] = cosf(ac); rd[16 + j] = sinf(ar); rd[24 + j] = sinf(ac); }
          continue; } it -= N_ROPE;
        if (it < N_ZERO) { float* z = (float*)(opaque_ws(P) + WS_SSQ); const int n = DEPTH * 3 * MT; for (int i = it * 512 + tid; i < n; i += N_ZERO * 512) z[i] = 0.f; continue; } it -= N_ZERO;
        if (it < N_CV13) { const int lf = it / CV_W13, r = it % CV_W13; convert_tile(P.in[7] + (size_t)lf * 1024 * 5632, 5632, 1024, 0, (bf16_t*)(opaque_ws(P) + WS_W13) + (size_t)lf * 5632 * 1024, r / 22, r % 22, lds); continue; } it -= N_CV13;
        if (it < N_CV2) { const int lf = it / CV_W2, r = it % CV_W2; convert_tile(P.in[8] + (size_t)lf * 2816 * 1024, 1024, 2816, 1, (bf16_t*)(opaque_ws(P) + WS_W2) + (size_t)lf * 1024 * 2816, r / 4, r % 4, lds); continue; } it -= N_CV2;
        if (it < N_CVIN) { const int l = it / CV_WIN, r = it % CV_WIN; convert_tile(P.in[9] + (size_t)l * 1024 * NIN, NIN, 1024, 2, (bf16_t*)(opaque_ws(P) + WS_WIN) + (size_t)l * NPG * 1024, r / 13, r % 13, lds); continue; } it -= N_CVIN;
        if (it < N_CVOUT) { const int l = it / CV_WOUT, r = it % CV_WOUT; convert_tile(P.in[10] + (size_t)l * 1024 * 1024, 1024, 1024, 1, (bf16_t*)(opaque_ws(P) + WS_WOUT) + (size_t)l * 1024 * 1024, r / 4, r % 4, lds); continue; }
    }
}
DEVI void phase0b(const Params& P, unsigned char* smem) {
    const int tid = opaque_tid();
    float* lds = (float*)(smem + 1024);
    for (int it0 = opaque_bid(); it0 < N_P0B; it0 += gridDim.x) {
        int it = it0;
        if (it < N_SB) { const int lf = it / 44; const int l = lf >> 1, f = lf & 1;
            sb_item(P, P.in[7] + (size_t)lf * 1024 * 5632, 5632, 0, (const float*)(opaque_ws(P) + WS_MOD) + (size_t)l * 9 * 9216 + (f ? 6 : 0) * 1024, (float*)(opaque_ws(P) + WS_SB) + (size_t)lf * 9 * 5632, 5632, it % 44, lds); continue; } it -= N_SB;
        if (it < N_SBIN) { const int l = it / 26;
            sb_item(P, P.in[9] + (size_t)l * 1024 * NIN, NIN, 2, (const float*)(opaque_ws(P) + WS_MOD) + (size_t)l * 9 * 9216 + 3 * 1024, (float*)(opaque_ws(P) + WS_SBIN) + (size_t)l * 9 * NPG, NPG, it % 26, lds); continue; } it -= N_SBIN;
        {
            const int lane = tid & 63, wid = tid >> 6;
            float* hctx = (float*)(opaque_ws(P) + WS_HCTX); bf16_t* A = (bf16_t*)(opaque_ws(P) + WS_A); float* ssq = (float*)(opaque_ws(P) + WS_SSQ);
            const float* g = P.in[6]; const float* modl = (const float*)(opaque_ws(P) + WS_MOD);
#pragma unroll 2
            for (int rr = 0; rr < 8; ++rr) { const int row = it * 64 + wid * 8 + rr;
                const float* sp = row < MLAT ? P.in[0] + (size_t)row * D : P.in[2] + (size_t)(row - MLAT) * D;
                float* dp = row < MLAT ? P.out + (size_t)row * D : hctx + (size_t)(row - MLAT) * D;
                const int r9 = row < MLAT ? (row >> 11) : 8; const float* scl = modl + (size_t)r9 * 9216 + 1024;
                float ss = 0.f;
#pragma unroll
                for (int j = 0; j < 4; ++j) { const int col = 4 * lane + 256 * j; const float4 x = *(const float4*)(sp + col); *(float4*)(dp + col) = x;
                    ss += x.x * x.x + x.y * x.y + x.z * x.z + x.w * x.w;
                    const float4 g4 = *(const float4*)(g + col), s4 = *(const float4*)(scl + col);
                    uint2 o; o.x = pack2(x.x * g4.x * (1.f + s4.x), x.y * g4.y * (1.f + s4.y)); o.y = pack2(x.z * g4.z * (1.f + s4.z), x.w * g4.w * (1.f + s4.w));
                    *(uint2*)(A + (size_t)row * D + col) = o; }
                ss = wave_sum(ss);
                if (lane == 0) ssq[row] = ss; }
        }
    }
}

template <bool GATES> DEVI void norm_phase(const Params& P, int l, int which, unsigned char* smem) {
    const int tid = opaque_tid(), lane = tid & 63, wid = tid >> 6;
    const float* g = P.in[6] + (size_t)(l * 3 + which) * 1024;
    const float* modl = (const float*)(opaque_ws(P) + WS_MOD) + (size_t)l * 9 * 9216;
    const float* hctx = (const float*)(opaque_ws(P) + WS_HCTX);
    bf16_t* A = (bf16_t*)(opaque_ws(P) + WS_A);
    float* WgT = (float*)(smem + 1024);
    if (GATES) { const float* win = P.in[9] + (size_t)l * 1024 * NIN;
        for (int idx = tid; idx < 16384; idx += 512) { const int k = idx >> 4, jj = idx & 15; WgT[jj * 1024 + k] = win[(size_t)k * NIN + 1024 + jj]; }
        __syncthreads(); }
    float4 gv[4];
#pragma unroll
    for (int j = 0; j < 4; ++j) gv[j] = *(const float4*)(g + 4 * lane + 256 * j);
    for (int row = opaque_bid() * 8 + wid; row < MT; row += gridDim.x * 8) {
        const float* hp = row < MLAT ? P.out + (size_t)row * D : hctx + (size_t)(row - MLAT) * D;
        const int r9 = row < MLAT ? (row >> 11) : 8;
        const float* sh = modl + (size_t)r9 * 9216 + (3 * which) * 1024; const float* scl = sh + 1024;
        float4 x[4]; float ss = 0.f;
#pragma unroll
        for (int j = 0; j < 4; ++j) { x[j] = *(const float4*)(hp + 4 * lane + 256 * j); ss += x[j].x * x[j].x + x[j].y * x[j].y + x[j].z * x[j].z + x[j].w * x[j].w; }
        ss = wave_sum(ss);
        const float rstd = rsqrtf(ss * (1.f / 1024.f) + 1e-6f);
        float ga[16];
        if (GATES) {
#pragma unroll
            for (int jj = 0; jj < 16; ++jj) ga[jj] = 0.f; }
#pragma unroll
        for (int j = 0; j < 4; ++j) { const int col = 4 * lane + 256 * j;
            const float4 s4 = *(const float4*)(scl + col), h4 = *(const float4*)(sh + col);
            float4 y;
            y.x = x[j].x * rstd * gv[j].x * (1.f + s4.x) + h4.x; y.y = x[j].y * rstd * gv[j].y * (1.f + s4.y) + h4.y;
            y.z = x[j].z * rstd * gv[j].z * (1.f + s4.z) + h4.z; y.w = x[j].w * rstd * gv[j].w * (1.f + s4.w) + h4.w;
            uint2 o; o.x = pack2(y.x, y.y); o.y = pack2(y.z, y.w);
            *(uint2*)(A + (size_t)row * D + col) = o;
            if (GATES) {
#pragma unroll
                for (int jj = 0; jj < 16; ++jj) { const float4 w = *(const float4*)(WgT + jj * 1024 + col); ga[jj] += y.x * w.x + y.y * w.y + y.z * w.z + y.w * w.w; } } }
        if (GATES) { float outv = 0.f;
#pragma unroll
            for (int jj = 0; jj < 16; ++jj) { const float t = wave_sum(ga[jj]); if (lane == jj) outv = t; }
            if (lane < 16) ((float*)(opaque_ws(P) + WS_GATES))[(size_t)row * 16 + lane] = outv + P.in[11][l * 16 + lane]; }
    }
}

template <int LEN> DEVI void prep_seg(const bf16_t* __restrict__ src, const float* __restrict__ g, const float* __restrict__ rope, float scale, bf16_t* __restrict__ dst) {
    float x[LEN];
#pragma unroll
    for (int i = 0; i < LEN / 8; ++i) { const uint4 v = *(const uint4*)(src + 8 * i);
        x[8 * i + 0] = bflo(v.x); x[8 * i + 1] = bfhi(v.x); x[8 * i + 2] = bflo(v.y); x[8 * i + 3] = bfhi(v.y);
        x[8 * i + 4] = bflo(v.z); x[8 * i + 5] = bfhi(v.z); x[8 * i + 6] = bflo(v.w); x[8 * i + 7] = bfhi(v.w); }
    float ss = 0.f;
#pragma unroll
    for (int i = 0; i < LEN; ++i) ss += x[i] * x[i];
    const float rstd = rsqrtf(ss * (1.f / LEN) + 1e-6f);
#pragma unroll
    for (int i = 0; i < LEN / 4; ++i) { const float4 g4 = *(const float4*)(g + 4 * i);
        x[4 * i] *= rstd * g4.x; x[4 * i + 1] *= rstd * g4.y; x[4 * i + 2] *= rstd * g4.z; x[4 * i + 3] *= rstd * g4.w; }
    if (rope) {
#pragma unroll
        for (int j4 = 0; j4 < LEN / 8; ++j4) { const float4 c4 = *(const float4*)(rope + 4 * j4), s4 = *(const float4*)(rope + LEN / 2 + 4 * j4);
            const float cc[4] = {c4.x, c4.y, c4.z, c4.w}, sn[4] = {s4.x, s4.y, s4.z, s4.w};
#pragma unroll
            for (int e = 0; e < 4; ++e) { const int j = 4 * j4 + e; const float a = x[j], b = x[j + LEN / 2]; x[j] = a * cc[e] - b * sn[e]; x[j + LEN / 2] = a * sn[e] + b * cc[e]; } } }
#pragma unroll
    for (int i = 0; i < LEN / 8; ++i) { uint4 o;
        o.x = pack2(x[8 * i + 0] * scale, x[8 * i + 1] * scale); o.y = pack2(x[8 * i + 2] * scale, x[8 * i + 3] * scale);
        o.z = pack2(x[8 * i + 4] * scale, x[8 * i + 5] * scale); o.w = pack2(x[8 * i + 6] * scale, x[8 * i + 7] * scale);
        *(uint4*)(dst + 8 * i) = o; }
}
DEVI void unpack8(const uint4 v, float (&x)[8]) { x[0] = bflo(v.x); x[1] = bfhi(v.x); x[2] = bflo(v.y); x[3] = bfhi(v.y); x[4] = bflo(v.z); x[5] = bfhi(v.z); x[6] = bflo(v.w); x[7] = bfhi(v.w); }

DEVI void prep_phase(const Params& P, int l, unsigned char* smem) {
    const int tid = opaque_tid();
    const bf16_t* p = (const bf16_t*)(opaque_ws(P) + WS_P);
    bf16_t* Qb = (bf16_t*)(opaque_ws(P) + WS_Q); bf16_t* Kb = (bf16_t*)(opaque_ws(P) + WS_K); bf16_t* VT = (bf16_t*)(opaque_ws(P) + WS_VT);
    bf16_t* mlqk = (bf16_t*)(opaque_ws(P) + WS_MLQK); bf16_t* hyu = (bf16_t*)(opaque_ws(P) + WS_HYU);
    const float* ropeG = (const float*)(opaque_ws(P) + WS_ROPEG); const float* ropeD = (const float*)(opaque_ws(P) + WS_ROPED);
    const float* gqa_g = P.in[15] + l * 128; const float* diff_g = P.in[25] + l * 64;
    bf16_t* lt = (bf16_t*)(smem + 1024);
    constexpr int TR = 16, LS = TR + 8;
    for (int rt = opaque_bid(); rt < MT / TR; rt += gridDim.x) {
        const int row0 = rt * TR; const bool isctx = row0 >= MLAT;
        int b, t0, Ls;
        if (!isctx) { b = row0 >> 11; t0 = row0 & 2047; Ls = SEQ; } else { const int rc = row0 - MLAT; b = rc >> 8; t0 = rc & 255; Ls = CTX; }
        const int pp0 = isctx ? t0 : CTX + t0;
        for (int task = tid; task < TR * 22; task += 512) {
            if (task < TR * 6) { const int seg = task % 6, r = task / 6;
                const int srccol = seg < 4 ? 1024 + 64 * seg : 1280 + 64 * (seg - 4);
                const float* g = gqa_g + (seg < 4 ? 0 : 64); const float scale = seg < 4 ? 0.125f * LOG2E : 1.f;
                bf16_t* dst = seg < 4 ? Qb + (((size_t)b * 8 + seg) * KEYS + pp0 + r) * 64 : Kb + (((size_t)b * 6 + (seg - 4)) * KEYS + pp0 + r) * 64;
                const float* rope = isctx ? nullptr : ropeG + (size_t)(t0 + r) * 64;
                prep_seg<64>(p + (size_t)(row0 + r) * NP + srccol, g, rope, scale, dst);
            } else { const int tt = task - TR * 6; const int seg = tt & 15, r = tt >> 4; const int isk = seg >> 3, hh = (seg >> 1) & 3, s = seg & 1;
                const int srccol = (isk ? 2560 : 2304) + 64 * hh + 32 * s;
                const float* g = diff_g + isk * 32; const float scale = isk ? 1.f : 0.17677669529663687f * LOG2E;
                bf16_t* dst = isk ? Kb + (((size_t)b * 6 + 2 + hh) * KEYS + pp0 + r) * 64 + 32 * s : Qb + (((size_t)b * 8 + 4 + hh) * KEYS + pp0 + r) * 64 + 32 * s;
                const float* rope = isctx ? nullptr : ropeD + (size_t)(t0 + r) * 32;
                prep_seg<32>(p + (size_t)(row0 + r) * NP + srccol, g, rope, scale, dst);
            }
        }
        { const float* cw = P.in[12] + (size_t)l * 3 * 512; const float* cb = P.in[13] + (size_t)l * 512;
          for (int task = tid; task < TR * 64; task += 512) { const int cg8 = task & 63, r = task >> 6; const int c0 = cg8 * 8; const int t = t0 + r;
              const bf16_t* pr = p + (size_t)(row0 + r) * NP + c0;
              float xm[8], x0[8], xp[8];
              unpack8(*(const uint4*)pr, x0);
              if (t > 0) unpack8(*(const uint4*)(pr - NP), xm); else {
#pragma unroll
                  for (int i = 0; i < 8; ++i) xm[i] = 0.f; }
              if (t < Ls - 1) unpack8(*(const uint4*)(pr + NP), xp); else {
#pragma unroll
                  for (int i = 0; i < 8; ++i) xp[i] = 0.f; }
              const float sc = c0 < 256 ? 0.125f : 1.f;
              float y[8];
#pragma unroll
              for (int i = 0; i < 8; ++i) { const float v = cw[c0 + i] * xm[i] + cw[512 + c0 + i] * x0[i] + cw[1024 + c0 + i] * xp[i] + cb[c0 + i]; y[i] = silu_fast(v) * sc; }
              uint4 o4; o4.x = pack2(y[0], y[1]); o4.y = pack2(y[2], y[3]); o4.z = pack2(y[4], y[5]); o4.w = pack2(y[6], y[7]);
              *(uint4*)(mlqk + (size_t)(row0 + r) * 512 + c0) = o4; } }
        for (int task = tid; task < TR * 48; task += 512) { const int r = task & (TR - 1), ch = task / TR;
            const int srccol = ch < 16 ? 1408 + ch * 8 : 2816 + (ch - 16) * 8;
            const uint4 v = *(const uint4*)(p + (size_t)(row0 + r) * NP + srccol);
            bf16_t* d = lt + (size_t)(ch * 8) * LS + r;
            d[0] = (bf16_t)(v.x & 0xffff); d[LS] = (bf16_t)(v.x >> 16); d[2 * LS] = (bf16_t)(v.y & 0xffff); d[3 * LS] = (bf16_t)(v.y >> 16);
            d[4 * LS] = (bf16_t)(v.z & 0xffff); d[5 * LS] = (bf16_t)(v.z >> 16); d[6 * LS] = (bf16_t)(v.w & 0xffff); d[7 * LS] = (bf16_t)(v.w >> 16); }
        __syncthreads();
        static_assert(TR == 16, "V^T key permutation below assumes 16-row tiles");
        for (int task = tid; task < 384 * 2; task += 512) { const int dd = task >> 1, ch = task & 1; const int slot = dd >> 6, d = dd & 63;
            const uint4 v = *(const uint4*)(lt + (size_t)dd * LS + ch * 8);
            bf16_t* dst = VT + (((size_t)b * 6 + slot) * 64 + d) * KEYS + (pp0 & ~31) + ((pp0 >> 4) & 1) * 4;
            *(uint2*)(dst + (2 * ch) * 8) = make_uint2(v.x, v.y); *(uint2*)(dst + (2 * ch + 1) * 8) = make_uint2(v.z, v.w); }
        __syncthreads();
        { const float* cw = P.in[16] + (size_t)l * 3 * 768; const float* cb = P.in[17] + (size_t)l * 768;
          for (int task = tid; task < TR * 96; task += 512) { const int r = task & (TR - 1), ch = task / TR; const int c0 = ch * 8; const int t = t0 + r;
              const bf16_t* pr = p + (size_t)(row0 + r) * NP + 1536 + c0;
              float xm[8], x0[8], xp[8];
              unpack8(*(const uint4*)pr, x0);
              if (t > 0) unpack8(*(const uint4*)(pr - NP), xm); else {
#pragma unroll
                  for (int i = 0; i < 8; ++i) xm[i] = 0.f; }
              if (t < Ls - 1) unpack8(*(const uint4*)(pr + NP), xp); else {
#pragma unroll
                  for (int i = 0; i < 8; ++i) xp[i] = 0.f; }
              bf16_t* d = lt + (size_t)c0 * LS + r;
#pragma unroll
              for (int i = 0; i < 8; ++i) { const float v = cw[c0 + i] * xm[i] + cw[768 + c0 + i] * x0[i] + cw[1536 + c0 + i] * xp[i] + cb[c0 + i]; d[i * LS] = f2bf(v); } } }
        __syncthreads();
        for (int task = tid; task < 768 * (TR / 8); task += 512) { const int cc = task / (TR / 8), ch = task % (TR / 8);
            *(uint4*)(hyu + (size_t)cc * MT + row0 + ch * 8) = *(const uint4*)(lt + (size_t)cc * LS + ch * 8); }
        __syncthreads();
    }
}

template <bool DIFF> DEVI void attn_item(const Params& P, int l, int b, int hsel, int qb, bool isctx, unsigned char* smem) {
    const int tid = opaque_tid(), lane = tid & 63, wid = tid >> 6, fr = lane & 15, quad = lane >> 4;
    bf16_t* Ks0 = (bf16_t*)(smem + 1024); bf16_t* Vs0 = Ks0 + 2 * 64 * 72;
    const int nkt = (isctx ? CTX : KEYS) / 64;
    const int pq0 = (isctx ? 0 : CTX) + qb * 128 + wid * 16;
    const int slotk = DIFF ? 2 + hsel : hsel;
    const bf16_t* Kg = (const bf16_t*)(opaque_ws(P) + WS_K) + ((size_t)b * 6 + slotk) * KEYS * 64;
    const bf16_t* Vg = (const bf16_t*)(opaque_ws(P) + WS_VT) + ((size_t)b * 6 + slotk) * 64 * KEYS;
    const bf16_t* Qg = (const bf16_t*)(opaque_ws(P) + WS_Q);
    bf16x8 q[2][2];
#pragma unroll
    for (int s = 0; s < 2; ++s) { const int slotq = DIFF ? 4 + hsel : 2 * hsel + s;
        const bf16_t* qp = Qg + (((size_t)b * 8 + slotq) * KEYS + pq0 + fr) * 64 + quad * 8;
        q[s][0] = *(const bf16x8*)qp; q[s][1] = *(const bf16x8*)(qp + 32); }
    float M2;
    { const float* g = DIFF ? P.in[25] + l * 64 : P.in[15] + l * 128; const int n = DIFF ? 32 : 64;
      float a = lane < n ? fabsf(g[lane]) : 0.f, bb = lane < n ? fabsf(g[n + lane]) : 0.f; a = wave_max(a); bb = wave_max(bb);
      M2 = sqrtf((float)n) * a * bb * LOG2E; }
    f32x4 O[2][5];
#pragma unroll
    for (int s = 0; s < 2; ++s)
#pragma unroll
        for (int d = 0; d < 5; ++d) O[s][d] = (f32x4){0.f, 0.f, 0.f, 0.f};
    const f32x4 minit = (f32x4){-M2, -M2, -M2, -M2};
    const int lrow = tid >> 3, lch = (tid & 7) * 8;
    const bf16_t* kgp = Kg + (size_t)lrow * 64 + lch; const bf16_t* vgp = Vg + (size_t)lrow * KEYS + lch;
#define LDK(t) (*(const uint4*)(kgp + (size_t)(t) * 64 * 64))
#define LDV(t) (*(const uint4*)(vgp + (size_t)(t) * 64))
    uint4 k0r = LDK(0), v0r = LDV(0), k1r = k0r, v1r = v0r;
    constexpr int KSZ = 64 * 72, VSZ = 80 * 72;
    __syncthreads();
    *(uint4*)(Ks0 + lrow * 72 + lch) = k0r; *(uint4*)(Vs0 + lrow * 72 + lch) = v0r;
    if (nkt > 1) { k0r = LDK(1); v0r = LDV(1); }
    if (nkt > 2) { k1r = LDK(2); v1r = LDV(2); }
    __syncthreads();
    f32x4 S[2][4]; bf16x8 pbp[2][2];
    bf16x8 vones;
#pragma unroll
    for (int i = 0; i < 8; ++i) vones[i] = (short)0x3F80;
#define ATT_QK(KS) do { _Pragma("unroll") for (int ks = 0; ks < 4; ++ks) { const bf16_t* kp = (KS) + (ks * 16 + fr) * 72 + quad * 8; \
            const bf16x8 k0 = *(const bf16x8*)kp, k1 = *(const bf16x8*)(kp + 32); \
            if (!DIFF) { S[0][ks] = mfma16(k0, q[0][0], minit); S[1][ks] = mfma16(k0, q[1][0], minit); S[0][ks] = mfma16(k1, q[0][1], S[0][ks]); S[1][ks] = mfma16(k1, q[1][1], S[1][ks]); } \
            else { S[0][ks] = mfma16(k0, q[0][0], minit); S[1][ks] = mfma16(k1, q[0][1], minit); } } } while (0)
#define ATT_EXP(PB) do { _Pragma("unroll") for (int s = 0; s < 2; ++s) _Pragma("unroll") for (int kk = 0; kk < 2; ++kk) { float pv[8]; \
            _Pragma("unroll") for (int i = 0; i < 4; ++i) { pv[i] = __builtin_amdgcn_exp2f(S[s][2 * kk][i]); pv[4 + i] = __builtin_amdgcn_exp2f(S[s][2 * kk + 1][i]); } \
            union { uint4 u; bf16x8 v; } cv; cv.u.x = pack2(pv[0], pv[1]); cv.u.y = pack2(pv[2], pv[3]); cv.u.z = pack2(pv[4], pv[5]); cv.u.w = pack2(pv[6], pv[7]); \
            PB[s][kk] = cv.v; } } while (0)
#define ATT_PV(VS, PB) do { _Pragma("unroll") for (int ds = 0; ds < 5; ++ds) _Pragma("unroll") for (int kk = 0; kk < 2; ++kk) { const bf16x8 vf = ds < 4 ? *(const bf16x8*)((VS) + (ds * 16 + fr) * 72 + kk * 32 + quad * 8) : vones; \
            O[0][ds] = mfma16(vf, PB[0][kk], O[0][ds]); O[1][ds] = mfma16(vf, PB[1][kk], O[1][ds]); } } while (0)
#define ATT_NEXT(kt, VN) do { if ((kt) + 1 < nkt) { bf16_t* Kn = Ks0 + (((kt) + 1) & 1) * KSZ; bf16_t* Vn = Vs0 + (VN) * VSZ; \
            if (((kt) & 1) == 0) { *(uint4*)(Kn + lrow * 72 + lch) = k0r; *(uint4*)(Vn + lrow * 72 + lch) = v0r; if ((kt) + 3 < nkt) { k0r = LDK((kt) + 3); v0r = LDV((kt) + 3); } } \
            else { *(uint4*)(Kn + lrow * 72 + lch) = k1r; *(uint4*)(Vn + lrow * 72 + lch) = v1r; if ((kt) + 3 < nkt) { k1r = LDK((kt) + 3); v1r = LDV((kt) + 3); } } } } while (0)
    ATT_QK(Ks0); ATT_EXP(pbp); ATT_NEXT(0, 1);
    __syncthreads();
    int vprev = 0, vcur = 1, vnext = 2;
    for (int kt = 1; kt < nkt; ++kt) {
        ATT_QK(Ks0 + (kt & 1) * KSZ);
        bf16x8 pb[2][2];
        ATT_PV(Vs0 + vprev * VSZ, pbp);
        ATT_EXP(pb);
#pragma unroll
        for (int s = 0; s < 2; ++s)
#pragma unroll
            for (int kk = 0; kk < 2; ++kk) pbp[s][kk] = pb[s][kk];
        ATT_NEXT(kt, vnext);
        __syncthreads();
        const int t_ = vprev; vprev = vcur; vcur = vnext; vnext = t_;
    }
    ATT_PV(Vs0 + vprev * VSZ, pbp);
#undef ATT_QK
#undef ATT_EXP
#undef ATT_PV
#undef ATT_NEXT
    float lsum[2];
#pragma unroll
    for (int s = 0; s < 2; ++s) lsum[s] = __shfl(O[s][4][0], fr);
    const int pp = pq0 + fr;
    const size_t row = pp < CTX ? (size_t)MLAT + b * CTX + pp : (size_t)b * SEQ + (pp - CTX);
    bf16_t* cat = (bf16_t*)(opaque_ws(P) + WS_CAT);
    if (!DIFF) {
#pragma unroll
        for (int s = 0; s < 2; ++s) { const float inv = 1.f / lsum[s]; bf16_t* op = cat + row * D + 256 + (2 * hsel + s) * 64 + quad * 4;
#pragma unroll
            for (int ds = 0; ds < 4; ++ds) *(uint2*)(op + ds * 16) = pack4(O[s][ds] * inv); }
    } else {
        const float* lp = P.in[26] + l * 128;
        float a = lane < 32 ? lp[lane] * lp[32 + lane] : 0.f, c = lane < 32 ? lp[64 + lane] * lp[96 + lane] : 0.f; a = wave_sum(a); c = wave_sum(c);
        const float lam_init = 0.8f - 0.6f * expf(-0.3f * (float)l);
        const float lam = expf(a) - expf(c) + lam_init;
        const float i0 = 1.f / lsum[0], i1 = lam / lsum[1];
        f32x4 o[4]; float ss = 0.f;
#pragma unroll
        for (int ds = 0; ds < 4; ++ds) { o[ds] = O[0][ds] * i0 - O[1][ds] * i1; ss += o[ds][0] * o[ds][0] + o[ds][1] * o[ds][1] + o[ds][2] * o[ds][2] + o[ds][3] * o[ds][3]; }
        ss += __shfl_xor(ss, 16); ss += __shfl_xor(ss, 32);
        const float fac = rsqrtf(ss * (1.f / 64.f) + 1e-6f) * (1.f - lam_init);
        const float* sg = P.in[27] + l * 64;
        bf16_t* op = cat + row * D + 768 + hsel * 64 + quad * 4;
#pragma unroll
        for (int ds = 0; ds < 4; ++ds) { const f32x4 gg = *(const f32x4*)(sg + ds * 16 + quad * 4); *(uint2*)(op + ds * 16) = pack4(o[ds] * gg * fac); }
    }
}

#undef LDK
#undef LDV
DEVI void hy_build_E(const float* hs, float norm, int L, bf16_t* E, int NG) {
    const int lo = L / 2, hi = 3 * L / 2 - 1;
    for (int idx = opaque_tid(); idx < 8 * NG; idx += 512) { const int r = idx / NG, m = idx - r * NG; const int i0 = 8 * m + r;
        float v[8];
#pragma unroll
        for (int e = 0; e < 8; ++e) { const int i = i0 + e; v[e] = (i >= lo && i <= hi) ? hs[hi - i] * norm : 0.f; }
        uint4 o; o.x = pack2(v[0], v[1]); o.y = pack2(v[2], v[3]); o.z = pack2(v[4], v[5]); o.w = pack2(v[6], v[7]);
        *(uint4*)(E + ((size_t)r * NG + m) * 8) = o; }
}
template <int NT> DEVI void hy_conv_chain(const bf16_t* E, int NG, const bf16_t* Us, int ustride, int L, int tbase, int fr, int quad, f32x4 (&acc)[NT]) {
    int jlo = tbase - L / 2 + 1; jlo = jlo < 0 ? 0 : (jlo & ~31);
    int jhi = (tbase + 32 * (NT - 1) + 16 + L / 2 + 31) & ~31; jhi = jhi > L ? L : jhi;
    const bf16_t* Er = E + (size_t)(7 - (fr & 7)) * NG * 8;
    const bf16_t* ub = Us + (fr & 7) * ustride + quad * 8;
    const int ob = quad * 8 - tbase - fr + L - 1;
    bf16x8 F[NT];
#pragma unroll
    for (int i = 0; i < NT; ++i) { acc[i] = (f32x4){0.f, 0.f, 0.f, 0.f}; F[i] = *(const bf16x8*)(Er + (size_t)((jlo + ob - 32 * i) >> 3) * 8); }
    for (int jb = jlo; jb < jhi; jb += 32) {
        const bf16x8 bv = *(const bf16x8*)(ub + jb);
        bf16x8 Fn = F[0];
        if (jb + 32 < jhi) Fn = *(const bf16x8*)(Er + (size_t)((jb + 32 + ob) >> 3) * 8);
#pragma unroll
        for (int i = 0; i < NT; ++i) acc[i] = mfma16(F[i], bv, acc[i]);
#pragma unroll
        for (int i = NT - 1; i > 0; --i) F[i] = F[i - 1];
        F[0] = Fn;
    }
}
template <int NT> DEVI void hy_item(const Params& P, int l, int c, unsigned char* smem) {
    constexpr int Lsel = (NT == 2) ? 1 : 0;
    constexpr int L = Lsel ? CTX : SEQ; constexpr int NG = L / 4 + 2; constexpr int ustride = L + 8;
    const int tid = opaque_tid(), lane = tid & 63, wid = tid >> 6, fr = lane & 15, quad = lane >> 4;
    bf16_t* E = (bf16_t*)(smem + 1024); bf16_t* Us = E + (size_t)8 * NG * 8; bf16_t* Zs = Us + 8 * ustride;
    const float* hfs = (const float*)(opaque_ws(P) + WS_HFS) + (size_t)l * 36 * 512;
    float s0 = 0.f, s1 = 0.f;
    { const int tlo = Lsel ? 32 : 0, thi = Lsel ? 36 : 32; for (int t = tlo; t < thi; ++t) { s0 += hfs[t * 512 + c]; s1 += hfs[t * 512 + 256 + c]; } }
    const float* hf = (const float*)(opaque_ws(P) + WS_HF) + (size_t)l * HF_LAYER + (Lsel ? (size_t)512 * SEQ : 0);
    const bf16_t* hyu = (const bf16_t*)(opaque_ws(P) + WS_HYU); bf16_t* hyo = (bf16_t*)(opaque_ws(P) + WS_HYO);
    { float* hs = (float*)Zs; const float* src = hf + (size_t)c * L; for (int i = tid; i < L / 4; i += 512) *(float4*)(hs + 4 * i) = *(const float4*)(src + 4 * i); }
    { constexpr int nch = L / 8; for (int idx = tid; idx < 8 * nch; idx += 512) { const int bb = idx / nch, ch = idx - bb * nch;
          const size_t base = Lsel ? (size_t)MLAT + bb * CTX : (size_t)bb * SEQ;
          *(uint4*)(Us + bb * ustride + ch * 8) = *(const uint4*)(hyu + (size_t)c * MT + base + ch * 8); } }
    __syncthreads();
    hy_build_E((const float*)Zs, 1.f / s0, L, E, NG);
    __syncthreads();
    const float sk0 = P.in[24][(size_t)l * 512 + c], sk1 = P.in[24][(size_t)l * 512 + 256 + c];
    const size_t baseb = Lsel ? (size_t)MLAT + (fr & 7) * CTX : (size_t)(fr & 7) * SEQ;
    const int tbase = 16 * (wid & 1) + 32 * NT * (wid >> 1);
    f32x4 acc[NT];
    hy_conv_chain<NT>(E, NG, Us, ustride, L, tbase, fr, quad, acc);
    if (fr < 8) {
#pragma unroll
        for (int i = 0; i < NT; ++i) { const int t = tbase + 32 * i + quad * 4;
            const uint2 v4 = *(const uint2*)(Us + fr * ustride + t); const uint2 x4 = *(const uint2*)(hyu + (size_t)(256 + c) * MT + baseb + t);
            f32x4 z; z[0] = bflo(x4.x) * (acc[i][0] + sk0 * bflo(v4.x)); z[1] = bfhi(x4.x) * (acc[i][1] + sk0 * bfhi(v4.x));
            z[2] = bflo(x4.y) * (acc[i][2] + sk0 * bflo(v4.y)); z[3] = bfhi(x4.y) * (acc[i][3] + sk0 * bfhi(v4.y));
            *(uint2*)(Zs + fr * ustride + t) = pack4(z); } }
    __syncthreads();
    { float* hs = (float*)Us; const float* src = hf + (size_t)(256 + c) * L; for (int i = tid; i < L / 4; i += 512) *(float4*)(hs + 4 * i) = *(const float4*)(src + 4 * i); }
    __syncthreads();
    hy_build_E((const float*)Us, 1.f / s1, L, E, NG);
    __syncthreads();
    hy_conv_chain<NT>(E, NG, Zs, ustride, L, tbase, fr, quad, acc);
    if (fr < 8) {
#pragma unroll
        for (int i = 0; i < NT; ++i) { const int t = tbase + 32 * i + quad * 4;
            const uint2 v4 = *(const uint2*)(Zs + fr * ustride + t); const uint2 x4 = *(const uint2*)(hyu + (size_t)(512 + c) * MT + baseb + t);
            f32x4 z; z[0] = bflo(x4.x) * (acc[i][0] + sk1 * bflo(v4.x)); z[1] = bfhi(x4.x) * (acc[i][1] + sk1 * bfhi(v4.x));
            z[2] = bflo(x4.y) * (acc[i][2] + sk1 * bflo(v4.y)); z[3] = bfhi(x4.y) * (acc[i][3] + sk1 * bfhi(v4.y));
            *(uint2*)(hyo + (size_t)c * MT + baseb + t) = pack4(z); } }
}

DEVI void ml_item(const Params& P, int l, int b, int hh, int dir, unsigned char* smem) {
    const int tid = opaque_tid(), lane = tid & 63, wid = tid >> 6, fr = lane & 15, quad = lane >> 4;
    bf16_t* Qs = (bf16_t*)(smem + 1024); bf16_t* Qp = Qs + 64 * 72; bf16_t* Ks = Qp + 64 * 72; bf16_t* KTw = Ks + 64 * 72; bf16_t* Ss = KTw + 64 * 72;
    bf16_t* VT = Ss + 64 * 72; bf16_t* Cs = VT + 80 * 72;
    float* btm = (float*)(Cs + 80 * 72); float* aval = btm + 64; float* mrow = aval + 64; float* winter = mrow + 64; float* wg = winter + 64; float* sc = wg + 64;
    const bf16_t* mlqk = (const bf16_t*)(opaque_ws(P) + WS_MLQK); const bf16_t* p = (const bf16_t*)(opaque_ws(P) + WS_P); const float* gates = (const float*)(opaque_ws(P) + WS_GATES);
    float* mlh = (float*)(opaque_ws(P) + WS_MLH) + (size_t)dir * MT * 256;
    for (int i = tid; i < 80 * 72; i += 512) Cs[i] = 0;
    for (int i = tid; i < 16 * 72; i += 512) VT[64 * 72 + i] = (i < 72) ? (bf16_t)0x3F80 : (bf16_t)0;
    if (tid == 0) sc[0] = 0.f;
    const int tt = wid & 3, grp = wid >> 2;
    f32x4 Cacc[3];
#pragma unroll
    for (int j = 0; j < 3; ++j) Cacc[j] = (f32x4){0.f, 0.f, 0.f, 0.f};
    const int lr = tid & 63, lc0 = (tid >> 6) * 8;
    uint4 qreg, kreg, vreg; float gi = 0.f, gf = 0.f;
    { const int Ls = CTX; const size_t rowbase = (size_t)MLAT + b * CTX; const int pos = dir ? Ls - 1 - lr : lr; const size_t row = rowbase + pos;
      qreg = *(const uint4*)(mlqk + row * 512 + hh * 64 + lc0); kreg = *(const uint4*)(mlqk + row * 512 + 256 + hh * 64 + lc0); vreg = *(const uint4*)(p + row * NP + 512 + hh * 64 + lc0);
      if (tid < 64) { const float* gp = gates + row * 16 + dir * 8 + hh; gi = gp[0]; gf = gp[4]; } }
    __syncthreads();
#pragma unroll 1
    for (int ck = 0; ck < 36; ++ck) {
        const int seq = ck >= 4; const int Ls = seq ? SEQ : CTX; const size_t rowbase = seq ? (size_t)b * SEQ : (size_t)MLAT + b * CTX; const int kk = seq ? ck - 4 : ck;
        if (tid < 64) {
            float bsum = logsigmoid(gf);
#pragma unroll
            for (int o = 1; o < 64; o <<= 1) { const float t = __shfl_up(bsum, o); if (lane >= o) bsum += t; }
            const float a = gi - bsum; float pm = a;
#pragma unroll
            for (int o = 1; o < 64; o <<= 1) { const float t = __shfl_up(pm, o); if (lane >= o) pm = fmaxf(pm, t); }
            const float m = sc[0]; const float mt = bsum + fmaxf(m, pm);
            btm[lane] = bsum - mt; aval[lane] = a; mrow[lane] = mt; winter[lane] = expf(bsum + m - mt);
            const float bend = __shfl(bsum, 63), pmend = __shfl(pm, 63); const float mnew = bend + fmaxf(m, pmend);
            wg[lane] = expf(bend + a - mnew);
            if (lane == 0) { sc[1] = expf(bend + m - mnew); sc[2] = mnew; } }
        __syncthreads();
        { float qf[8], kf[8]; unpack8(qreg, qf); unpack8(kreg, kf);
          const float wi = winter[lr], wgs = wg[lr];
          *(uint4*)(Qs + lr * 72 + lc0) = qreg; *(uint4*)(Ks + lr * 72 + lc0) = kreg;
          uint4 o; o.x = pack2(qf[0] * wi, qf[1] * wi); o.y = pack2(qf[2] * wi, qf[3] * wi); o.z = pack2(qf[4] * wi, qf[5] * wi); o.w = pack2(qf[6] * wi, qf[7] * wi);
          *(uint4*)(Qp + lr * 72 + lc0) = o;
          const unsigned k01 = pack2(kf[0] * wgs, kf[1] * wgs), k23 = pack2(kf[2] * wgs, kf[3] * wgs), k45 = pack2(kf[4] * wgs, kf[5] * wgs), k67 = pack2(kf[6] * wgs, kf[7] * wgs);
          bf16_t* kt = KTw + lc0 * 72 + lr;
          kt[0] = (bf16_t)(k01 & 0xffff); kt[72] = (bf16_t)(k01 >> 16); kt[144] = (bf16_t)(k23 & 0xffff); kt[216] = (bf16_t)(k23 >> 16);
          kt[288] = (bf16_t)(k45 & 0xffff); kt[360] = (bf16_t)(k45 >> 16); kt[432] = (bf16_t)(k67 & 0xffff); kt[504] = (bf16_t)(k67 >> 16);
          bf16_t* vt = VT + lc0 * 72 + lr;
          vt[0] = (bf16_t)(vreg.x & 0xffff); vt[72] = (bf16_t)(vreg.x >> 16); vt[144] = (bf16_t)(vreg.y & 0xffff); vt[216] = (bf16_t)(vreg.y >> 16);
          vt[288] = (bf16_t)(vreg.z & 0xffff); vt[360] = (bf16_t)(vreg.z >> 16); vt[432] = (bf16_t)(vreg.w & 0xffff); vt[504] = (bf16_t)(vreg.w >> 16); }
        __syncthreads();
        if (ck + 1 < 36) { const int ck1 = ck + 1; const int seq1 = ck1 >= 4; const int Ls1 = seq1 ? SEQ : CTX; const size_t rb1 = seq1 ? (size_t)b * SEQ : (size_t)MLAT + b * CTX; const int kk1 = seq1 ? ck1 - 4 : ck1;
            const int pos = dir ? Ls1 - 1 - (kk1 * 64 + lr) : kk1 * 64 + lr; const size_t row = rb1 + pos;
            qreg = *(const uint4*)(mlqk + row * 512 + hh * 64 + lc0); kreg = *(const uint4*)(mlqk + row * 512 + 256 + hh * 64 + lc0); vreg = *(const uint4*)(p + row * NP + 512 + hh * 64 + lc0);
            if (tid < 64) { const float* gp = gates + row * 16 + dir * 8 + hh; gi = gp[0]; gf = gp[4]; } }
#pragma unroll
        for (int j = 0; j < 2; ++j) { const int ti = 2 * wid + j; const int st = ti >> 2, t2 = ti & 3;
            f32x4 sv = (f32x4){0.f, 0.f, 0.f, 0.f};
            if (st <= t2) {
#pragma unroll
                for (int k2 = 0; k2 < 2; ++k2) { const bf16x8 af = *(const bf16x8*)(Ks + (st * 16 + fr) * 72 + k2 * 32 + quad * 8); const bf16x8 bq = *(const bf16x8*)(Qs + (t2 * 16 + fr) * 72 + k2 * 32 + quad * 8);
                    sv = mfma16(af, bq, sv); }
                const int t = t2 * 16 + fr; const float bt = btm[t];
#pragma unroll
                for (int i = 0; i < 4; ++i) { const int s_ = st * 16 + quad * 4 + i; sv[i] = s_ <= t ? sv[i] * expf(bt + aval[s_]) : 0.f; } }
            *(uint2*)(Ss + (t2 * 16 + fr) * 72 + st * 16 + quad * 4) = pack4(sv); }
        __syncthreads();
        { f32x4 oacc[3];
#pragma unroll
          for (int j = 0; j < 3; ++j) oacc[j] = (f32x4){0.f, 0.f, 0.f, 0.f};
#pragma unroll
          for (int k2 = 0; k2 < 2; ++k2) { const bf16x8 bS = *(const bf16x8*)(Ss + (tt * 16 + fr) * 72 + k2 * 32 + quad * 8); const bf16x8 bQ = *(const bf16x8*)(Qp + (tt * 16 + fr) * 72 + k2 * 32 + quad * 8);
              const bf16x8 bK = *(const bf16x8*)(KTw + (tt * 16 + fr) * 72 + k2 * 32 + quad * 8);
#pragma unroll
              for (int j = 0; j < 3; ++j) { const int dt = j < 2 ? 2 * grp + j : 4;
                  const bf16x8 aV = *(const bf16x8*)(VT + (dt * 16 + fr) * 72 + k2 * 32 + quad * 8); const bf16x8 aC = *(const bf16x8*)(Cs + (dt * 16 + fr) * 72 + k2 * 32 + quad * 8);
                  oacc[j] = mfma16(aV, bS, oacc[j]); oacc[j] = mfma16(aC, bQ, oacc[j]);
                  if (k2 == 0) Cacc[j] = Cacc[j] * sc[1];
                  Cacc[j] = mfma16(aV, bK, Cacc[j]); } }
          const int t = tt * 16 + fr;
          const float den = __shfl(oacc[2][0], fr);
          const float inv = 1.f / fmaxf(fabsf(den), expf(-mrow[t]));
          const int pos = dir ? Ls - 1 - (kk * 64 + t) : kk * 64 + t; const size_t row = rowbase + pos;
#pragma unroll
          for (int j = 0; j < 2; ++j) { const f32x4 o = oacc[j] * inv; *(f32x4*)(mlh + row * 256 + hh * 64 + (2 * grp + j) * 16 + quad * 4) = o; } }
        __syncthreads();
#pragma unroll
        for (int j = 0; j < 3; ++j) { const int dt = j < 2 ? 2 * grp + j : 4;
#pragma unroll
            for (int i = 0; i < 4; ++i) Cs[(dt * 16 + quad * 4 + i) * 72 + tt * 16 + fr] = f2bf(Cacc[j][i]); }
        if (tid == 0) sc[0] = sc[2];
    }
}

constexpr int MX_ML = 64, MX_HYL = 256, MX_GQAL = 256, MX_DIFL = 512, MX_GQAC = 32, MX_DIFC = 64, MX_HYC = 256;
constexpr int MX_TOTAL = MX_ML + MX_HYL + MX_GQAL + MX_DIFL + MX_GQAC + MX_DIFC + MX_HYC;

DEVI void mixer_phase(const Params& P, int cidx, int l, unsigned char* smem) {
    unsigned* ctr = (unsigned*)(opaque_ws(P) + WS_CTL) + cidx;
    int* s_item = (int*)smem;
    for (;;) {
        __syncthreads();
        if (opaque_tid() == 0) *s_item = (int)atomicAdd(ctr, 1u);
        __syncthreads();
        int it = *s_item;
        if (it >= (l == DEPTH - 1 ? MX_ML + MX_HYL + MX_GQAL + MX_DIFL : MX_TOTAL)) break;
        if (it < MX_ML) { ml_item(P, l, it >> 3, (it >> 1) & 3, it & 1, smem);
#ifdef PROBE_ML2
            __syncthreads(); ml_item(P, l, it >> 3, (it >> 1) & 3, it & 1, smem);
#endif
            continue; } it -= MX_ML;
#ifndef PROBE_MX
#define PROBE_MX 0
#endif
        if (it < MX_DIFL) { for (int pr = 0; pr < (PROBE_MX == 3 ? 2 : 1); ++pr) { if (pr) __syncthreads(); attn_item<true>(P, l, it >> 6, (it >> 4) & 3, it & 15, false, smem); } continue; } it -= MX_DIFL;
        if (it < MX_GQAL) { for (int pr = 0; pr < (PROBE_MX == 2 ? 2 : 1); ++pr) { if (pr) __syncthreads(); attn_item<false>(P, l, it >> 5, (it >> 4) & 1, it & 15, false, smem); } continue; } it -= MX_GQAL;
        if (it < MX_HYL) { for (int pr = 0; pr < (PROBE_MX == 1 ? 2 : 1); ++pr) { if (pr) __syncthreads(); hy_item<16>(P, l, it, smem); } continue; } it -= MX_HYL;
        if (it < MX_GQAC) { attn_item<false>(P, l, it >> 2, (it >> 1) & 1, it & 1, true, smem); continue; } it -= MX_GQAC;
        if (it < MX_DIFC) { attn_item<true>(P, l, it >> 3, (it >> 1) & 3, it & 1, true, smem); continue; } it -= MX_DIFC;
        hy_item<2>(P, l, it, smem);
    }
}

DEVI void final_phase(const Params& P, int l, unsigned char* smem) {
    const int tid = opaque_tid();
    const float* mlh0 = (const float*)(opaque_ws(P) + WS_MLH); const float* mlh1 = mlh0 + (size_t)MT * 256;
    const bf16_t* p = (const bf16_t*)(opaque_ws(P) + WS_P); const bf16_t* hyo = (const bf16_t*)(opaque_ws(P) + WS_HYO);
    bf16_t* cat = (bf16_t*)(opaque_ws(P) + WS_CAT);
    const float* ng = P.in[14] + (size_t)l * 256;
    bf16_t* lt = (bf16_t*)(smem + 1024);
    constexpr int TR = 32;
    const int ntile = ((l == DEPTH - 1 ? MLAT : MT) + TR - 1) / TR;
    for (int rt = opaque_bid(); rt < ntile; rt += gridDim.x) { const int row0 = rt * TR;
        for (int task = tid; task < TR * 64; task += 512) { const int r = task >> 6, c4 = (task & 63) * 4; const size_t row = row0 + r;
            const float4 a = *(const float4*)(mlh0 + row * 256 + c4), bq = *(const float4*)(mlh1 + row * 256 + c4);
            float4 h; h.x = a.x + bq.x; h.y = a.y + bq.y; h.z = a.z + bq.z; h.w = a.w + bq.w;
            float ss = h.x * h.x + h.y * h.y + h.z * h.z + h.w * h.w;
            ss += __shfl_xor(ss, 1); ss += __shfl_xor(ss, 2); ss += __shfl_xor(ss, 4); ss += __shfl_xor(ss, 8);
            const float rstd = rsqrtf(ss * (1.f / 64.f) + 1e-6f);
            const float4 g4 = *(const float4*)(ng + c4);
            const uint2 ov = *(const uint2*)(p + row * NP + 768 + c4);
            f32x4 y; y[0] = h.x * rstd * g4.x * sigmoid_fast(bflo(ov.x)); y[1] = h.y * rstd * g4.y * sigmoid_fast(bfhi(ov.x));
            y[2] = h.z * rstd * g4.z * sigmoid_fast(bflo(ov.y)); y[3] = h.w * rstd * g4.w * sigmoid_fast(bfhi(ov.y));
            *(uint2*)(cat + row * D + c4) = pack4(y); }
        for (int task = tid; task < 256 * (TR / 8); task += 512) { const int c = task / (TR / 8), ch = task % (TR / 8);
            const uint4 v = *(const uint4*)(hyo + (size_t)c * MT + row0 + ch * 8);
            bf16_t* d = lt + (size_t)(ch * 8) * 264 + c;
            d[0] = (bf16_t)(v.x & 0xffff); d[264] = (bf16_t)(v.x >> 16); d[528] = (bf16_t)(v.y & 0xffff); d[792] = (bf16_t)(v.y >> 16);
            d[1056] = (bf16_t)(v.z & 0xffff); d[1320] = (bf16_t)(v.z >> 16); d[1584] = (bf16_t)(v.w & 0xffff); d[1848] = (bf16_t)(v.w >> 16); }
        __syncthreads();
        for (int task = tid; task < TR * 32; task += 512) { const int r = task >> 5, c8 = (task & 31) * 8;
            *(uint4*)(cat + (size_t)(row0 + r) * D + 512 + c8) = *(const uint4*)(lt + (size_t)r * 264 + c8); }
        __syncthreads();
    }
}

#ifndef REPSTEP
#define REPSTEP -1
#endif
#define XBAR() do { XcdBarrier xb_; xb_.bar = (unsigned*)(opaque_ws(P) + WS_BAR); xb_.x = xb_xcc_id(); xb_.st = (volatile LAS3 unsigned*)(smem + 16); xcd_barrier(xb_); } while (0)
__global__ void __launch_bounds__(512) mega_fwd(Params P) {
    extern __shared__ __attribute__((aligned(16))) unsigned char smem[];
    cg::grid_group grid = cg::this_grid();
    if (threadIdx.x < 8) ((volatile LAS3 unsigned*)(smem + 16))[threadIdx.x] = 0u;
    __syncthreads();
    if (blockIdx.x == 0) { for (int i = threadIdx.x; i < (4096 + 16384) / 4; i += 512) ((unsigned*)(P.ws + WS_CTL))[i] = 0u; }
    phase0a(P, smem);
    grid.sync();
#ifdef PROBE_P0A
    phase0a(P, smem);
    grid.sync();
#endif
    (void)xcd_barrier_post((unsigned*)(opaque_ws(P) + WS_BAR), (volatile LAS3 unsigned*)(smem + 16));
    phase0b(P, smem);
    XBAR();
#ifdef PROBE_P0B
    phase0b(P, smem);
    XBAR();
#endif
    constexpr int NS = 10;
#ifdef PROBE_S
    unsigned long long pacc = 0;
#endif
#pragma unroll 1
    for (int step = 0; step < DEPTH * NS; ++step) {
        const int l = step / NS, s = step - l * NS;
#ifdef PROBE_S
        unsigned long long pt0 = 0; if (s == PROBE_S) pt0 = __builtin_amdgcn_s_memrealtime();
#endif
        if (s == 4) prep_phase(P, l, smem);
        else if (s == 5) mixer_phase(P, l, l, smem);
        else if (s == 6) final_phase(P, l, smem);
        else {
            int opA = 0, partA = 0, lA = l, opB = 0, partB = 0, B0 = 0, R = 0;
            const bool last = (l == DEPTH - 1);
            switch (s) {
            case 0: if (l > 0) { opA = 6; partA = 1; lA = l - 1; B0 = 32; R = 3; } opB = 1; break;
            case 1: opA = 2; opB = 1; partB = 1; break;
            case 2: opA = 2; partA = 1; opB = 3; B0 = 32; R = 3; break;
            case 3: opA = 3; partA = 1; break;
            case 7: opA = 4; break;
            case 8: if (!last) { opA = 4; partA = 1; B0 = 32; R = 2; } opB = 5; break;
            default: opA = 6; if (!last) { opB = 5; partB = 1; } break;
            }
#pragma unroll 1
            for (int jj = 0; jj < 2; ++jj) {
                const int op = jj ? opB : opA, part = jj ? partB : partA, lj = jj ? l : lA;
                if (op == 0) continue;
                unsigned char* ws = opaque_ws(P);
                const float* modl = (const float*)(ws + WS_MOD) + (size_t)lj * 9 * 9216;
                float* ssqb = (float*)(ws + WS_SSQ);
                GemmJob J;
                J.nM = part ? 8 : 64; J.pm0 = part ? 64 : 0; J.B0 = jj ? B0 : 0; J.R = jj ? R : 0; J.nK = 1; J.order = 0; J.K = 1024; J.ld = 1024;
                J.hl = P.out; J.hc = (float*)(ws + WS_HCTX); J.gates = (float*)(ws + WS_GATES); J.gb = P.in[11] + lj * 16;
                J.obf = nullptr; J.gate = modl; J.fac = 0.f; J.aout = nullptr; J.ng = P.in[6]; J.nscale = modl; J.ssq = ssqb; J.Sb = nullptr;
                if (op == 1 || op == 5) { const int f = op == 1 ? 0 : 1; J.A = (const bf16_t*)(ws + WS_A); J.Bt = (const bf16_t*)(ws + WS_W13) + (size_t)(lj * 2 + f) * 5632 * 1024; J.nN = 22; J.epi = 0; J.obf = (bf16_t*)(ws + WS_HID);
                    J.ssq = ssqb + (size_t)(lj * 3 + (f ? 2 : 0)) * MT; J.Sb = (const float*)(ws + WS_SB) + (size_t)(lj * 2 + f) * 9 * 5632; }
                else if (op == 2 || op == 6) { const int f = op == 2 ? 0 : 1; J.A = (const bf16_t*)(ws + WS_HID); J.Bt = (const bf16_t*)(ws + WS_W2) + (size_t)(lj * 2 + f) * 1024 * 2816; J.nN = 4; J.K = 2816; J.ld = 2816; J.epi = 1;
                    J.gate = modl + (f == 0 ? 2 : 8) * 1024; J.fac = 0.5f;
                    const bool fuse = (f == 0) || (lj + 1 < DEPTH); const int ln = (f == 1 && lj + 1 < DEPTH) ? lj + 1 : lj;
                    J.aout = fuse ? (bf16_t*)(ws + WS_A) : (bf16_t*)nullptr; J.ng = P.in[6] + (size_t)(ln * 3 + (f == 0 ? 1 : 0)) * 1024;
                    J.nscale = (const float*)(ws + WS_MOD) + (size_t)ln * 9 * 9216 + (f == 0 ? 4 : 1) * 1024; J.ssq = ssqb + (size_t)(ln * 3 + (f == 0 ? 1 : 0)) * MT; }
                else if (op == 3) { J.A = (const bf16_t*)(ws + WS_A); J.Bt = (const bf16_t*)(ws + WS_WIN) + (size_t)lj * NPG * 1024; J.nN = 13; J.epi = 2; J.obf = (bf16_t*)(ws + WS_P);
                    J.ssq = ssqb + (size_t)(lj * 3 + 1) * MT; J.Sb = (const float*)(ws + WS_SBIN) + (size_t)lj * 9 * NPG; }
                else { J.A = (const bf16_t*)(ws + WS_CAT); J.Bt = (const bf16_t*)(ws + WS_WOUT) + (size_t)lj * 1024 * 1024; J.nN = 4; J.epi = 1; J.gate = modl + 5 * 1024; J.fac = 1.f;
                    J.aout = (bf16_t*)(ws + WS_A); J.ng = P.in[6] + (size_t)(lj * 3 + 2) * 1024; J.nscale = modl + 7 * 1024; J.ssq = ssqb + (size_t)(lj * 3 + 2) * MT; }
                run_job(smem, J);
            }
        }
        XBAR();
#ifdef PROBE_S
        if (s == PROBE_S) pacc += __builtin_amdgcn_s_memrealtime() - pt0;
#endif
    }
#ifdef PROBE_EPI
    if (blockIdx.x == 0) { const unsigned pe = *(volatile LAS3 unsigned*)(smem + 32); const unsigned long long t1 = __builtin_amdgcn_s_memrealtime(); while (__builtin_amdgcn_s_memrealtime() - t1 < 4ull * pe) __builtin_amdgcn_s_sleep(8); }
#endif
#ifdef PROBE_S
    if (blockIdx.x == 0) { const unsigned long long t1 = __builtin_amdgcn_s_memrealtime(); while (__builtin_amdgcn_s_memrealtime() - t1 < 4ull * pacc) __builtin_amdgcn_s_sleep(8); }
#endif
}

extern "C" void kernel_launch(void* const* d_in, const int* in_sizes, int n_in, void* d_out, int out_size, void* d_ws, size_t ws_size, hipStream_t stream) {
    static int grid_blocks = 0;
    if (grid_blocks == 0) {
        if (n_in != 28 || ws_size < WS_END) { fprintf(stderr, "kernel_launch: unexpected n_in %d or ws_size %zu (need %zu)\n", n_in, ws_size, (size_t)WS_END); grid_blocks = -1; return; }
        int dev = 0, cus = 0, per_cu = 0;
        hipGetDevice(&dev);
        hipDeviceGetAttribute(&cus, hipDeviceAttributeMultiprocessorCount, dev);
        if (hipFuncSetAttribute((const void*)mega_fwd, hipFuncAttributeMaxDynamicSharedMemorySize, LDS_BYTES) != hipSuccess) { fprintf(stderr, "kernel_launch: hipFuncSetAttribute failed\n"); }
        if (hipOccupancyMaxActiveBlocksPerMultiprocessor(&per_cu, (const void*)mega_fwd, 512, LDS_BYTES) != hipSuccess || per_cu < 1) { fprintf(stderr, "kernel_launch: occupancy query gave %d\n", per_cu); per_cu = 1; }
        (void)hipGetLastError();
        grid_blocks = cus;
    }
    if (grid_blocks < 0) return;
    Params p{};
    for (int i = 0; i < 28; ++i) p.in[i] = (const float*)d_in[i];
    p.out = (float*)d_out; p.ws = (unsigned char*)d_ws;
    void* args[] = {&p};
    hipError_t e = hipLaunchCooperativeKernel((const void*)mega_fwd, dim3(grid_blocks), dim3(512), args, LDS_BYTES, stream);
    if (e != hipSuccess) fprintf(stderr, "cooperative launch failed: %s (grid %d)\n", hipGetErrorString(e), grid_blocks);
}
```
